# Optimizing an MI355X kernel written in HIP

```python
import math
import jax, jax.numpy as jnp
from jax import lax
import numpy as np

D_MODEL = 2048
BATCH = 2
SEQ = 4096
DEPTH = 2
DEC_BATCH = 32
DEC_SEQ = 4
PAST_LEN = 16384
PAGE_SIZE = 128

N_MIXERS = 2
N_ATTN_LAYERS = (DEPTH + 1) // 2
N_GDN_LAYERS = DEPTH // 2

HEAD_DIM = 64
N_HEADS = D_MODEL // HEAD_DIM
N_KV_HEADS = N_HEADS // 8
GROUP = N_HEADS // N_KV_HEADS
WINDOW = 128
BLOCK = 128
N_BUCKETS = 32
MAX_DISTANCE = 128
NEG_INF = -1e30

GDN_K_HEADS = 16
GDN_V_HEADS = 32
GDN_DK = 128
GDN_DV = 128
GDN_KEY_DIM = GDN_K_HEADS * GDN_DK
GDN_VAL_DIM = GDN_V_HEADS * GDN_DV
GDN_CONV_DIM = 2 * GDN_KEY_DIM + GDN_VAL_DIM
GDN_IN_DIM = GDN_CONV_DIM + GDN_VAL_DIM + 2 * GDN_V_HEADS
GDN_CONV = 4
GDN_CHUNK = 64

D_FF = 5632
FFN_CONV = 3

NORM_EPS = 1e-6

kernel_name = 'hybrid_swa_sink_gdn_convffn_step'


def rms_norm(x, gain):
    xf = x.astype(jnp.float32)
    y = xf * lax.rsqrt(jnp.mean(xf * xf, axis=-1, keepdims=True) + NORM_EPS)
    return (y * gain.astype(jnp.float32)).astype(x.dtype)


def l2_norm(x):
    xf = x.astype(jnp.float32)
    return xf * lax.rsqrt(jnp.sum(xf * xf, axis=-1, keepdims=True) + NORM_EPS)


def modulate(h, shift, scale):
    return h * (1 + scale[:, None, :]) + shift[:, None, :]


def causal_dwconv(x, hist, w, bias=None):
    width = w.shape[0]
    L = x.shape[1]
    xp = jnp.concatenate([hist.astype(x.dtype), x], axis=1)
    y = xp[:, 0:L] * w[0]
    for j in range(1, width):
        y = y + xp[:, j:j + L] * w[j]
    if bias is not None:
        y = y + bias
    return y, xp[:, L:]


def t5_bucket(dist):
    max_exact = N_BUCKETS // 2
    d = jnp.maximum(dist, 0)
    df = jnp.maximum(d, 1).astype(jnp.float32)
    large = max_exact + (jnp.log(df / max_exact) / math.log(MAX_DISTANCE / max_exact)
                         * (N_BUCKETS - max_exact)).astype(jnp.int32)
    large = jnp.minimum(large, N_BUCKETS - 1)
    return jnp.where(d < max_exact, d, large)


def rel_bias(dist, table):
    b = table.astype(jnp.float32)[t5_bucket(dist)]
    return jnp.moveaxis(b, -1, 0).reshape(N_KV_HEADS, GROUP, *dist.shape)


def softmax_with_sink(s, sinks):
    sink = sinks.astype(jnp.float32).reshape(N_KV_HEADS, GROUP, 1, 1)
    m = jnp.maximum(jnp.max(s, axis=-1, keepdims=True), sink)
    p = jnp.exp(s - m)
    return p / (jnp.sum(p, axis=-1, keepdims=True) + jnp.exp(sink - m))


def attn_qkv(h, w_qkv, q_gain, k_gain):
    B, L, _ = h.shape
    qkv = h @ w_qkv
    q, k, v = jnp.split(qkv, [N_HEADS * HEAD_DIM, (N_HEADS + N_KV_HEADS) * HEAD_DIM], axis=-1)
    q = rms_norm(q.reshape(B, L, N_KV_HEADS, GROUP, HEAD_DIM), q_gain)
    k = rms_norm(k.reshape(B, L, N_KV_HEADS, HEAD_DIM), k_gain)
    v = v.reshape(B, L, N_KV_HEADS, HEAD_DIM)
    return q, k, v


def attn_prompt(h, w_qkv, q_gain, k_gain, sinks, w_o, rel_table):
    B, L, _ = h.shape
    nb = L // BLOCK
    q, k, v = attn_qkv(h, w_qkv, q_gain, k_gain)
    qb = q.reshape(B, nb, BLOCK, N_KV_HEADS, GROUP, HEAD_DIM)
    kb = k.reshape(B, nb, BLOCK, N_KV_HEADS, HEAD_DIM)
    vb = v.reshape(B, nb, BLOCK, N_KV_HEADS, HEAD_DIM)
    prev = lambda t: jnp.pad(t, ((0, 0), (1, 0), (0, 0), (0, 0), (0, 0)))[:, :-1]
    k2 = jnp.concatenate([prev(kb), kb], axis=2)
    v2 = jnp.concatenate([prev(vb), vb], axis=2)
    qi = jnp.arange(BLOCK)[:, None]
    sj = jnp.arange(2 * BLOCK)[None, :]
    dist = qi + BLOCK - sj
    in_band = (dist >= 0) & (dist <= WINDOW)
    has_prev = (jnp.arange(nb)[:, None, None] > 0) | (sj >= BLOCK)[None]
    mask = in_band[None] & has_prev
    s = jnp.einsum('bnqkgd,bnskd->bnkgqs', qb, k2,
                   preferred_element_type=jnp.float32) * HEAD_DIM ** -0.5
    s = s + rel_bias(dist, rel_table)
    s = jnp.where(mask[None, :, None, None], s, NEG_INF)
    p = softmax_with_sink(s, sinks)
    o = jnp.einsum('bnkgqs,bnskd->bnqkgd', p.astype(v.dtype), v2)
    y = o.reshape(B, L, N_HEADS * HEAD_DIM) @ w_o
    keep = min(WINDOW, PAST_LEN)
    return y, k[:, L - keep:], v[:, L - keep:]


def attn_sample(h, buf_k, buf_v, w_qkv, q_gain, k_gain, sinks, w_o, rel_table):
    B, T, _ = h.shape
    W = buf_k.shape[1]
    q, k, v = attn_qkv(h, w_qkv, q_gain, k_gain)
    k_all = jnp.concatenate([buf_k.astype(k.dtype), k], axis=1)
    v_all = jnp.concatenate([buf_v.astype(v.dtype), v], axis=1)
    q_pos = PAST_LEN + jnp.arange(T)
    k_pos = PAST_LEN - W + jnp.arange(W + T)
    dist = q_pos[:, None] - k_pos[None, :]
    mask = (dist >= 0) & (dist <= WINDOW)
    s = jnp.einsum('bqkgd,bskd->bkgqs', q, k_all,
                   preferred_element_type=jnp.float32) * HEAD_DIM ** -0.5
    s = jnp.where(mask, s + rel_bias(dist, rel_table), NEG_INF)
    p = softmax_with_sink(s, sinks)
    o = jnp.einsum('bkgqs,bskd->bqkgd', p.astype(v.dtype), v_all)
    y = o.reshape(B, T, N_HEADS * HEAD_DIM) @ w_o
    return y, k_all[:, T:], v_all[:, T:]


def gated_delta_chunked(q, k, v, beta, g, state0):
    f32 = jnp.float32
    B, L, H, DK = q.shape
    DV = v.shape[-1]
    C = min(GDN_CHUNK, L)
    pad = (-L) % C
    q = q.astype(f32) * DK ** -0.5
    k = k.astype(f32)
    v = v.astype(f32)
    beta = beta.astype(f32)
    g = g.astype(f32)
    if pad:
        p4 = ((0, 0), (0, pad), (0, 0), (0, 0))
        q, k, v = jnp.pad(q, p4), jnp.pad(k, p4), jnp.pad(v, p4)
        beta, g = jnp.pad(beta, p4[:3]), jnp.pad(g, p4[:3])
    N = (L + pad) // C
    chunk = lambda t: jnp.moveaxis(t.reshape(B, N, C, H, *t.shape[3:]), 3, 1)
    q, k, v, beta, g = chunk(q), chunk(k), chunk(v), chunk(beta), chunk(g)
    g = jnp.cumsum(g, axis=-1)
    k_beta = k * beta[..., None]
    v_beta = v * beta[..., None]
    tril = jnp.tril(jnp.ones((C, C), dtype=bool))
    strict = jnp.tril(jnp.ones((C, C), dtype=bool), -1)
    decay = jnp.exp(jnp.where(tril, g[..., :, None] - g[..., None, :], -jnp.inf))
    A = jnp.where(strict, jnp.einsum('bhnid,bhnjd->bhnij', k_beta, k) * decay, 0.0)
    eye = jnp.eye(C, dtype=f32)
    T = lax.linalg.triangular_solve(eye + A, jnp.broadcast_to(eye, A.shape),
                                    left_side=True, lower=True, unit_diagonal=True)
    u = T @ v_beta
    w = T @ (k_beta * jnp.exp(g)[..., None])
    qk = jnp.einsum('bhnid,bhnjd->bhnij', q, k) * decay

    def step(S, xs):
        q_c, k_c, u_c, w_c, g_c, qk_c = xs
        v_new = u_c - w_c @ S
        o = (q_c * jnp.exp(g_c)[..., None]) @ S + qk_c @ v_new
        g_last = g_c[..., -1]
        S = S * jnp.exp(g_last)[..., None, None] + jnp.einsum(
            'bhcd,bhce->bhde', k_c * jnp.exp(g_last[..., None] - g_c)[..., None], v_new)
        return S, o

    xs = tuple(jnp.moveaxis(t, 2, 0) for t in (q, k, u, w, g, qk))
    S, o = lax.scan(step, state0.astype(f32), xs)
    o = jnp.transpose(o, (1, 0, 3, 2, 4)).reshape(B, N * C, H, DV)[:, :L]
    return o, S


def gdn_mixer(h, S0, conv0, w_in, conv_w, a_log, dt_bias, out_norm, w_out):
    B, L, _ = h.shape
    proj = h @ w_in
    mixed, z, b, a = jnp.split(
        proj, [GDN_CONV_DIM, GDN_CONV_DIM + GDN_VAL_DIM, GDN_CONV_DIM + GDN_VAL_DIM + GDN_V_HEADS], axis=-1)
    mixed, conv1 = causal_dwconv(mixed, conv0, conv_w)
    mixed = jax.nn.silu(mixed)
    q, k, v = jnp.split(mixed, [GDN_KEY_DIM, 2 * GDN_KEY_DIM], axis=-1)
    rep = GDN_V_HEADS // GDN_K_HEADS
    q = jnp.repeat(l2_norm(q.reshape(B, L, GDN_K_HEADS, GDN_DK)), rep, axis=2)
    k = jnp.repeat(l2_norm(k.reshape(B, L, GDN_K_HEADS, GDN_DK)), rep, axis=2)
    v = v.reshape(B, L, GDN_V_HEADS, GDN_DV)
    beta = jax.nn.sigmoid(b.astype(jnp.float32))
    g = -jnp.exp(a_log.astype(jnp.float32)) * jax.nn.softplus(
        a.astype(jnp.float32) + dt_bias.astype(jnp.float32))
    o, S1 = gated_delta_chunked(q, k, v, beta, g, S0)
    o = rms_norm(o, out_norm) * jax.nn.silu(z.reshape(B, L, GDN_V_HEADS, GDN_DV).astype(jnp.float32))
    y = o.reshape(B, L, GDN_VAL_DIM).astype(h.dtype) @ w_out
    return y, S1, conv1


def conv_ffn(h, hist, w_up, conv_w, conv_b, w_down):
    u = h @ w_up
    y, hist1 = causal_dwconv(u, hist, conv_w, conv_b)
    gate, val = jnp.split(y, 2, axis=-1)
    return (jax.nn.silu(gate) * val) @ w_down, hist1


def trunk(x, c, win_k, win_v, gdn_state, gdn_conv, ffn_conv, P):
    sample = win_k is not None
    B = x.shape[0]
    new_k, new_v, new_s, new_gc, new_fc = [], [], [], [], []
    for layer in range(DEPTH):
        mod = jax.nn.silu(c) @ P['w_ada'][layer] + P['b_ada'][layer]
        sh_m, sc_m, g_m, sh_f, sc_f, g_f = jnp.split(mod, 6, axis=-1)
        h = modulate(rms_norm(x, P['norm_mix'][layer]), sh_m, sc_m)
        i = layer // N_MIXERS
        if layer % N_MIXERS == 0:
            args = (P['w_attn_qkv'][i], P['attn_q_norm'][i], P['attn_k_norm'][i],
                    P['attn_sinks'][i], P['w_attn_o'][i], P['rel_bias_table'])
            if sample:
                out, kk, vv = attn_sample(h, win_k[i], win_v[i], *args)
            else:
                out, kk, vv = attn_prompt(h, *args)
            new_k.append(kk)
            new_v.append(vv)
        else:
            if sample:
                s0, c0 = gdn_state[i], gdn_conv[i]
            else:
                s0 = jnp.zeros((B, GDN_V_HEADS, GDN_DK, GDN_DV), jnp.float32)
                c0 = jnp.zeros((B, GDN_CONV - 1, GDN_CONV_DIM), x.dtype)
            out, s1, c1 = gdn_mixer(h, s0, c0, P['w_gdn_in'][i], P['gdn_conv_w'][i], P['gdn_a_log'][i],
                                    P['gdn_dt_bias'][i], P['gdn_out_norm'][i], P['w_gdn_out'][i])
            new_s.append(s1)
            new_gc.append(c1)
        x = x + g_m[:, None, :] * out
        h = modulate(rms_norm(x, P['norm_ffn'][layer]), sh_f, sc_f)
        f0 = ffn_conv[layer] if sample else jnp.zeros((B, FFN_CONV - 1, 2 * D_FF), x.dtype)
        out, f1 = conv_ffn(h, f0, P['w_ffn_up'][layer], P['ffn_conv_w'][layer],
                           P['ffn_conv_b'][layer], P['w_ffn_down'][layer])
        new_fc.append(f1)
        x = x + g_f[:, None, :] * out
    return (x, jnp.stack(new_k), jnp.stack(new_v), jnp.stack(new_s),
            jnp.stack(new_gc), jnp.stack(new_fc))


def setup_inputs(seed: int = 0) -> dict:
    key = jax.random.key(seed)
    ks = jax.random.split(key, 32)
    f32 = jnp.float32
    nrm = lambda k, shape, scale: jax.random.normal(k, shape, f32) * scale
    win_len = min(WINDOW, PAST_LEN)
    dt = jax.random.uniform(ks[22], (N_GDN_LAYERS, GDN_V_HEADS), f32, 1e-3, 0.1)
    return {
        'x_prompt': nrm(ks[0], (BATCH, SEQ, D_MODEL), 1.0),
        'x_sample': nrm(ks[1], (DEC_BATCH, DEC_SEQ, D_MODEL), 1.0),
        'c_prompt': nrm(ks[2], (BATCH, D_MODEL), 1.0),
        'c_sample': nrm(ks[3], (DEC_BATCH, D_MODEL), 1.0),
        'cache_win_k': nrm(ks[4], (N_ATTN_LAYERS, DEC_BATCH, win_len, N_KV_HEADS, HEAD_DIM), 1.0),
        'cache_win_v': nrm(ks[5], (N_ATTN_LAYERS, DEC_BATCH, win_len, N_KV_HEADS, HEAD_DIM), 1.0),
        'state_gdn': nrm(ks[6], (N_GDN_LAYERS, DEC_BATCH, GDN_V_HEADS, GDN_DK, GDN_DV), 0.5),
        'state_gdn_conv': nrm(ks[7], (N_GDN_LAYERS, DEC_BATCH, GDN_CONV - 1, GDN_CONV_DIM), 1.0),
        'state_ffn_conv': nrm(ks[8], (DEPTH, DEC_BATCH, FFN_CONV - 1, 2 * D_FF), 1.0),
        'rel_bias_table': nrm(ks[9], (N_BUCKETS, N_HEADS), 0.5),
        'w_ada': nrm(ks[10], (DEPTH, D_MODEL, 6 * D_MODEL), 0.5 * D_MODEL ** -0.5),
        'b_ada': nrm(ks[11], (DEPTH, 6 * D_MODEL), 0.01),
        'norm_mix': 1.0 + nrm(ks[12], (DEPTH, D_MODEL), 0.01),
        'norm_ffn': 1.0 + nrm(ks[13], (DEPTH, D_MODEL), 0.01),
        'w_attn_qkv': nrm(ks[14], (N_ATTN_LAYERS, D_MODEL, (N_HEADS + 2 * N_KV_HEADS) * HEAD_DIM), D_MODEL ** -0.5),
        'attn_q_norm': 1.0 + nrm(ks[15], (N_ATTN_LAYERS, HEAD_DIM), 0.01),
        'attn_k_norm': 1.0 + nrm(ks[16], (N_ATTN_LAYERS, HEAD_DIM), 0.01),
        'attn_sinks': nrm(ks[17], (N_ATTN_LAYERS, N_HEADS), 0.5),
        'w_attn_o': nrm(ks[18], (N_ATTN_LAYERS, N_HEADS * HEAD_DIM, D_MODEL), (N_HEADS * HEAD_DIM) ** -0.5),
        'w_gdn_in': nrm(ks[19], (N_GDN_LAYERS, D_MODEL, GDN_IN_DIM), D_MODEL ** -0.5),
        'gdn_conv_w': nrm(ks[20], (N_GDN_LAYERS, GDN_CONV, GDN_CONV_DIM), GDN_CONV ** -0.5),
        'gdn_a_log': jnp.log(jax.random.uniform(ks[21], (N_GDN_LAYERS, GDN_V_HEADS), f32, 1.0, 16.0)),
        'gdn_dt_bias': dt + jnp.log(-jnp.expm1(-dt)),
        'gdn_out_norm': 1.0 + nrm(ks[23], (N_GDN_LAYERS, GDN_DV), 0.01),
        'w_gdn_out': nrm(ks[24], (N_GDN_LAYERS, GDN_VAL_DIM, D_MODEL), GDN_VAL_DIM ** -0.5),
        'w_ffn_up': nrm(ks[25], (DEPTH, D_MODEL, 2 * D_FF), D_MODEL ** -0.5),
        'ffn_conv_w': nrm(ks[26], (DEPTH, FFN_CONV, 2 * D_FF), FFN_CONV ** -0.5),
        'ffn_conv_b': nrm(ks[27], (DEPTH, 2 * D_FF), 0.01),
        'w_ffn_down': nrm(ks[28], (DEPTH, D_FF, D_MODEL), D_FF ** -0.5),
    }


def reference(x_prompt, x_sample, c_prompt, c_sample,
              cache_win_k, cache_win_v, state_gdn, state_gdn_conv, state_ffn_conv,
              rel_bias_table, w_ada, b_ada, norm_mix, norm_ffn,
              w_attn_qkv, attn_q_norm, attn_k_norm, attn_sinks, w_attn_o,
              w_gdn_in, gdn_conv_w, gdn_a_log, gdn_dt_bias, gdn_out_norm, w_gdn_out,
              w_ffn_up, ffn_conv_w, ffn_conv_b, w_ffn_down):
    P = {
        'rel_bias_table': rel_bias_table, 'w_ada': w_ada, 'b_ada': b_ada,
        'norm_mix': norm_mix, 'norm_ffn': norm_ffn,
        'w_attn_qkv': w_attn_qkv, 'attn_q_norm': attn_q_norm, 'attn_k_norm': attn_k_norm,
        'attn_sinks': attn_sinks, 'w_attn_o': w_attn_o,
        'w_gdn_in': w_gdn_in, 'gdn_conv_w': gdn_conv_w, 'gdn_a_log': gdn_a_log,
        'gdn_dt_bias': gdn_dt_bias, 'gdn_out_norm': gdn_out_norm, 'w_gdn_out': w_gdn_out,
        'w_ffn_up': w_ffn_up, 'ffn_conv_w': ffn_conv_w, 'ffn_conv_b': ffn_conv_b,
        'w_ffn_down': w_ffn_down,
    }
    y_prompt, wk_p, wv_p, gdn_p, gconv_p, fconv_p = trunk(
        x_prompt, c_prompt, None, None, None, None, None, P)
    y_sample, wk_s, wv_s, gdn_s, gconv_s, fconv_s = trunk(
        x_sample, c_sample, cache_win_k, cache_win_v, state_gdn, state_gdn_conv, state_ffn_conv, P)
    return (y_prompt, y_sample, wk_p, wv_p, wk_s, wv_s, gdn_p, gdn_s, gconv_p, gconv_s, fconv_p, fconv_s)
```

```cpp
#include <hip/hip_runtime.h>
#include <cstdio>
#include <cstdint>
namespace pg8 {
#define PG8_LAS __attribute__((address_space(3)))
typedef unsigned short bf16_t;
typedef short bf16x8 __attribute__((ext_vector_type(8)));
typedef float f32x4 __attribute__((ext_vector_type(4)));
typedef unsigned u32x4 __attribute__((ext_vector_type(4)));
constexpr int BM = 256, BK = 64, HALF = 128, HTB = HALF * BK * 2  , STAGE_BYTES = 8 * HTB, NXCD = 8, WGM = 8;

__host__ __device__ __forceinline__ int lds_byte(int r, int c) { const int st = (r >> 4) * 2 + (c >> 5), rr = r & 15, cc = c & 31, ob = rr * 64 + cc * 2; return st * 1024 + (ob ^ (((ob >> 9) & 1) << 5)); }
__host__ __device__ __forceinline__ void stage_rc(int b, int& R, int& C) { const int st = b / 1024, sb = b % 1024, swz = sb ^ (((sb >> 9) & 1) << 5); R = (st >> 1) * 16 + swz / 64; C = (st & 1) * 32 + (swz % 64) / 2; }
__host__ __device__ __forceinline__ int perm32(int rho) { const int n = rho >> 4, i = rho & 15; return 8 * (i >> 2) + 4 * n + (i & 3); }

struct Unit { int pm, pn; };
struct Gemm { const bf16_t* A; const bf16_t* Bt; int M, N, K; };

struct StaticOrder {
    int nM, nN, nwg, G, c;
    __host__ __device__ void init(int M, int N, int G_, int c_) { nM = M / BM; nN = N / BM; nwg = nM * nN; G = G_; c = c_; }
    __host__ __device__ bool next(int i, Unit& u) const {
        const long L = (long)i * G + c; if (L >= nwg) return false;
        int wgid = (int)L; { const int q = nwg / NXCD, r = nwg % NXCD, xcd = wgid % NXCD, off = wgid / NXCD; wgid = (xcd < r ? xcd * (q + 1) : r * (q + 1) + (xcd - r) * q) + off; }
        const int nig = WGM * nN, gid = wgid / nig, fm = gid * WGM, gsz = (nM - fm) < WGM ? (nM - fm) : WGM;
        u.pm = fm + ((wgid % nig) % gsz); u.pn = (wgid % nig) / gsz; return true;
    }
    __device__ __forceinline__ void a_ready(const Unit&) const {}
    __device__ __forceinline__ void done(const Unit&) const {}
};

__device__ __forceinline__ unsigned cvt_pk_bf16(float lo, float hi) { unsigned r; asm volatile("v_cvt_pk_bf16_f32 %0, %1, %2" : "=v"(r) : "v"(lo), "v"(hi)); return r; }
typedef float f32x2 __attribute__((ext_vector_type(2)));
template <class Epi, class Sched, bool ALIGN_EPI = false, bool SP2 = false>
__device__ __forceinline__ void gemm_phase(PG8_LAS unsigned char* lds, const Gemm g, const Sched& S, const Epi& E) {
    const int tid = threadIdx.x, wid = __builtin_amdgcn_readfirstlane(tid >> 6), lane = tid & 63, wr = wid >> 2, wc = wid & 3, fr = lane & 15, fq = lane >> 4;
    const int K = g.K, nt = K / BK;
    unsigned voffA[2], voffB[2];
#pragma unroll
    for (int i = 0; i < 2; ++i) { int R, C; stage_rc(tid * 16 + i * 8192, R, C); const int Rb = Epi::PERM ? ((R & ~31) + perm32(R & 31)) : R;
        voffA[i] = (unsigned)(R * K + C) * 2u; voffB[i] = (unsigned)(Rb * K + C) * 2u; }
    const size_t kstep = (size_t)(BK * 2);
    const size_t hstep = (size_t)HALF * K * 2;
    const size_t tstep = 2 * hstep;
    const unsigned ldsw = (unsigned)wid * 1024u;
    const int aoff = lds_byte(wr * 64 + fr, fq * 8), boff = lds_byte(wc * 32 + fr, fq * 8);
#define PG8_SA(b, h) (((b) * 2 + (h)) * HTB)
#define PG8_SB(b, h) ((4 + (b) * 2 + (h)) * HTB)
#define PG8_STAGE(bufoff, gbase, voff) do { _Pragma("unroll") for (int _i = 0; _i < 2; ++_i) \
        __builtin_amdgcn_global_load_lds((const unsigned*)((const char*)(gbase) + (voff)[_i]), (PG8_LAS unsigned*)(lds + (bufoff) + ldsw + _i * 8192), 16, 0, 0); } while (0)
#define PG8_LDA(dst, b, h) do { _Pragma("unroll") for (int m = 0; m < 4; ++m) _Pragma("unroll") for (int k = 0; k < 2; ++k) dst[m][k] = *(const PG8_LAS bf16x8*)(lds + PG8_SA(b, h) + aoff + m * 2048 + k * 1024); } while (0)
#define PG8_LDB(dst, b, h) do { _Pragma("unroll") for (int n = 0; n < 2; ++n) _Pragma("unroll") for (int k = 0; k < 2; ++k) dst[n][k] = *(const PG8_LAS bf16x8*)(lds + PG8_SB(b, h) + boff + n * 2048 + k * 1024); } while (0)
#define PG8_MMA(ai, bj, At, Bt) do { __builtin_amdgcn_s_setprio(1); _Pragma("unroll") for (int m = 0; m < 4; ++m) _Pragma("unroll") for (int n = 0; n < 2; ++n) _Pragma("unroll") for (int k = 0; k < 2; ++k) \
        acc[ai][bj][m][n] = __builtin_amdgcn_mfma_f32_16x16x32_bf16(Bt[n][k], At[m][k], acc[ai][bj][m][n], 0, 0, 0); __builtin_amdgcn_s_setprio(0); } while (0)
#define PG8_WAIT_V(n) asm volatile("s_waitcnt vmcnt(" #n ")" ::: "memory")
#define PG8_WAIT_L(n) asm volatile("s_waitcnt lgkmcnt(" #n ")" ::: "memory")
#define PG8_BAR __builtin_amdgcn_s_barrier()
#define PG8_SCHED __builtin_amdgcn_sched_barrier(0)
    Unit cur, nxt; int ui = 0;
    if (!S.next(0, cur)) return;
    f32x4 acc[2][2][4][2];
#pragma unroll
    for (int a = 0; a < 2; ++a)
#pragma unroll
        for (int b = 0; b < 2; ++b)
#pragma unroll
            for (int m = 0; m < 4; ++m)
#pragma unroll
                for (int n = 0; n < 2; ++n) acc[a][b][m][n] = (f32x4){0.f, 0.f, 0.f, 0.f};
    bf16x8 At[4][2], B0[2][2], B1[2][2];
    const char* cA = (const char*)g.A + (size_t)cur.pm * tstep; const char* cB = (const char*)g.Bt + (size_t)cur.pn * tstep;
    S.a_ready(cur);
    if constexpr (SP2) {
        PG8_STAGE(PG8_SB(0, 0), cB, voffB); PG8_STAGE(PG8_SB(0, 1), cB + hstep, voffB); PG8_STAGE(PG8_SA(0, 0), cA, voffA); PG8_STAGE(PG8_SA(0, 1), cA + hstep, voffA);
        if (wr == 1) PG8_BAR;
        PG8_WAIT_V(2); PG8_BAR;
        PG8_STAGE(PG8_SB(1, 0), cB + kstep, voffB); PG8_STAGE(PG8_SA(1, 0), cA + kstep, voffA); PG8_STAGE(PG8_SB(1, 1), cB + hstep + kstep, voffB);
        PG8_WAIT_V(6); PG8_BAR;
    } else {
        PG8_STAGE(PG8_SB(0, 0), cB, voffB); PG8_STAGE(PG8_SA(0, 0), cA, voffA); PG8_STAGE(PG8_SB(0, 1), cB + hstep, voffB); PG8_STAGE(PG8_SA(0, 1), cA + hstep, voffA);
        if (wr == 1) PG8_BAR;
        PG8_WAIT_V(4); PG8_BAR;
        PG8_STAGE(PG8_SB(1, 0), cB + kstep, voffB); PG8_STAGE(PG8_SA(1, 0), cA + kstep, voffA); PG8_STAGE(PG8_SB(1, 1), cB + hstep + kstep, voffB);
        PG8_WAIT_V(6); PG8_BAR;
    }
    for (;;) {
        const bool has_next = S.next(ui + 1, nxt);
        const char* nA = has_next ? (const char*)g.A + (size_t)nxt.pm * tstep : cA; const char* nB = has_next ? (const char*)g.Bt + (size_t)nxt.pn * tstep : cB;
        for (int t = 0; t < nt; t += 2) {
            const bool last = (t == nt - 2);
            const char* a1 = cA + (size_t)(t + 1) * kstep;
            const char* a2 = last ? nA : cA + (size_t)(t + 2) * kstep; const char* b2 = last ? nB : cB + (size_t)(t + 2) * kstep;
            const char* a3 = a2 + kstep; const char* b3 = b2 + kstep;
            if (last && has_next) S.a_ready(nxt);
            if constexpr (SP2) {
            PG8_LDB(B0, 0, 0); PG8_LDB(B1, 0, 1); PG8_SCHED; PG8_LDA(At, 0, 0); PG8_STAGE(PG8_SA(1, 1), a1 + hstep, voffA);
            PG8_WAIT_V(8); PG8_WAIT_L(0); PG8_BAR; PG8_MMA(0, 0, At, B0); PG8_MMA(0, 1, At, B1); PG8_BAR; PG8_SCHED;
            PG8_LDA(At, 0, 1); PG8_STAGE(PG8_SB(0, 0), b2, voffB); PG8_STAGE(PG8_SB(0, 1), b2 + hstep, voffB); PG8_STAGE(PG8_SA(0, 0), a2, voffA);
            PG8_WAIT_V(8); PG8_WAIT_L(0); PG8_BAR; PG8_MMA(1, 0, At, B0); PG8_MMA(1, 1, At, B1); PG8_BAR; PG8_SCHED;
            PG8_LDB(B0, 1, 0); PG8_LDB(B1, 1, 1); PG8_SCHED; PG8_LDA(At, 1, 0); PG8_STAGE(PG8_SA(0, 1), a2 + hstep, voffA);
            PG8_WAIT_V(8); PG8_WAIT_L(0); PG8_BAR; PG8_MMA(0, 0, At, B0); PG8_MMA(0, 1, At, B1); PG8_BAR; PG8_SCHED;
            PG8_LDA(At, 1, 1); PG8_STAGE(PG8_SB(1, 0), b3, voffB); PG8_STAGE(PG8_SB(1, 1), b3 + hstep, voffB); PG8_STAGE(PG8_SA(1, 0), a3, voffA);
            PG8_WAIT_V(8); PG8_WAIT_L(0); PG8_BAR; PG8_MMA(1, 0, At, B0); PG8_MMA(1, 1, At, B1); PG8_BAR; PG8_SCHED;
            } else {
            PG8_LDB(B0, 0, 0); PG8_SCHED; PG8_LDA(At, 0, 0); PG8_STAGE(PG8_SA(1, 1), a1 + hstep, voffA);
            PG8_WAIT_L(8); PG8_BAR; PG8_WAIT_L(0); PG8_MMA(0, 0, At, B0); PG8_BAR; PG8_SCHED;
            PG8_LDB(B1, 0, 1); PG8_STAGE(PG8_SB(0, 0), b2, voffB);
            PG8_BAR; PG8_WAIT_L(0); PG8_MMA(0, 1, At, B1); PG8_BAR;
            PG8_LDA(At, 0, 1); PG8_STAGE(PG8_SA(0, 0), a2, voffA);
            PG8_BAR; PG8_WAIT_L(0); PG8_MMA(1, 0, At, B0); PG8_BAR; PG8_SCHED;
            PG8_STAGE(PG8_SB(0, 1), b2 + hstep, voffB);
            PG8_WAIT_V(6); PG8_BAR; PG8_MMA(1, 1, At, B1); PG8_BAR;
            PG8_LDB(B0, 1, 0); PG8_SCHED; PG8_LDA(At, 1, 0); PG8_STAGE(PG8_SA(0, 1), a2 + hstep, voffA);
            PG8_WAIT_L(8); PG8_BAR; PG8_WAIT_L(0); PG8_MMA(0, 0, At, B0); PG8_BAR; PG8_SCHED;
            PG8_LDB(B1, 1, 1); PG8_STAGE(PG8_SB(1, 0), b3, voffB);
            PG8_BAR; PG8_WAIT_L(0); PG8_MMA(0, 1, At, B1); PG8_BAR;
            PG8_LDA(At, 1, 1); PG8_STAGE(PG8_SA(1, 0), a3, voffA);
            PG8_BAR; PG8_WAIT_L(0); PG8_MMA(1, 0, At, B0); PG8_BAR; PG8_SCHED;
            PG8_STAGE(PG8_SB(1, 1), b3 + hstep, voffB);
            PG8_WAIT_V(6); PG8_BAR; PG8_MMA(1, 1, At, B1); PG8_BAR;
            }
        }
        if constexpr (ALIGN_EPI) { if (wr == 0) PG8_BAR; }
        if constexpr (!Epi::AFTER_DRAIN) { E(acc, cur, wr, wc, fr, fq); S.done(cur); }
        if (!has_next) break;
#pragma unroll
        for (int a = 0; a < 2; ++a)
#pragma unroll
            for (int b = 0; b < 2; ++b)
#pragma unroll
                for (int m = 0; m < 4; ++m)
#pragma unroll
                    for (int n = 0; n < 2; ++n) acc[a][b][m][n] = (f32x4){0.f, 0.f, 0.f, 0.f};
        cur = nxt; cA = nA; cB = nB; ++ui;
        if constexpr (ALIGN_EPI) { if (wr == 1) PG8_BAR; }
    }
    PG8_WAIT_V(0);
    if constexpr (!ALIGN_EPI) { if (wr == 0) PG8_BAR; }
    PG8_BAR;
    if constexpr (Epi::AFTER_DRAIN) { E.fused(acc, cur, wr, wc, fr, fq, lds, wid, lane); S.done(cur); }
#undef PG8_SA
#undef PG8_SB
#undef PG8_STAGE
#undef PG8_LDA
#undef PG8_LDB
#undef PG8_MMA
#undef PG8_WAIT_V
#undef PG8_WAIT_L
#undef PG8_BAR
#undef PG8_SCHED
}
}
#define GAS __attribute__((address_space(1)))
#define LAS __attribute__((address_space(3)))
typedef unsigned short bf16;
typedef unsigned v4u __attribute__((ext_vector_type(4)));
typedef float f32x4 __attribute__((ext_vector_type(4)));
typedef short bf16x8 __attribute__((ext_vector_type(8)));
typedef GAS unsigned gu32;
typedef GAS unsigned long long gu64;
#define RLX_AGENT __ATOMIC_RELAXED, __HIP_MEMORY_SCOPE_AGENT
#define LDS_WAIT() asm volatile("s_waitcnt lgkmcnt(0)" ::: "memory")
#define VM_WAIT() asm volatile("s_waitcnt vmcnt(0)" ::: "memory")
__device__ __forceinline__ unsigned long long rt() { return __builtin_amdgcn_s_memrealtime(); }
__device__ __forceinline__ unsigned f2bf(float f) { unsigned u = __builtin_bit_cast(unsigned, f); return (u + 0x7fffu + ((u >> 16) & 1u)) >> 16; }
__device__ __forceinline__ unsigned pk2(float lo, float hi) { return f2bf(lo) | (f2bf(hi) << 16); }

#define XB_TMO      128
#define XB_XCNT(j)  (256  + 64 * (j))
#define XB_XSUB(j)  (1280 + 64 * (j))
#define XB_XGEN(j)  (2304 + 64 * (j))
#define XB_TOP      3328
#define XB_TOPGEN   3392
#define XCD_BAR_WORDS 3456
#define XB_SPIN_CAP (1u << 18)

__device__ __forceinline__ unsigned xb_ld(unsigned* p)              { return __hip_atomic_load(p, __ATOMIC_RELAXED, __HIP_MEMORY_SCOPE_AGENT); }
__device__ __forceinline__ unsigned xb_add(unsigned* p, unsigned v) { return __hip_atomic_fetch_add(p, v, __ATOMIC_RELAXED, __HIP_MEMORY_SCOPE_AGENT); }
__device__ __forceinline__ unsigned xb_xcc_id() { return (unsigned)__builtin_amdgcn_s_getreg((3 << 11) | 20) & 0xFu; }
#define XB_SPIN(cond, bar) do { unsigned _sp = 0; while (cond) { __builtin_amdgcn_s_sleep(1); \
    if ((++_sp & 255u) == 0u) { if (xb_ld(&(bar)[XB_TMO])) break; if (_sp > XB_SPIN_CAP) { atomicAdd(&(bar)[XB_TMO], 1u); break; } } } } while (0)

struct XcdBarrier {
    unsigned* bar; unsigned x;
    volatile LAS unsigned* st;
};

__device__ __forceinline__ XcdBarrier xcd_barrier_post(unsigned* bar, volatile LAS unsigned* st) {
    XcdBarrier b; b.bar = bar; b.x = xb_xcc_id(); b.st = st;
    if (threadIdx.x == 0) (void)xb_add(&bar[XB_XCNT(b.x)], 1u);
    return b;
}
__device__ __forceinline__ void xcd_barrier_complete(unsigned* bar, unsigned x, unsigned& nloc, unsigned& nx) {
    const unsigned G = gridDim.x * gridDim.y * gridDim.z;
    unsigned sum, cnt, mine, sp = 0u;
    for (;;) {
        sum = 0u; cnt = 0u; mine = 0u;
#pragma unroll
        for (unsigned j = 0; j < 16; ++j) { const unsigned c = xb_ld(&bar[XB_XCNT(j)]); sum += c; cnt += (c > 0u) ? 1u : 0u; mine = (j == x) ? c : mine; }
        if (sum == G) break;
        __builtin_amdgcn_s_sleep(1);
        if ((++sp & 255u) == 0u) { if (xb_ld(&bar[XB_TMO])) break; if (sp > XB_SPIN_CAP) { atomicAdd(&bar[XB_TMO], 1u); break; } }
    }
    nloc = mine > 0u ? mine : 1u; nx = cnt > 0u ? cnt : 1u;
}

__device__ __forceinline__ void xcd_barrier(const XcdBarrier& b) {
    asm volatile("s_waitcnt vmcnt(0)" ::: "memory");
    __syncthreads();
    if (threadIdx.x == 0) {
        unsigned* bar = b.bar;
        __builtin_amdgcn_s_waitcnt(0);
        unsigned nloc = b.st[0], nx = b.st[1];
        if (nloc == 0u) { xcd_barrier_complete(bar, b.x, nloc, nx); b.st[0] = nloc; b.st[1] = nx; }
        const unsigned old = xb_add(&bar[XB_XSUB(b.x)], 1u);
        const unsigned gen = old / nloc;
        if (old + 1u == (gen + 1u) * nloc) {
            __builtin_amdgcn_fence(__ATOMIC_RELEASE, "agent");
            asm volatile("s_waitcnt vmcnt(0)" ::: "memory");
            const unsigned og = xb_add(&bar[XB_TOP], 1u);
            const unsigned tg = og / nx;
            if (og + 1u == (tg + 1u) * nx) xb_add(&bar[XB_TOPGEN], 1u);
            else XB_SPIN(xb_ld(&bar[XB_TOPGEN]) == tg, bar);
            __builtin_amdgcn_fence(__ATOMIC_ACQUIRE, "agent");
            xb_add(&bar[XB_XGEN(b.x)], 1u);
            asm volatile("s_waitcnt vmcnt(0)" ::: "memory");
        } else {
            XB_SPIN(xb_ld(&bar[XB_XGEN(b.x)]) == gen, bar);
            __builtin_amdgcn_fence(__ATOMIC_ACQUIRE, "agent");
            asm volatile("s_waitcnt vmcnt(0)" ::: "memory");
        }
    }
    __syncthreads();
}
__device__ __forceinline__ float wave_sum(float v) {
#pragma unroll
    for (int o = 1; o < 64; o <<= 1) v += __shfl_xor(v, o);
    return v;
}
__device__ __forceinline__ void p0_transpose_item(const float* W, int K, int N, bf16* WT, int row_off, LAS float* scr, int item, int lane) {
    const int nblk = N / 32, kb = item / nblk, nb = item % nblk, k0 = 64 * kb, n0 = 32 * nb;
#pragma unroll 8
    for (int i = 0; i < 32; ++i) { const int kk = 2 * i + (lane >> 5); scr[kk * 33 + (lane & 31)] = W[(size_t)(k0 + kk) * N + n0 + (lane & 31)]; }
    LDS_WAIT(); asm volatile("" ::: "memory");
    const int c = lane & 7;
#pragma unroll
    for (int j = 0; j < 4; ++j) { const int n = (lane >> 3) + 8 * j; const LAS float* s = scr + (8 * c) * 33 + n;
        v4u o; o.x = pk2(s[0 * 33], s[1 * 33]); o.y = pk2(s[2 * 33], s[3 * 33]); o.z = pk2(s[4 * 33], s[5 * 33]); o.w = pk2(s[6 * 33], s[7 * 33]);
        *(GAS v4u*)(WT + (size_t)(row_off + n0 + n) * K + k0 + 8 * c) = o; }
    LDS_WAIT(); asm volatile("" ::: "memory");
}

#define DI __device__ __forceinline__
typedef float f32x2 __attribute__((ext_vector_type(2)));
typedef float f32x16 __attribute__((ext_vector_type(16)));
typedef unsigned v2u __attribute__((ext_vector_type(2)));
typedef __bf16 bf16x2_t __attribute__((ext_vector_type(2)));
#define MFMA32(a, b, c) __builtin_amdgcn_mfma_f32_32x32x16_bf16((a), (b), (c), 0, 0, 0)

constexpr int DM = 2048, SEQ = 4096, MPROMPT = 8192, MSAMP = 128, MTOK = 8320, MP = 8448;
constexpr int NQKV = 2560, DFF = 5632, NUP = 11264, NGIN = 12352, NGINP = 12544, GVAL = 4096;
constexpr int MODW = 12288, NMODROW = 34;
constexpr float NORM_EPS = 1e-6f;

constexpr size_t O_Y = 0;
constexpr size_t O_WKP = (size_t)MTOK * DM;
constexpr size_t O_WVP = O_WKP + 65536;
constexpr size_t O_WKS = O_WVP + 65536;
constexpr size_t O_WVS = O_WKS + 1048576;
constexpr size_t O_GDNP = O_WVS + 1048576;
constexpr size_t O_GDNS = O_GDNP + 1048576;
constexpr size_t O_GCP = O_GDNS + 16777216;
constexpr size_t O_GCS = O_GCP + 49152;
constexpr size_t O_FCP = O_GCS + 786432;
constexpr size_t O_FCS = O_FCP + 90112;
constexpr size_t O_END = O_FCS + 1441792;

constexpr size_t MiB = 1u << 20;
constexpr size_t WS_CTL = 0, CTL_ZERO_BYTES = 1 * MiB;
constexpr size_t WS_MOD = 1 * MiB;
constexpr size_t WS_WQKV = 5 * MiB, WS_WO = 15 * MiB, WS_WGIN = 23 * MiB, WS_WGOUT = 72 * MiB;
constexpr size_t WS_WUP0 = 88 * MiB, WS_WUP1 = 132 * MiB, WS_WDN0 = 176 * MiB, WS_WDN1 = 198 * MiB;
constexpr size_t WS_H = 220 * MiB;
constexpr size_t WS_BIG = 253 * MiB;
constexpr size_t WS_R = 456 * MiB;
constexpr size_t WS_QKV = WS_R;
constexpr size_t WS_AO = 498 * MiB;
constexpr size_t WS_ACT = 531 * MiB;
constexpr size_t WS_KQ = WS_R;
constexpr size_t WS_TH = 552 * MiB;
constexpr size_t WS_VEC = 680 * MiB;
constexpr size_t WS_BA = 684 * MiB;
constexpr size_t WS_GO = 687 * MiB;
constexpr size_t WS_END = 753 * MiB;
static_assert(WS_H + (size_t)MP * DM * 2 <= WS_BIG && WS_BIG + (size_t)MP * NGINP * 2 <= WS_R, "ws map");
static_assert(WS_QKV + (size_t)MP * NQKV * 2 <= WS_AO && WS_AO + (size_t)MP * DM * 2 <= WS_ACT && WS_ACT + (size_t)MP * DFF * 2 <= WS_VEC, "ws map");
static_assert(WS_KQ + (size_t)2048 * 49152 <= WS_TH && WS_TH + (size_t)4096 * 32768 <= WS_VEC && WS_VEC + (size_t)4096 * 1024 <= WS_BA, "ws map");
static_assert(WS_BA + (size_t)MP * 64 * 4 <= WS_GO && WS_GO + (size_t)MP * GVAL * 2 <= WS_END, "ws map");
constexpr int CW_QUEUE = 64;
constexpr int CW_BAR = 4096;

constexpr int LDS_BYTES = 155648;
constexpr int MISC_OFF = 151552;

DI float bflo(unsigned w) { return __uint_as_float(w << 16); }
DI float bfhi(unsigned w) { return __uint_as_float(w & 0xffff0000u); }
DI float bf2f(unsigned short b) { return __uint_as_float((unsigned)b << 16); }
DI unsigned pkbf(float lo, float hi) { f32x2 v = {lo, hi}; bf16x2_t b = __builtin_convertvector(v, bf16x2_t); return __builtin_bit_cast(unsigned, b); }
DI unsigned short f2bf16(float f) { return (unsigned short)(pkbf(f, 0.f) & 0xffffu); }
DI void unpack8(v4u w, float (&x)[8]) { x[0] = bflo(w.x); x[1] = bfhi(w.x); x[2] = bflo(w.y); x[3] = bfhi(w.y); x[4] = bflo(w.z); x[5] = bfhi(w.z); x[6] = bflo(w.w); x[7] = bfhi(w.w); }
DI v4u pack8f(const float (&x)[8]) { v4u w; w.x = pkbf(x[0], x[1]); w.y = pkbf(x[2], x[3]); w.z = pkbf(x[4], x[5]); w.w = pkbf(x[6], x[7]); return w; }
DI float silu_f(float x) { return x / (1.f + __expf(-x)); }
DI float sigmoid_f(float x) { return 1.f / (1.f + __expf(-x)); }
DI float softplus_f(float x) { return fmaxf(x, 0.f) + log1pf(__expf(-fabsf(x))); }
DI int crow(int reg, int h) { return (reg & 3) + 8 * (reg >> 2) + 4 * h; }
DI int rho32(int p) { return (p & ~12) | ((p & 4) << 1) | ((p & 8) >> 1); }
DI int pos64(int j) { return (j & ~31) | rho32(j & 31); }
template <int S_> DI bf16x8 pack_acc(const f32x16& x) {
    v4u p; p.x = pkbf(x[8 * S_ + 0], x[8 * S_ + 1]); p.y = pkbf(x[8 * S_ + 2], x[8 * S_ + 3]); p.z = pkbf(x[8 * S_ + 4], x[8 * S_ + 5]); p.w = pkbf(x[8 * S_ + 6], x[8 * S_ + 7]);
    return __builtin_bit_cast(bf16x8, p);
}
DI f32x16 zero16() { f32x16 z; _Pragma("unroll") for (int i = 0; i < 16; ++i) z[i] = 0.f; return z; }

struct P {
    const float *x_prompt, *x_sample, *c_prompt, *c_sample, *cache_k, *cache_v, *state_gdn, *state_gconv, *state_fconv, *rel_table;
    const float *w_ada, *b_ada, *norm_mix, *norm_ffn, *w_qkv, *q_norm, *k_norm, *sinks, *w_o, *w_gin, *gconv_w, *a_log, *dt_bias, *out_norm, *w_gout;
    const float *w_up, *fconv_w, *fconv_b, *w_dn;
    float* out; unsigned char* ws;
};

namespace pg8 {
struct EpiStore {
    static constexpr bool PERM = true, AFTER_DRAIN = false;
    bf16_t* O; int ldc; float* side; int sidepn;
    __device__ __forceinline__ void operator()(const f32x4 (&acc)[2][2][4][2], const Unit& u, int wr, int wc, int fr, int fq) const {
        const int row0 = u.pm * BM + wr * 64 + fr;
        if (side != nullptr && u.pn == sidepn) {
            if (wc < 2) {
#pragma unroll
                for (int ai = 0; ai < 2; ++ai)
#pragma unroll
                    for (int m = 0; m < 4; ++m) { float* rp = side + (size_t)(row0 + ai * HALF + m * 16) * 64 + wc * 32 + 8 * fq;
                        *(f32x4*)(rp) = acc[ai][0][m][0]; *(f32x4*)(rp + 4) = acc[ai][0][m][1]; }
            }
            return;
        }
        const int col0 = u.pn * BM + wc * 32 + 8 * fq;
#pragma unroll
        for (int ai = 0; ai < 2; ++ai)
#pragma unroll
            for (int m = 0; m < 4; ++m) { bf16_t* rowp = O + (size_t)(row0 + ai * HALF + m * 16) * ldc + col0;
#pragma unroll
                for (int bj = 0; bj < 2; ++bj) { const f32x4 v0 = acc[ai][bj][m][0], v1 = acc[ai][bj][m][1];
                    u32x4 w; w.x = cvt_pk_bf16(v0[0], v0[1]); w.y = cvt_pk_bf16(v0[2], v0[3]); w.z = cvt_pk_bf16(v1[0], v1[1]); w.w = cvt_pk_bf16(v1[2], v1[3]);
                    *(u32x4*)(rowp + bj * HALF) = w; } }
    }
};
struct EpiResid {
    static constexpr bool PERM = false, AFTER_DRAIN = false;
    const float* xin_p; const float* xin_s; float* xout; const float* gate;
    __device__ __forceinline__ void operator()(const f32x4 (&acc)[2][2][4][2], const Unit& u, int wr, int wc, int fr, int fq) const {
        const int col0 = u.pn * BM + wc * 32 + 4 * fq;
        if (u.pm < 32) {
            const float* g = gate + (size_t)(u.pm >> 4) * 12288 + col0;
            f32x4 gv[2][2];
#pragma unroll
            for (int bj = 0; bj < 2; ++bj)
#pragma unroll
                for (int n = 0; n < 2; ++n) gv[bj][n] = *(const f32x4*)(g + bj * HALF + n * 16);
#pragma unroll
            for (int ai = 0; ai < 2; ++ai)
#pragma unroll
                for (int m = 0; m < 4; ++m) { const size_t off = (size_t)(u.pm * BM + ai * HALF + wr * 64 + m * 16 + fr) * 2048 + col0;
#pragma unroll
                    for (int bj = 0; bj < 2; ++bj)
#pragma unroll
                        for (int n = 0; n < 2; ++n) { const f32x4 xv = *(const f32x4*)(xin_p + off + bj * HALF + n * 16);
                            *(f32x4*)(xout + off + bj * HALF + n * 16) = xv + gv[bj][n] * acc[ai][bj][m][n]; }
                    asm volatile("" ::: "memory"); }
        } else {
#pragma unroll
            for (int m = 0; m < 4; ++m) { const int rs = wr * 64 + m * 16 + fr;
                const float* g = gate + (size_t)(2 + (rs >> 2)) * 12288 + col0; const size_t off = (size_t)rs * 2048 + col0;
#pragma unroll
                for (int bj = 0; bj < 2; ++bj)
#pragma unroll
                    for (int n = 0; n < 2; ++n) { const f32x4 gvv = *(const f32x4*)(g + bj * HALF + n * 16); const f32x4 xv = *(const f32x4*)(xin_s + off + bj * HALF + n * 16);
                        *(f32x4*)(xout + (size_t)8192 * 2048 + off + bj * HALF + n * 16) = xv + gvv * acc[0][bj][m][n]; }
                asm volatile("" ::: "memory"); }
        }
    }
};
}

constexpr int I_QKV = 32 * 80, I_O = 32 * 64, I_GIN = 32 * 386, I_GOUT = 64 * 64, I_UP = 32 * 352, I_DN = 88 * 64;
constexpr int NITEMS = I_QKV + I_O + I_GIN + I_GOUT + 2 * I_UP + 2 * I_DN;
DI void p0_item(const P& p, int it, LAS float* scr, int lane) {
    unsigned char* ws = p.ws; int r = it;
    if (r < I_QKV) { p0_transpose_item(p.w_qkv, 2048, NQKV, (bf16*)(ws + WS_WQKV), 0, scr, r, lane); return; } r -= I_QKV;
    if (r < I_O) { p0_transpose_item(p.w_o, 2048, 2048, (bf16*)(ws + WS_WO), 0, scr, r, lane); return; } r -= I_O;
    if (r < I_GIN) { p0_transpose_item(p.w_gin, 2048, NGIN, (bf16*)(ws + WS_WGIN), 0, scr, r, lane); return; } r -= I_GIN;
    if (r < I_GOUT) { p0_transpose_item(p.w_gout, 4096, 2048, (bf16*)(ws + WS_WGOUT), 0, scr, r, lane); return; } r -= I_GOUT;
    if (r < I_UP) { p0_transpose_item(p.w_up, 2048, NUP, (bf16*)(ws + WS_WUP0), 0, scr, r, lane); return; } r -= I_UP;
    if (r < I_UP) { p0_transpose_item(p.w_up + (size_t)2048 * NUP, 2048, NUP, (bf16*)(ws + WS_WUP1), 0, scr, r, lane); return; } r -= I_UP;
    if (r < I_DN) { p0_transpose_item(p.w_dn, DFF, 2048, (bf16*)(ws + WS_WDN0), 0, scr, r, lane); return; } r -= I_DN;
    p0_transpose_item(p.w_dn + (size_t)DFF * 2048, DFF, 2048, (bf16*)(ws + WS_WDN1), 0, scr, r, lane);
}
DI void p0_adaln_unit(const P& p, int unit, LAS unsigned char* lds, int tid, int wave, int lane) {
    LAS float* sc = (LAS float*)lds;
    const int layer = unit / 96, n0 = (unit % 96) * 128;
    const int ch = wave & 1, kq = wave >> 1;
    const float* wp = p.w_ada + (size_t)layer * 2048 * MODW + n0 + ch * 64 + lane;
    f32x2 acc[17];
#pragma unroll
    for (int i = 0; i < 17; ++i) acc[i] = (f32x2){0.f, 0.f};
    for (int kc = 0; kc < 4; ++kc) {
        __syncthreads();
        for (int idx = tid; idx < 34 * 512; idx += 512) { const int r = idx >> 9, kk = idx & 511;
            const float cv = (r < 2) ? p.c_prompt[r * 2048 + kc * 512 + kk] : p.c_sample[(r - 2) * 2048 + kc * 512 + kk];
            sc[kk * 36 + r] = silu_f(cv); }
        __syncthreads();
        const float* wk = wp + (size_t)(kc * 512 + kq * 128) * MODW;
#pragma unroll 4
        for (int i = 0; i < 128; ++i) {
            const float w = wk[(size_t)i * MODW];
            const LAS f32x4* s4 = (const LAS f32x4*)(sc + (kq * 128 + i) * 36);
#pragma unroll
            for (int q = 0; q < 8; ++q) { const f32x4 s = s4[q]; acc[2 * q] += (f32x2){s.x, s.y} * w; acc[2 * q + 1] += (f32x2){s.z, s.w} * w; }
            { const f32x4 s = s4[8]; acc[16] += (f32x2){s.x, s.y} * w; }
        }
    }
    __syncthreads();
    LAS float* red = (LAS float*)lds;
#pragma unroll
    for (int r = 0; r < 34; ++r) red[(kq * 34 + r) * 128 + ch * 64 + lane] = acc[r >> 1][r & 1];
    __syncthreads();
    float* mod = (float*)(p.ws + WS_MOD);
    for (int idx = tid; idx < 34 * 128; idx += 512) { const int r = idx >> 7, ci = idx & 127;
        const float v = (red[(0 * 34 + r) * 128 + ci] + red[(1 * 34 + r) * 128 + ci]) + (red[(2 * 34 + r) * 128 + ci] + red[(3 * 34 + r) * 128 + ci]) + p.b_ada[layer * MODW + n0 + ci];
        mod[((size_t)layer * NMODROW + r) * MODW + n0 + ci] = v; }
    __syncthreads();
}
DI void p0_phase(const P& p, LAS unsigned char* lds, volatile LAS unsigned* misc, int tid, int wave, int lane) {
    const int G = gridDim.x, bx = blockIdx.x;
    { GAS v4u* z = (GAS v4u*)(p.ws + WS_WGIN + (size_t)NGIN * 2048 * 2); const int n = (NGINP - NGIN) * 2048 * 2 / 16;
      for (int i = bx * 512 + tid; i < n; i += G * 512) z[i] = (v4u){0u, 0u, 0u, 0u}; }
    for (int u = bx; u < 192; u += G) p0_adaln_unit(p, u, lds, tid, wave, lane);
    gu32* q = (gu32*)(p.ws + WS_CTL) + CW_QUEUE;
    LAS float* scr = (LAS float*)(lds + wave * 16384);
    for (;;) {
        if (tid == 0) misc[0] = __hip_atomic_fetch_add(q, 32u, __ATOMIC_RELAXED, __HIP_MEMORY_SCOPE_AGENT);
        __syncthreads();
        const int base = (int)misc[0];
        __syncthreads();
        if (base >= NITEMS) break;
#pragma unroll 1
        for (int i = 0; i < 4; ++i) { const int it = base + wave * 4 + i; if (it < NITEMS) p0_item(p, it, scr, lane); }
    }
}

DI void norm_phase(const float* xp, const float* xs, const float* gain, const float* modl, int shc, bf16* H, int tid, int wave, int lane) {
    const int gw = blockIdx.x * 8 + wave, NGW = gridDim.x * 8;
    for (int row = gw; row < MP; row += NGW) {
        GAS v2u* o = (GAS v2u*)(H + (size_t)row * DM) + lane;
        if (row >= MTOK) {
#pragma unroll
            for (int j = 0; j < 8; ++j) o[64 * j] = (v2u){0u, 0u};
            continue; }
        const float* src = row < MPROMPT ? xp + (size_t)row * DM : xs + (size_t)(row - MPROMPT) * DM;
        const int mr = row < MPROMPT ? (row >> 12) : 2 + ((row - MPROMPT) >> 2);
        const GAS f32x4* s4 = (const GAS f32x4*)src + lane;
        f32x4 v[8]; float ss = 0.f;
#pragma unroll
        for (int j = 0; j < 8; ++j) { v[j] = s4[64 * j]; ss += (v[j].x * v[j].x + v[j].y * v[j].y) + (v[j].z * v[j].z + v[j].w * v[j].w); }
        const float rstd = rsqrtf(wave_sum(ss) * (1.f / DM) + NORM_EPS);
        const GAS f32x4* g4 = (const GAS f32x4*)gain + lane;
        const GAS f32x4* sh4 = (const GAS f32x4*)(modl + (size_t)mr * MODW + shc * DM) + lane;
        const GAS f32x4* sc4 = sh4 + DM / 4;
#pragma unroll
        for (int j = 0; j < 8; ++j) { const f32x4 y = v[j] * rstd * g4[64 * j] * (sc4[64 * j] + 1.f) + sh4[64 * j];
            o[64 * j] = (v2u){pkbf(y.x, y.y), pkbf(y.z, y.w)}; }
    }
}

constexpr int AT_KS = 144, AT_VT = 528;
constexpr int AT_KS_OFF = 0, AT_VT_OFF = 256 * AT_KS, AT_LUT_OFF = AT_VT_OFF + 64 * AT_VT, AT_END = AT_LUT_OFF + 8 * 132 * 4;
static_assert(AT_END <= MISC_OFF, "attention LDS");

template <bool SAMPLE>
DI void attn_tile(const P& p, LAS unsigned char* lds, int b, int kvh, int qb, int qt, int wave, int lane) {
    const int c = lane & 31, h = lane >> 5;
    const bf16* QKV = (const bf16*)(p.ws + WS_QKV);
    bf16* AO = (bf16*)(p.ws + WS_AO);
    int qrow, gq;
    if (!SAMPLE) { qrow = b * SEQ + qb * 128 + 32 * qt + c; gq = wave; } else { qrow = MPROMPT + 4 * b + (c >> 3); gq = c & 7; }
    const int head = kvh * 8 + gq;
    const float sinkv = p.sinks[head];
    bf16x8 qfr[4];
    {
        const bf16* qp = QKV + (size_t)qrow * NQKV + head * 64 + 8 * h;
        float qf[4][8]; float ss = 0.f;
#pragma unroll
        for (int s = 0; s < 4; ++s) { const v4u w = *(const GAS v4u*)(qp + 16 * s); unpack8(w, qf[s]);
#pragma unroll
            for (int j = 0; j < 8; ++j) ss += qf[s][j] * qf[s][j]; }
        ss += __shfl_xor(ss, 32);
        const float rs = rsqrtf(ss * (1.f / 64.f) + NORM_EPS) * 0.125f;
#pragma unroll
        for (int s = 0; s < 4; ++s) { float y[8];
#pragma unroll
            for (int j = 0; j < 8; ++j) y[j] = qf[s][j] * rs * p.q_norm[16 * s + 8 * h + j];
            qfr[s] = __builtin_bit_cast(bf16x8, pack8f(y)); }
    }
    const int kt0 = SAMPLE ? 0 : qt;
    f32x16 sc[5];
#pragma unroll
    for (int i = 0; i < 5; ++i) { f32x16 acc = zero16();
#pragma unroll
        for (int s = 0; s < 4; ++s) { const bf16x8 a = *(const LAS bf16x8*)(lds + AT_KS_OFF + (32 * (kt0 + i) + c) * AT_KS + (16 * s + 8 * h) * 2); acc = MFMA32(a, qfr[s], acc); }
        sc[i] = acc; }
    const LAS float* lut = (const LAS float*)(lds + AT_LUT_OFF) + gq * 132;
    float m = sinkv;
#pragma unroll
    for (int i = 0; i < 5; ++i)
#pragma unroll
        for (int r = 0; r < 16; ++r) { const int key = 32 * (kt0 + i) + crow(r, h); int dist; bool valid;
            if (!SAMPLE) { dist = 32 * qt + c + 128 - key; valid = (dist >= 0) && (dist <= 128) && (qb > 0 || key >= 128); }
            else { dist = (c >> 3) + 128 - key; valid = (dist >= 0) && (dist <= 128) && (key < 132); }
            const int dcl = dist < 0 ? 0 : (dist > 128 ? 128 : dist);
            const float v = valid ? sc[i][r] + lut[dcl] : -1e30f; sc[i][r] = v; m = fmaxf(m, v); }
    m = fmaxf(m, __shfl_xor(m, 32));
    float l = 0.f;
#pragma unroll
    for (int i = 0; i < 5; ++i)
#pragma unroll
        for (int r = 0; r < 16; ++r) { const float e = __expf(sc[i][r] - m); sc[i][r] = e; l += e; }
    l += __shfl_xor(l, 32);
    l += __expf(sinkv - m);
    f32x16 o[2]; o[0] = zero16(); o[1] = zero16();
#pragma unroll
    for (int i = 0; i < 5; ++i) {
        const bf16x8 b0 = pack_acc<0>(sc[i]), b1 = pack_acc<1>(sc[i]);
#pragma unroll
        for (int dt = 0; dt < 2; ++dt) {
            const LAS unsigned char* vp = lds + AT_VT_OFF + (32 * dt + c) * AT_VT + (32 * (kt0 + i) + 8 * h) * 2;
            const bf16x8 a0 = *(const LAS bf16x8*)(vp), a1 = *(const LAS bf16x8*)(vp + 32);
            o[dt] = MFMA32(a0, b0, o[dt]); o[dt] = MFMA32(a1, b1, o[dt]); }
    }
    const float inv = 1.f / l;
    bf16* op = AO + (size_t)qrow * DM + head * 64;
#pragma unroll
    for (int dt = 0; dt < 2; ++dt)
#pragma unroll
        for (int q4 = 0; q4 < 4; ++q4) { const int d0 = 32 * dt + 8 * q4 + 4 * h;
            *(GAS v2u*)(op + d0) = (v2u){pkbf(o[dt][4 * q4] * inv, o[dt][4 * q4 + 1] * inv), pkbf(o[dt][4 * q4 + 2] * inv, o[dt][4 * q4 + 3] * inv)}; }
}

template <bool SAMPLE>
DI void attn_unit(const P& p, int unit, LAS unsigned char* lds, int tid, int wave, int lane) {
    int b, kvh, qb;
    if (!SAMPLE) { kvh = unit & 3; qb = (unit >> 2) & 31; b = unit >> 7; } else { kvh = unit & 3; b = unit >> 2; qb = 0; }
    const bf16* QKV = (const bf16*)(p.ws + WS_QKV);
    __syncthreads();
    constexpr int NK = SAMPLE ? 160 : 256;
    for (int cidx = tid; cidx < NK * 8; cidx += 512) {
        const int key = cidx >> 3, part = cidx & 7;
        float kx[8], vx[8]; bool need_norm = false, have = false;
#pragma unroll
        for (int e = 0; e < 8; ++e) { kx[e] = 0.f; vx[e] = 0.f; }
        if (!SAMPLE) {
            const int pos = qb * 128 - 128 + key;
            if (pos >= 0) { const bf16* rp = QKV + (size_t)(b * SEQ + pos) * NQKV + 2048 + kvh * 64 + part * 8;
                unpack8(*(const GAS v4u*)rp, kx); unpack8(*(const GAS v4u*)(rp + 256), vx); need_norm = true; have = true; }
        } else {
            if (key < 128) { const size_t off = ((size_t)(b * 128 + key) * 4 + kvh) * 64 + part * 8;
                const f32x4 k0 = *(const GAS f32x4*)(p.cache_k + off), k1 = *(const GAS f32x4*)(p.cache_k + off + 4), v0 = *(const GAS f32x4*)(p.cache_v + off), v1 = *(const GAS f32x4*)(p.cache_v + off + 4);
                kx[0] = k0.x; kx[1] = k0.y; kx[2] = k0.z; kx[3] = k0.w; kx[4] = k1.x; kx[5] = k1.y; kx[6] = k1.z; kx[7] = k1.w;
                vx[0] = v0.x; vx[1] = v0.y; vx[2] = v0.z; vx[3] = v0.w; vx[4] = v1.x; vx[5] = v1.y; vx[6] = v1.z; vx[7] = v1.w; have = true; }
            else if (key < 132) { const bf16* rp = QKV + (size_t)(MPROMPT + 4 * b + key - 128) * NQKV + 2048 + kvh * 64 + part * 8;
                unpack8(*(const GAS v4u*)rp, kx); unpack8(*(const GAS v4u*)(rp + 256), vx); need_norm = true; have = true; }
        }
        float ss = 0.f;
#pragma unroll
        for (int e = 0; e < 8; ++e) ss += kx[e] * kx[e];
        ss += __shfl_xor(ss, 1); ss += __shfl_xor(ss, 2); ss += __shfl_xor(ss, 4);
        if (need_norm) { const float rs = rsqrtf(ss * (1.f / 64.f) + NORM_EPS);
#pragma unroll
            for (int e = 0; e < 8; ++e) kx[e] = kx[e] * rs * p.k_norm[part * 8 + e]; }
        *(LAS v4u*)(lds + AT_KS_OFF + key * AT_KS + part * 16) = pack8f(kx);
        const int kpos = pos64(key);
#pragma unroll
        for (int e = 0; e < 8; ++e) *(LAS unsigned short*)(lds + AT_VT_OFF + (part * 8 + e) * AT_VT + kpos * 2) = f2bf16(vx[e]);
        if (!SAMPLE) {
            if (qb == 31 && key >= 128) { const size_t off = ((size_t)(b * 128 + key - 128) * 4 + kvh) * 64 + part * 8;
                float* ok = p.out + O_WKP + off; float* ov = p.out + O_WVP + off;
                *(GAS f32x4*)ok = (f32x4){kx[0], kx[1], kx[2], kx[3]}; *(GAS f32x4*)(ok + 4) = (f32x4){kx[4], kx[5], kx[6], kx[7]};
                *(GAS f32x4*)ov = (f32x4){vx[0], vx[1], vx[2], vx[3]}; *(GAS f32x4*)(ov + 4) = (f32x4){vx[4], vx[5], vx[6], vx[7]}; }
        } else {
            if (have && key >= 4) { const size_t off = ((size_t)(b * 128 + key - 4) * 4 + kvh) * 64 + part * 8;
                float* ok = p.out + O_WKS + off; float* ov = p.out + O_WVS + off;
                *(GAS f32x4*)ok = (f32x4){kx[0], kx[1], kx[2], kx[3]}; *(GAS f32x4*)(ok + 4) = (f32x4){kx[4], kx[5], kx[6], kx[7]};
                *(GAS f32x4*)ov = (f32x4){vx[0], vx[1], vx[2], vx[3]}; *(GAS f32x4*)(ov + 4) = (f32x4){vx[4], vx[5], vx[6], vx[7]}; }
        }
    }
    for (int i = tid; i < 8 * 132; i += 512) { const int g = i / 132, d = i - g * 132; float v = 0.f;
        if (d <= 128) { int bk = d;
            if (d >= 16) { bk = 16 + (int)(__logf((float)d * (1.f / 16.f)) / 2.0794415416798357f * 16.f); bk = bk > 31 ? 31 : bk; }
            v = p.rel_table[bk * 32 + kvh * 8 + g]; }
        ((LAS float*)(lds + AT_LUT_OFF))[i] = v; }
    __syncthreads();
    if (!SAMPLE) {
#pragma unroll 1
        for (int qt = 0; qt < 4; ++qt) attn_tile<false>(p, lds, b, kvh, qb, qt, wave, lane);
    } else { if (wave == 0) attn_tile<true>(p, lds, b, kvh, 0, 0, wave, lane); }
}
DI void attn_phase(const P& p, LAS unsigned char* lds, int tid, int wave, int lane) {
    const int G = gridDim.x;
    for (int u = blockIdx.x; u < 256 + 128; u += G) { if (u < 256) attn_unit<false>(p, u, lds, tid, wave, lane); else attn_unit<true>(p, u - 256, lds, tid, wave, lane); }
    __syncthreads();
}

DI void ffn_act_phase(const P& p, int layer, int tid) {
    const bf16* U = (const bf16*)(p.ws + WS_BIG);
    bf16* ACT = (bf16*)(p.ws + WS_ACT);
    const float* cw = p.fconv_w + (size_t)layer * 3 * NUP; const float* cb = p.fconv_b + (size_t)layer * NUP;
    constexpr int NOCT = DFF / 8, NPR = (MPROMPT / 32) * NOCT, NTASK = NPR + 32 * NOCT;
    for (int task = blockIdx.x * 512 + tid; task < NTASK; task += gridDim.x * 512) {
        int row0, nrows, oct; bool samp; int sb = 0;
        if (task < NPR) { const int run = task / NOCT; oct = task - run * NOCT; row0 = run * 32; nrows = 32; samp = false; }
        else { const int t2 = task - NPR; sb = t2 / NOCT; oct = t2 - sb * NOCT; row0 = MPROMPT + 4 * sb; nrows = 4; samp = true; }
        const int cg = oct * 8, cv = DFF + oct * 8;
        float wg[3][8], wv[3][8], bg[8], bv[8];
#pragma unroll
        for (int j = 0; j < 3; ++j)
#pragma unroll
            for (int e = 0; e < 8; ++e) { wg[j][e] = cw[j * NUP + cg + e]; wv[j][e] = cw[j * NUP + cv + e]; }
#pragma unroll
        for (int e = 0; e < 8; ++e) { bg[e] = cb[cg + e]; bv[e] = cb[cv + e]; }
        float g0[8], g1[8], v0[8], v1[8];
        if (samp) { const float* h0 = p.state_fconv + ((size_t)(layer * 32 + sb) * 2) * NUP;
#pragma unroll
            for (int e = 0; e < 8; ++e) { g0[e] = h0[cg + e]; v0[e] = h0[cv + e]; g1[e] = h0[NUP + cg + e]; v1[e] = h0[NUP + cv + e]; } }
        else if ((row0 & (SEQ - 1)) == 0) {
#pragma unroll
            for (int e = 0; e < 8; ++e) { g0[e] = 0.f; g1[e] = 0.f; v0[e] = 0.f; v1[e] = 0.f; } }
        else { unpack8(*(const GAS v4u*)(U + (size_t)(row0 - 2) * NUP + cg), g0); unpack8(*(const GAS v4u*)(U + (size_t)(row0 - 2) * NUP + cv), v0);
               unpack8(*(const GAS v4u*)(U + (size_t)(row0 - 1) * NUP + cg), g1); unpack8(*(const GAS v4u*)(U + (size_t)(row0 - 1) * NUP + cv), v1); }
#pragma unroll 4
        for (int i = 0; i < nrows; ++i) {
            const int row = row0 + i; float g2[8], v2[8], a[8];
            unpack8(*(const GAS v4u*)(U + (size_t)row * NUP + cg), g2); unpack8(*(const GAS v4u*)(U + (size_t)row * NUP + cv), v2);
#pragma unroll
            for (int e = 0; e < 8; ++e) { const float yg = wg[0][e] * g0[e] + wg[1][e] * g1[e] + wg[2][e] * g2[e] + bg[e];
                const float yv = wv[0][e] * v0[e] + wv[1][e] * v1[e] + wv[2][e] * v2[e] + bv[e]; a[e] = silu_f(yg) * yv; }
            *(GAS v4u*)(ACT + (size_t)row * DFF + cg) = pack8f(a);
            int orow = -1; float* ob = nullptr;
            if (samp) { if (i >= 2) { orow = i - 2; ob = p.out + O_FCS + ((size_t)(layer * 32 + sb) * 2) * NUP; } }
            else { const int t = row & (SEQ - 1); if (t >= SEQ - 2) { orow = t - (SEQ - 2); ob = p.out + O_FCP + ((size_t)(layer * 2 + (row >> 12)) * 2) * NUP; } }
            if (orow >= 0) { float* o = ob + (size_t)orow * NUP;
                *(GAS f32x4*)(o + cg) = (f32x4){g2[0], g2[1], g2[2], g2[3]}; *(GAS f32x4*)(o + cg + 4) = (f32x4){g2[4], g2[5], g2[6], g2[7]};
                *(GAS f32x4*)(o + cv) = (f32x4){v2[0], v2[1], v2[2], v2[3]}; *(GAS f32x4*)(o + cv + 4) = (f32x4){v2[4], v2[5], v2[6], v2[7]}; }
#pragma unroll
            for (int e = 0; e < 8; ++e) { g0[e] = g1[e]; g1[e] = g2[e]; v0[e] = v1[e]; v1[e] = v2[e]; }
        }
    }
}

constexpr int CH_QK = 0, CH_QK_LD = 260;
constexpr int CH_VB = 66560, CH_VB_LD = 528;
constexpr int CH_KB = 100352, CH_QB = 117760, CH_KQ_LD = 272;
constexpr int CH_VEC = 135168;
constexpr int CH_A = 0, CH_A_LD = 68;
static_assert(CH_VEC + 1024 <= MISC_OFF && 2 * 64 * CH_A_LD * 4 <= CH_VB, "chunk LDS");

DI void gdn_chunk_unit(const P& p, int unit, LAS unsigned char* lds, int tid, int wave, int lane) {
    const int n = unit & 63, kh = (unit >> 6) & 15, b = unit >> 10;
    const bf16* PROJ = (const bf16*)(p.ws + WS_BIG);
    const float* BA = (const float*)(p.ws + WS_BA);
    const int R0 = b * SEQ + n * 64;
    LAS float* vec = (LAS float*)(lds + CH_VEC);
    __syncthreads();
    if (tid < 128) { const int hh = tid >> 6, t = tid & 63, hd = 2 * kh + hh;
        const float bv = BA[(size_t)(R0 + t) * 64 + hd], av = BA[(size_t)(R0 + t) * 64 + 32 + hd];
        const float beta = sigmoid_f(bv);
        float g = -__expf(p.a_log[hd]) * softplus_f(av + p.dt_bias[hd]);
#pragma unroll
        for (int o = 1; o < 64; o <<= 1) { const float up = __shfl_up(g, o); if (t >= o) g += up; }
        vec[hh * 64 + t] = beta; vec[128 + hh * 64 + t] = g; }
    __syncthreads();
    {
        const int pc = tid < 128 ? kh * 128 + tid : (tid < 256 ? 2048 + kh * 128 + (tid - 128) : 4096 + 2 * kh * 128 + (tid - 256));
        const float w0 = p.gconv_w[pc], w1 = p.gconv_w[8192 + pc], w2 = p.gconv_w[2 * 8192 + pc], w3 = p.gconv_w[3 * 8192 + pc];
        float x0 = 0.f, x1 = 0.f, x2 = 0.f;
        if (n > 0) { x0 = bf2f(PROJ[(size_t)(R0 - 3) * NGINP + pc]); x1 = bf2f(PROJ[(size_t)(R0 - 2) * NGINP + pc]); x2 = bf2f(PROJ[(size_t)(R0 - 1) * NGINP + pc]); }
        const int hh = (tid - 256) >> 7;
#pragma unroll 8
        for (int t = 0; t < 64; ++t) {
            const float x3 = bf2f(PROJ[(size_t)(R0 + t) * NGINP + pc]);
            float y = silu_f(w0 * x0 + w1 * x1 + w2 * x2 + w3 * x3);
            if (tid < 256) ((LAS float*)(lds + CH_QK))[t * CH_QK_LD + tid] = y;
            else { y *= vec[hh * 64 + t]; *(LAS unsigned short*)(lds + CH_VB + t * CH_VB_LD + (tid - 256) * 2) = f2bf16(y); }
            if (n == 63 && t >= 61) p.out[O_GCP + (size_t)(b * 3 + (t - 61)) * 8192 + pc] = x3;
            x0 = x1; x1 = x2; x2 = x3;
        }
    }
    __syncthreads();
    { const int row = tid >> 2, part = tid & 3, t = row & 63, isk = row >> 6;
      const LAS float* src = (const LAS float*)(lds + CH_QK) + t * CH_QK_LD + isk * 128 + part * 32;
      float x[32]; float ss = 0.f;
#pragma unroll
      for (int i = 0; i < 8; ++i) { const f32x4 v = *(const LAS f32x4*)(src + 4 * i); x[4 * i] = v.x; x[4 * i + 1] = v.y; x[4 * i + 2] = v.z; x[4 * i + 3] = v.w; ss += (v.x * v.x + v.y * v.y) + (v.z * v.z + v.w * v.w); }
      ss += __shfl_xor(ss, 1); ss += __shfl_xor(ss, 2);
      const float rs = rsqrtf(ss + NORM_EPS) * (isk ? 1.f : 0.08838834764831845f);
      LAS unsigned char* dst = lds + (isk ? CH_KB : CH_QB) + t * CH_KQ_LD + part * 64;
#pragma unroll
      for (int i = 0; i < 4; ++i) { v4u w; w.x = pkbf(x[8 * i] * rs, x[8 * i + 1] * rs); w.y = pkbf(x[8 * i + 2] * rs, x[8 * i + 3] * rs); w.z = pkbf(x[8 * i + 4] * rs, x[8 * i + 5] * rs); w.w = pkbf(x[8 * i + 6] * rs, x[8 * i + 7] * rs);
          *(LAS v4u*)(dst + 16 * i) = w; } }
    __syncthreads();
    {
        unsigned char* kq = p.ws + WS_KQ + (size_t)((b * 16 + kh) * 64 + n) * 49152;
#pragma unroll
        for (int i = 0; i < 2; ++i) { const int cc = tid + 512 * i, t = cc >> 4, ch = cc & 15;
            const int dlo = 32 * (ch >> 2) + 16 * ((ch >> 1) & 1) + 4 * (ch & 1);
            const v2u ka = *(const LAS v2u*)(lds + CH_KB + t * CH_KQ_LD + dlo * 2), kb2 = *(const LAS v2u*)(lds + CH_KB + t * CH_KQ_LD + (dlo + 8) * 2);
            const v2u qa = *(const LAS v2u*)(lds + CH_QB + t * CH_KQ_LD + dlo * 2), qb2 = *(const LAS v2u*)(lds + CH_QB + t * CH_KQ_LD + (dlo + 8) * 2);
            *(GAS v4u*)(kq + (size_t)t * 256 + ch * 16) = (v4u){ka.x, ka.y, kb2.x, kb2.y};
            *(GAS v4u*)(kq + 16384 + (size_t)t * 256 + ch * 16) = (v4u){qa.x, qa.y, qb2.x, qb2.y}; }
#pragma unroll
        for (int i = 0; i < 2; ++i) { const int cc = tid + 512 * i, d = cc >> 3, ch = cc & 7;
            const int tlo = 32 * (ch >> 2) + 16 * ((ch >> 1) & 1) + 4 * (ch & 1); unsigned short e[8];
#pragma unroll
            for (int j = 0; j < 8; ++j) e[j] = *(const LAS unsigned short*)(lds + CH_KB + (tlo + 8 * (j >> 2) + (j & 3)) * CH_KQ_LD + d * 2);
            *(GAS v4u*)(kq + 32768 + (size_t)d * 128 + ch * 16) = (v4u){(unsigned)e[0] | ((unsigned)e[1] << 16), (unsigned)e[2] | ((unsigned)e[3] << 16), (unsigned)e[4] | ((unsigned)e[5] << 16), (unsigned)e[6] | ((unsigned)e[7] << 16)}; }
#pragma unroll
        for (int i = 0; i < 4; ++i) { const int cc = tid + 512 * i, hh = cc >> 10, v = (cc >> 3) & 127, ch = cc & 7;
            unsigned char* th = p.ws + WS_TH + (size_t)((b * 32 + 2 * kh + hh) * 64 + n) * 32768;
            const int tlo = 32 * (ch >> 2) + 16 * ((ch >> 1) & 1) + 4 * (ch & 1); unsigned short e[8];
#pragma unroll
            for (int j = 0; j < 8; ++j) e[j] = *(const LAS unsigned short*)(lds + CH_VB + (tlo + 8 * (j >> 2) + (j & 3)) * CH_VB_LD + (hh * 128 + v) * 2);
            *(GAS v4u*)(th + 16384 + (size_t)v * 128 + ch * 16) = (v4u){(unsigned)e[0] | ((unsigned)e[1] << 16), (unsigned)e[2] | ((unsigned)e[3] << 16), (unsigned)e[4] | ((unsigned)e[5] << 16), (unsigned)e[6] | ((unsigned)e[7] << 16)}; }
        if (tid < 128) { const int hh = tid >> 6, t = tid & 63; float* vo = (float*)(p.ws + WS_VEC) + (size_t)((b * 32 + 2 * kh + hh) * 64 + n) * 256;
            const float beta = vec[hh * 64 + t], gc = vec[128 + hh * 64 + t], gl = vec[128 + hh * 64 + 63];
            vo[t] = __expf(gc); vo[64 + t] = beta * __expf(gc); vo[128 + t] = __expf(gl - gc); vo[192 + t] = __expf(gl); }
    }
    f32x16 accK = zero16(), accQ = zero16();
    const int hh = wave >> 2, mt = (wave >> 1) & 1, nt = wave & 1, c = lane & 31, h = lane >> 5;
#pragma unroll
    for (int s8 = 0; s8 < 8; ++s8) {
        const bf16x8 bk = *(const LAS bf16x8*)(lds + CH_KB + (32 * nt + c) * CH_KQ_LD + (16 * s8 + 8 * h) * 2);
        const bf16x8 ak = *(const LAS bf16x8*)(lds + CH_KB + (32 * mt + c) * CH_KQ_LD + (16 * s8 + 8 * h) * 2);
        const bf16x8 aq = *(const LAS bf16x8*)(lds + CH_QB + (32 * mt + c) * CH_KQ_LD + (16 * s8 + 8 * h) * 2);
        accK = MFMA32(ak, bk, accK); accQ = MFMA32(aq, bk, accQ); }
    __syncthreads();
    {
        const int j = 32 * nt + c; const float gj = vec[128 + hh * 64 + j];
        bf16* qkg = (bf16*)(p.ws + WS_TH + (size_t)((b * 32 + 2 * kh + hh) * 64 + n) * 32768 + 8192);
        LAS float* Am = (LAS float*)(lds + CH_A) + hh * 64 * CH_A_LD;
#pragma unroll
        for (int r = 0; r < 16; ++r) { const int i = 32 * mt + crow(r, h);
            const float gi = vec[128 + hh * 64 + i], bi = vec[hh * 64 + i];
            const float dec = __expf(fminf(gi - gj, 0.f));
            Am[i * CH_A_LD + j] = (i > j) ? bi * accK[r] * dec : 0.f;
            qkg[i * 64 + pos64(j)] = f2bf16((i >= j) ? accQ[r] * dec : 0.f); }
    }
    __syncthreads();
    if ((wave & 3) == 0) {
        const LAS float* Am = (const LAS float*)(lds + CH_A) + hh * 64 * CH_A_LD;
        bf16* Tg = (bf16*)(p.ws + WS_TH + (size_t)((b * 32 + 2 * kh + hh) * 64 + n) * 32768);
        const int pc = pos64(lane);
        float T[64];
#pragma unroll
        for (int i = 0; i < 64; ++i) {
            float acc = (i == lane) ? 1.f : 0.f;
#pragma unroll
            for (int jj = 0; jj < (i + 3) / 4; ++jj) { const f32x4 a = *(const LAS f32x4*)(Am + i * CH_A_LD + 4 * jj);
                if (4 * jj + 0 < i) acc -= a.x * T[4 * jj + 0];
                if (4 * jj + 1 < i) acc -= a.y * T[4 * jj + 1];
                if (4 * jj + 2 < i) acc -= a.z * T[4 * jj + 2];
                if (4 * jj + 3 < i) acc -= a.w * T[4 * jj + 3]; }
            T[i] = acc;
            Tg[i * 64 + pc] = f2bf16(acc);
        }
    }
}

constexpr int SC_KP = 0, SC_QP = 17408, SC_KT = 34816, SC_T = 53248, SC_QK = 62464, SC_VBT = 71680, SC_VEC = 90112, SC_OST = 91136, SC_OST_LD = 132, SC_END = SC_OST + 64 * SC_OST_LD * 4;
static_assert(SC_END <= MISC_OFF, "scan LDS");

DI void gdn_scan_unit(const P& p, int unit, LAS unsigned char* lds, int tid, int wave, int lane) {
    const int h_ = unit & 31, b = unit >> 5, kh = h_ >> 1;
    const int c = lane & 31, h = lane >> 5;
    const bf16* PROJ = (const bf16*)(p.ws + WS_BIG);
    bf16* GO = (bf16*)(p.ws + WS_GO);
    f32x16 S[4]; S[0] = zero16(); S[1] = zero16(); S[2] = zero16(); S[3] = zero16();
    v4u pf[20]; v4u pfv = (v4u){0u, 0u, 0u, 0u};
    const int lt = tid - 256;
#define SCAN_FETCH(nn) do { \
        const unsigned char* kq_ = p.ws + WS_KQ + (size_t)((b * 16 + kh) * 64 + (nn)) * 49152; \
        const unsigned char* th_ = p.ws + WS_TH + (size_t)((b * 32 + h_) * 64 + (nn)) * 32768; \
        _Pragma("unroll") for (int i_ = 0; i_ < 20; ++i_) { const int cc_ = lt + 256 * i_; \
            const unsigned char* src_ = (cc_ < 3072) ? kq_ + (size_t)cc_ * 16 : th_ + (size_t)(cc_ - 3072) * 16; \
            pf[i_] = *(const GAS v4u*)src_; } \
        if (lt < 64) pfv = *(const GAS v4u*)((const unsigned char*)(p.ws + WS_VEC) + (size_t)((b * 32 + h_) * 64 + (nn)) * 1024 + lt * 16); } while (0)
#define SCAN_PUT() do { \
        _Pragma("unroll") for (int i_ = 0; i_ < 20; ++i_) { const int cc_ = lt + 256 * i_; int off_; \
            if (cc_ < 1024) off_ = SC_KP + (cc_ >> 4) * 272 + (cc_ & 15) * 16; \
            else if (cc_ < 2048) off_ = SC_QP + ((cc_ - 1024) >> 4) * 272 + (cc_ & 15) * 16; \
            else if (cc_ < 3072) off_ = SC_KT + ((cc_ - 2048) >> 3) * 144 + (cc_ & 7) * 16; \
            else if (cc_ < 3584) off_ = SC_T + ((cc_ - 3072) >> 3) * 144 + (cc_ & 7) * 16; \
            else if (cc_ < 4096) off_ = SC_QK + ((cc_ - 3584) >> 3) * 144 + (cc_ & 7) * 16; \
            else off_ = SC_VBT + ((cc_ - 4096) >> 3) * 144 + (cc_ & 7) * 16; \
            *(LAS v4u*)(lds + off_) = pf[i_]; } \
        if (lt < 64) *(LAS v4u*)(lds + SC_VEC + lt * 16) = pfv; } while (0)
    __syncthreads();
    const LAS float* vec = (const LAS float*)(lds + SC_VEC);
    if (wave >= 4) {
        SCAN_FETCH(0); SCAN_PUT();
        __syncthreads();
#pragma unroll 1
        for (int n = 0; n < 64; ++n) {
            if (n + 1 < 64) SCAN_FETCH(n + 1);
            __syncthreads();
            if (n + 1 < 64) SCAN_PUT();
            __syncthreads();
        }
    } else {
        __syncthreads();
#pragma unroll 1
        for (int n = 0; n < 64; ++n) {
            {
            const int w = wave;
            bf16x8 Sb[4][2];
#pragma unroll
            for (int dt = 0; dt < 4; ++dt) { Sb[dt][0] = pack_acc<0>(S[dt]); Sb[dt][1] = pack_acc<1>(S[dt]); }
            f32x16 ks[2], qs[2];
#pragma unroll
            for (int tt = 0; tt < 2; ++tt) { ks[tt] = zero16(); qs[tt] = zero16();
#pragma unroll
                for (int dt = 0; dt < 4; ++dt)
#pragma unroll
                    for (int s = 0; s < 2; ++s) {
                        const bf16x8 ak = *(const LAS bf16x8*)(lds + SC_KP + (32 * tt + c) * 272 + (32 * dt + 16 * s + 8 * h) * 2);
                        const bf16x8 aq = *(const LAS bf16x8*)(lds + SC_QP + (32 * tt + c) * 272 + (32 * dt + 16 * s + 8 * h) * 2);
                        ks[tt] = MFMA32(ak, Sb[dt][s], ks[tt]); qs[tt] = MFMA32(aq, Sb[dt][s], qs[tt]); } }
            bf16x8 tb[2][2];
#pragma unroll
            for (int tt = 0; tt < 2; ++tt) {
#pragma unroll
                for (int q4 = 0; q4 < 4; ++q4) { const f32x4 bg = *(const LAS f32x4*)(vec + 64 + 32 * tt + 8 * q4 + 4 * h);
                    ks[tt][4 * q4] *= -bg.x; ks[tt][4 * q4 + 1] *= -bg.y; ks[tt][4 * q4 + 2] *= -bg.z; ks[tt][4 * q4 + 3] *= -bg.w; }
                tb[tt][0] = pack_acc<0>(ks[tt]); tb[tt][1] = pack_acc<1>(ks[tt]); }
            f32x16 vn[2];
#pragma unroll
            for (int tt = 0; tt < 2; ++tt) { vn[tt] = zero16();
#pragma unroll
                for (int st = 0; st <= tt; ++st)
#pragma unroll
                    for (int s = 0; s < 2; ++s) {
                        const bf16x8 at = *(const LAS bf16x8*)(lds + SC_T + (32 * tt + c) * 144 + (32 * st + 16 * s + 8 * h) * 2);
                        const bf16x8 bv = *(const LAS bf16x8*)(lds + SC_VBT + (32 * w + c) * 144 + (32 * st + 16 * s + 8 * h) * 2);
                        vn[tt] = MFMA32(at, tb[st][s], vn[tt]); vn[tt] = MFMA32(at, bv, vn[tt]); } }
            bf16x8 vb[2][2];
#pragma unroll
            for (int tt = 0; tt < 2; ++tt) { vb[tt][0] = pack_acc<0>(vn[tt]); vb[tt][1] = pack_acc<1>(vn[tt]); }
#pragma unroll
            for (int tt = 0; tt < 2; ++tt) {
#pragma unroll
                for (int q4 = 0; q4 < 4; ++q4) { const f32x4 eg = *(const LAS f32x4*)(vec + 32 * tt + 8 * q4 + 4 * h);
                    qs[tt][4 * q4] *= eg.x; qs[tt][4 * q4 + 1] *= eg.y; qs[tt][4 * q4 + 2] *= eg.z; qs[tt][4 * q4 + 3] *= eg.w; }
#pragma unroll
                for (int st = 0; st <= tt; ++st)
#pragma unroll
                    for (int s = 0; s < 2; ++s) {
                        const bf16x8 aqk = *(const LAS bf16x8*)(lds + SC_QK + (32 * tt + c) * 144 + (32 * st + 16 * s + 8 * h) * 2);
                        qs[tt] = MFMA32(aqk, vb[st][s], qs[tt]); }
#pragma unroll
                for (int r = 0; r < 16; ++r) ((LAS float*)(lds + SC_OST))[(32 * tt + crow(r, h)) * SC_OST_LD + 32 * w + c] = qs[tt][r];
            }
            const float dec = vec[192];
            bf16x8 vs[2][2];
#pragma unroll
            for (int tt = 0; tt < 2; ++tt) {
#pragma unroll
                for (int q4 = 0; q4 < 4; ++q4) { const f32x4 e4 = *(const LAS f32x4*)(vec + 128 + 32 * tt + 8 * q4 + 4 * h);
                    vn[tt][4 * q4] *= e4.x; vn[tt][4 * q4 + 1] *= e4.y; vn[tt][4 * q4 + 2] *= e4.z; vn[tt][4 * q4 + 3] *= e4.w; }
                vs[tt][0] = pack_acc<0>(vn[tt]); vs[tt][1] = pack_acc<1>(vn[tt]); }
#pragma unroll
            for (int dt = 0; dt < 4; ++dt) {
#pragma unroll
                for (int r = 0; r < 16; ++r) S[dt][r] *= dec;
#pragma unroll
                for (int tt = 0; tt < 2; ++tt)
#pragma unroll
                    for (int s = 0; s < 2; ++s) {
                        const bf16x8 akt = *(const LAS bf16x8*)(lds + SC_KT + (32 * dt + c) * 144 + (32 * tt + 16 * s + 8 * h) * 2);
                        S[dt] = MFMA32(akt, vs[tt][s], S[dt]); } }
            }
            __syncthreads();
            {
            const int t = tid >> 2, part = tid & 3; const int row = b * SEQ + n * 64 + t;
            const LAS float* os = (const LAS float*)(lds + SC_OST) + t * SC_OST_LD + part * 32;
            float x[32]; float ss = 0.f;
#pragma unroll
            for (int i = 0; i < 8; ++i) { const f32x4 v = *(const LAS f32x4*)(os + 4 * i); x[4 * i] = v.x; x[4 * i + 1] = v.y; x[4 * i + 2] = v.z; x[4 * i + 3] = v.w; ss += (v.x * v.x + v.y * v.y) + (v.z * v.z + v.w * v.w); }
            ss += __shfl_xor(ss, 1); ss += __shfl_xor(ss, 2);
            const float rs = rsqrtf(ss * (1.f / 128.f) + NORM_EPS);
            const bf16* zp = PROJ + (size_t)row * NGINP + 8192 + h_ * 128 + part * 32;
            bf16* gp = GO + (size_t)row * GVAL + h_ * 128 + part * 32;
#pragma unroll
            for (int i = 0; i < 4; ++i) { float z[8], y[8]; unpack8(*(const GAS v4u*)(zp + 8 * i), z);
#pragma unroll
                for (int e = 0; e < 8; ++e) y[e] = x[8 * i + e] * rs * p.out_norm[part * 32 + 8 * i + e] * silu_f(z[e]);
                *(GAS v4u*)(gp + 8 * i) = pack8f(y); }
            }
            __syncthreads();
        }
    }
    if (wave < 4) { float* so = p.out + O_GDNP + (size_t)(b * 32 + h_) * 128 * 128;
#pragma unroll
        for (int dt = 0; dt < 4; ++dt)
#pragma unroll
            for (int r = 0; r < 16; ++r) so[(size_t)(32 * dt + crow(r, h)) * 128 + 32 * wave + c] = S[dt][r]; }
#undef SCAN_FETCH
#undef SCAN_PUT
}

DI void gdn_sample_unit(const P& p, int unit, LAS unsigned char* lds, int tid, int wave, int lane) {
    const int h_ = unit & 31, b = unit >> 5, kh = h_ >> 1;
    const bf16* PROJ = (const bf16*)(p.ws + WS_BIG);
    const float* BA = (const float*)(p.ws + WS_BA);
    bf16* GO = (bf16*)(p.ws + WS_GO);
    LAS float* L = (LAS float*)lds;
    __syncthreads();
    if (tid < 384) { const int which = tid >> 7, i = tid & 127;
        const int pc = which == 0 ? kh * 128 + i : (which == 1 ? 2048 + kh * 128 + i : 4096 + h_ * 128 + i);
        float x[7];
#pragma unroll
        for (int j = 0; j < 3; ++j) x[j] = p.state_gconv[(size_t)(b * 3 + j) * 8192 + pc];
#pragma unroll
        for (int t = 0; t < 4; ++t) x[3 + t] = bf2f(PROJ[(size_t)(MPROMPT + 4 * b + t) * NGINP + pc]);
        const float w0 = p.gconv_w[pc], w1 = p.gconv_w[8192 + pc], w2 = p.gconv_w[2 * 8192 + pc], w3 = p.gconv_w[3 * 8192 + pc];
#pragma unroll
        for (int t = 0; t < 4; ++t) L[which * 512 + t * 128 + i] = silu_f(w0 * x[t] + w1 * x[t + 1] + w2 * x[t + 2] + w3 * x[t + 3]);
#pragma unroll
        for (int r = 0; r < 3; ++r) p.out[O_GCS + (size_t)(b * 3 + r) * 8192 + pc] = x[4 + r];
    } else if (tid < 388) { const int t = tid - 384; const size_t row = MPROMPT + 4 * b + t;
        const float bv = BA[row * 64 + h_], av = BA[row * 64 + 32 + h_];
        L[2560 + t] = sigmoid_f(bv); L[2564 + t] = __expf(-__expf(p.a_log[h_]) * softplus_f(av + p.dt_bias[h_])); }
    __syncthreads();
    { LAS float* r = L + (wave < 4 ? 0 : 512) + (wave & 3) * 128; const float a = r[lane], c2 = r[lane + 64];
      const float rs = rsqrtf(wave_sum(a * a + c2 * c2) + NORM_EPS) * (wave < 4 ? 0.08838834764831845f : 1.f);
      r[lane] = a * rs; r[lane + 64] = c2 * rs; }
    __syncthreads();
    const int v = tid & 127, dg = tid >> 7;
    float S[32];
    const float* s0 = p.state_gdn + ((size_t)(b * 32 + h_) * 128 + 32 * dg) * 128 + v;
#pragma unroll
    for (int i = 0; i < 32; ++i) S[i] = s0[(size_t)i * 128];
#pragma unroll 1
    for (int t = 0; t < 4; ++t) {
        const float eg = L[2564 + t], beta = L[2560 + t];
        const LAS float* kk = L + 512 + t * 128 + 32 * dg; const LAS float* qq = L + t * 128 + 32 * dg;
        float part = 0.f;
#pragma unroll
        for (int i = 0; i < 32; ++i) { S[i] *= eg; part += S[i] * kk[i]; }
        L[1536 + dg * 128 + v] = part;
        __syncthreads();
        const float kv = (L[1536 + v] + L[1536 + 128 + v]) + (L[1536 + 256 + v] + L[1536 + 384 + v]);
        const float vnew = beta * (L[1024 + t * 128 + v] - kv);
        __syncthreads();
        float part2 = 0.f;
#pragma unroll
        for (int i = 0; i < 32; ++i) { S[i] += kk[i] * vnew; part2 += S[i] * qq[i]; }
        L[1536 + dg * 128 + v] = part2;
        __syncthreads();
        if (dg == 0) L[2048 + t * 128 + v] = (L[1536 + v] + L[1536 + 128 + v]) + (L[1536 + 256 + v] + L[1536 + 384 + v]);
        __syncthreads();
    }
    float* so = p.out + O_GDNS + ((size_t)(b * 32 + h_) * 128 + 32 * dg) * 128 + v;
#pragma unroll
    for (int i = 0; i < 32; ++i) so[(size_t)i * 128] = S[i];
    if (wave < 4) { const int t = wave; const size_t row = MPROMPT + 4 * b + t;
        const float o1 = L[2048 + t * 128 + lane], o2 = L[2048 + t * 128 + lane + 64];
        const float rs = rsqrtf(wave_sum(o1 * o1 + o2 * o2) * (1.f / 128.f) + NORM_EPS);
        const float z1 = bf2f(PROJ[row * NGINP + 8192 + h_ * 128 + lane]), z2 = bf2f(PROJ[row * NGINP + 8192 + h_ * 128 + lane + 64]);
        GO[row * GVAL + h_ * 128 + lane] = f2bf16(o1 * rs * p.out_norm[lane] * silu_f(z1));
        GO[row * GVAL + h_ * 128 + lane + 64] = f2bf16(o2 * rs * p.out_norm[lane + 64] * silu_f(z2)); }
}

#ifndef MK_N_LAUNCHES
#define MK_N_LAUNCHES 1
#endif
constexpr int N_PHASES = 18;
struct Args { const float* in[29]; float* out; unsigned char* ws; int ph_lo, ph_hi; };
static_assert(sizeof(Args) == 31 * 8 + 8, "Args has no padding");

__global__ void __launch_bounds__(512, 2) hybrid_fwd(Args args) {
    extern __shared__ __attribute__((aligned(16))) unsigned char lds_raw[];
    LAS unsigned char* lds = (LAS unsigned char*)lds_raw;
    volatile LAS unsigned* MISC = (volatile LAS unsigned*)(lds + MISC_OFF);
    const int tid = threadIdx.x, lane = tid & 63, wave = __builtin_amdgcn_readfirstlane(tid >> 6);
    const int G = gridDim.x;
    P p;
    p.x_prompt = args.in[0]; p.x_sample = args.in[1]; p.c_prompt = args.in[2]; p.c_sample = args.in[3]; p.cache_k = args.in[4]; p.cache_v = args.in[5];
    p.state_gdn = args.in[6]; p.state_gconv = args.in[7]; p.state_fconv = args.in[8]; p.rel_table = args.in[9]; p.w_ada = args.in[10]; p.b_ada = args.in[11];
    p.norm_mix = args.in[12]; p.norm_ffn = args.in[13]; p.w_qkv = args.in[14]; p.q_norm = args.in[15]; p.k_norm = args.in[16]; p.sinks = args.in[17]; p.w_o = args.in[18];
    p.w_gin = args.in[19]; p.gconv_w = args.in[20]; p.a_log = args.in[21]; p.dt_bias = args.in[22]; p.out_norm = args.in[23]; p.w_gout = args.in[24];
    p.w_up = args.in[25]; p.fconv_w = args.in[26]; p.fconv_b = args.in[27]; p.w_dn = args.in[28];
    p.out = args.out; p.ws = args.ws;
    unsigned char* ws = args.ws;
    for (int u = tid; u < (LDS_BYTES - MISC_OFF) / 4; u += 512) ((LAS unsigned*)(lds + MISC_OFF))[u] = 0u;
    __syncthreads();
    XcdBarrier bar; bar.bar = (unsigned*)(ws + WS_CTL) + CW_BAR; bar.x = 0; bar.st = nullptr;
    if (MK_N_LAUNCHES == 1) bar = xcd_barrier_post((unsigned*)(ws + WS_CTL) + CW_BAR, MISC + 8);
    const int lo = args.ph_lo, hi = args.ph_hi;
#define IN(k) (lo <= (k) && (k) < hi)
#define SEAM(k) do { if (IN(k) && IN((k) + 1)) xcd_barrier(bar); } while (0)
    float* XR = p.out + O_Y;
    const float* mod = (const float*)(ws + WS_MOD);
    bf16* H = (bf16*)(ws + WS_H);

    if (IN(0)) { p0_phase(p, lds, MISC, tid, wave, lane); } SEAM(0);
    if (IN(1)) { norm_phase(p.x_prompt, p.x_sample, p.norm_mix, mod, 0, H, tid, wave, lane); } SEAM(1);
    if (IN(2)) { pg8::Gemm g{H, (const bf16*)(ws + WS_WQKV), MP, NQKV, DM}; pg8::StaticOrder S; S.init(MP, NQKV, G, (int)blockIdx.x);
        pg8::EpiStore E{(bf16*)(ws + WS_QKV), NQKV, nullptr, -1};
        pg8::gemm_phase<pg8::EpiStore, pg8::StaticOrder, true, true>(lds, g, S, E); } SEAM(2);
    if (IN(3)) { attn_phase(p, lds, tid, wave, lane); } SEAM(3);
    if (IN(4)) { pg8::Gemm g{(const bf16*)(ws + WS_AO), (const bf16*)(ws + WS_WO), MP, DM, DM}; pg8::StaticOrder S; S.init(MP, DM, G, (int)blockIdx.x);
        pg8::EpiResid E{p.x_prompt, p.x_sample, XR, mod + 2 * DM};
        pg8::gemm_phase<pg8::EpiResid, pg8::StaticOrder, true, true>(lds, g, S, E); } SEAM(4);
    if (IN(5)) { norm_phase(XR, XR + (size_t)MPROMPT * DM, p.norm_ffn, mod, 3, H, tid, wave, lane); } SEAM(5);
    if (IN(6)) { pg8::Gemm g{H, (const bf16*)(ws + WS_WUP0), MP, NUP, DM}; pg8::StaticOrder S; S.init(MP, NUP, G, (int)blockIdx.x);
        pg8::EpiStore E{(bf16*)(ws + WS_BIG), NUP, nullptr, -1};
        pg8::gemm_phase<pg8::EpiStore, pg8::StaticOrder, true, true>(lds, g, S, E); } SEAM(6);
    if (IN(7)) { ffn_act_phase(p, 0, tid); } SEAM(7);
    if (IN(8)) { pg8::Gemm g{(const bf16*)(ws + WS_ACT), (const bf16*)(ws + WS_WDN0), MP, DM, DFF}; pg8::StaticOrder S; S.init(MP, DM, G, (int)blockIdx.x);
        pg8::EpiResid E{XR, XR + (size_t)MPROMPT * DM, XR, mod + 5 * DM};
        pg8::gemm_phase<pg8::EpiResid, pg8::StaticOrder, true, true>(lds, g, S, E); } SEAM(8);
    const float* mod1 = mod + (size_t)NMODROW * MODW;
    if (IN(9)) { norm_phase(XR, XR + (size_t)MPROMPT * DM, p.norm_mix + DM, mod1, 0, H, tid, wave, lane); } SEAM(9);
    if (IN(10)) { pg8::Gemm g{H, (const bf16*)(ws + WS_WGIN), MP, NGINP, DM}; pg8::StaticOrder S; S.init(MP, NGINP, G, (int)blockIdx.x);
        pg8::EpiStore E{(bf16*)(ws + WS_BIG), NGINP, (float*)(ws + WS_BA), 48};
        pg8::gemm_phase<pg8::EpiStore, pg8::StaticOrder, true, true>(lds, g, S, E); } SEAM(10);
    if (IN(11)) { for (int u = blockIdx.x; u < 2048; u += G) gdn_chunk_unit(p, u, lds, tid, wave, lane); __syncthreads(); } SEAM(11);
    if (IN(12)) {
        if (G >= 128) { if ((int)blockIdx.x < 64) gdn_scan_unit(p, (int)blockIdx.x, lds, tid, wave, lane);
                        else for (int u = (int)blockIdx.x - 64; u < 1024; u += G - 64) gdn_sample_unit(p, u, lds, tid, wave, lane); }
        else { for (int u = blockIdx.x; u < 64; u += G) gdn_scan_unit(p, u, lds, tid, wave, lane);
               for (int u = blockIdx.x; u < 1024; u += G) gdn_sample_unit(p, u, lds, tid, wave, lane); }
        __syncthreads(); } SEAM(12);
    if (IN(13)) { pg8::Gemm g{(const bf16*)(ws + WS_GO), (const bf16*)(ws + WS_WGOUT), MP, DM, GVAL}; pg8::StaticOrder S; S.init(MP, DM, G, (int)blockIdx.x);
        pg8::EpiResid E{XR, XR + (size_t)MPROMPT * DM, XR, mod1 + 2 * DM};
        pg8::gemm_phase<pg8::EpiResid, pg8::StaticOrder, true, true>(lds, g, S, E); } SEAM(13);
    if (IN(14)) { norm_phase(XR, XR + (size_t)MPROMPT * DM, p.norm_ffn + DM, mod1, 3, H, tid, wave, lane); } SEAM(14);
    if (IN(15)) { pg8::Gemm g{H, (const bf16*)(ws + WS_WUP1), MP, NUP, DM}; pg8::StaticOrder S; S.init(MP, NUP, G, (int)blockIdx.x);
        pg8::EpiStore E{(bf16*)(ws + WS_BIG), NUP, nullptr, -1};
        pg8::gemm_phase<pg8::EpiStore, pg8::StaticOrder, true, true>(lds, g, S, E); } SEAM(15);
    if (IN(16)) { ffn_act_phase(p, 1, tid); } SEAM(16);
    if (IN(17)) { pg8::Gemm g{(const bf16*)(ws + WS_ACT), (const bf16*)(ws + WS_WDN1), MP, DM, DFF}; pg8::StaticOrder S; S.init(MP, DM, G, (int)blockIdx.x);
        pg8::EpiResid E{XR, XR + (size_t)MPROMPT * DM, XR, mod1 + 5 * DM};
        pg8::gemm_phase<pg8::EpiResid, pg8::StaticOrder, true, true>(lds, g, S, E); }
#undef IN
#undef SEAM
}

extern "C" void kernel_launch(void* const* d_in, const int* in_sizes, int n_in, void* d_out, int out_size, void* d_ws, size_t ws_size, hipStream_t stream) {
    static int grid = 0;
    if (grid == 0) {
        if (n_in != 29 || (size_t)out_size != O_END || ws_size < WS_END) { fprintf(stderr, "kernel_launch: unexpected sizes: n_in %d out %d ws %zu (need 29, %zu, >= %zu)\n", n_in, out_size, ws_size, (size_t)O_END, (size_t)WS_END); grid = -1; return; }
        int dev = 0, cus = 0, per_cu = 0;
        if (hipGetDevice(&dev) != hipSuccess || hipDeviceGetAttribute(&cus, hipDeviceAttributeMultiprocessorCount, dev) != hipSuccess) { grid = -1; return; }
        if (hipFuncSetAttribute((const void*)hybrid_fwd, hipFuncAttributeMaxDynamicSharedMemorySize, LDS_BYTES) != hipSuccess) { fprintf(stderr, "kernel_launch: hipFuncSetAttribute failed\n"); grid = -1; return; }
        if (hipOccupancyMaxActiveBlocksPerMultiprocessor(&per_cu, (const void*)hybrid_fwd, 512, LDS_BYTES) != hipSuccess || per_cu < 1) { fprintf(stderr, "kernel_launch: occupancy query says %d\n", per_cu); per_cu = 1; }
        (void)hipGetLastError();
        grid = cus;
    }
    if (grid < 0) return;
    (void)hipMemsetAsync((char*)d_ws + WS_CTL, 0, CTL_ZERO_BYTES, stream);
    Args a{};
    for (int i = 0; i < 29; ++i) a.in[i] = (const float*)d_in[i];
    a.out = (float*)d_out; a.ws = (unsigned char*)d_ws;
    if (MK_N_LAUNCHES == 1) { a.ph_lo = 0; a.ph_hi = N_PHASES; hipLaunchKernelGGL(hybrid_fwd, dim3(grid), dim3(512), LDS_BYTES, stream, a); }
    else { for (int k = 0; k < N_PHASES; ++k) { a.ph_lo = k; a.ph_hi = k + 1; hipLaunchKernelGGL(hybrid_fwd, dim3(grid), dim3(512), LDS_BYTES, stream, a); } }
}
```

```cpp
#include <hip/hip_runtime.h>
#include <cstdio>
#include <cstdint>
#define PROBE_MASK 0u
namespace pg8 {
#define PG8_LAS __attribute__((address_space(3)))
typedef unsigned short bf16_t;
typedef short bf16x8 __attribute__((ext_vector_type(8)));
typedef float f32x4 __attribute__((ext_vector_type(4)));
typedef unsigned u32x4 __attribute__((ext_vector_type(4)));
constexpr int BM = 256, BK = 64, HALF = 128, HTB = HALF * BK * 2  , STAGE_BYTES = 8 * HTB, NXCD = 8, WGM = 8;

__host__ __device__ __forceinline__ int lds_byte(int r, int c) { const int st = (r >> 4) * 2 + (c >> 5), rr = r & 15, cc = c & 31, ob = rr * 64 + cc * 2; return st * 1024 + (ob ^ (((ob >> 9) & 1) << 5)); }
__host__ __device__ __forceinline__ void stage_rc(int b, int& R, int& C) { const int st = b / 1024, sb = b % 1024, swz = sb ^ (((sb >> 9) & 1) << 5); R = (st >> 1) * 16 + swz / 64; C = (st & 1) * 32 + (swz % 64) / 2; }
__host__ __device__ __forceinline__ int perm32(int rho) { const int n = rho >> 4, i = rho & 15; return 8 * (i >> 2) + 4 * n + (i & 3); }

struct Unit { int pm, pn, ui; };
struct Gemm { const bf16_t* A; const bf16_t* Bt; int M, N, K; };

struct StaticOrder {
    int nM, nN, nwg, G, c;
    __host__ __device__ void init(int M, int N, int G_, int c_) { nM = M / BM; nN = N / BM; nwg = nM * nN; G = G_; c = c_; }
    __host__ __device__ bool next(int i, Unit& u) const {
        const long L = (long)i * G + c; if (L >= nwg) return false;
        int wgid = (int)L; { const int q = nwg / NXCD, r = nwg % NXCD, xcd = wgid % NXCD, off = wgid / NXCD; wgid = (xcd < r ? xcd * (q + 1) : r * (q + 1) + (xcd - r) * q) + off; }
        const int nig = WGM * nN, gid = wgid / nig, fm = gid * WGM, gsz = (nM - fm) < WGM ? (nM - fm) : WGM;
        u.pm = fm + ((wgid % nig) % gsz); u.pn = (wgid % nig) / gsz; return true;
    }
    __device__ __forceinline__ void a_ready(const Unit&) const {}
    __device__ __forceinline__ void done(const Unit&) const {}
};

__device__ __forceinline__ unsigned cvt_pk_bf16(float lo, float hi) { unsigned r; asm volatile("v_cvt_pk_bf16_f32 %0, %1, %2" : "=v"(r) : "v"(lo), "v"(hi)); return r; }
typedef float f32x2 __attribute__((ext_vector_type(2)));
template <class Epi, class Sched, bool ALIGN_EPI = false, bool SP2 = false>
__device__ __forceinline__ void gemm_phase(PG8_LAS unsigned char* lds, const Gemm g, const Sched& S, const Epi& E) {
    const int tid = threadIdx.x, wid = __builtin_amdgcn_readfirstlane(tid >> 6), lane = tid & 63, wr = wid >> 2, wc = wid & 3, fr = lane & 15, fq = lane >> 4;
    const int K = g.K, nt = K / BK;
    unsigned voffA[2], voffB[2];
#pragma unroll
    for (int i = 0; i < 2; ++i) { int R, C; stage_rc(tid * 16 + i * 8192, R, C); const int Rb = Epi::PERM ? ((R & ~31) + perm32(R & 31)) : R;
        voffA[i] = (unsigned)(R * K + C) * 2u; voffB[i] = (unsigned)(Rb * K + C) * 2u; }
    const size_t kstep = (size_t)(BK * 2);
    const size_t hstep = (size_t)HALF * K * 2;
    const size_t tstep = 2 * hstep;
    const unsigned ldsw = (unsigned)wid * 1024u;
    const int aoff = lds_byte(wr * 64 + fr, fq * 8), boff = lds_byte(wc * 32 + fr, fq * 8);
#define PG8_SA(b, h) (((b) * 2 + (h)) * HTB)
#define PG8_SB(b, h) ((4 + (b) * 2 + (h)) * HTB)
#define PG8_STAGE(bufoff, gbase, voff) do { _Pragma("unroll") for (int _i = 0; _i < 2; ++_i) \
        __builtin_amdgcn_global_load_lds((const unsigned*)((const char*)(gbase) + (voff)[_i]), (PG8_LAS unsigned*)(lds + (bufoff) + ldsw + _i * 8192), 16, 0, 0); } while (0)
#define PG8_LDA(dst, b, h) do { _Pragma("unroll") for (int m = 0; m < 4; ++m) _Pragma("unroll") for (int k = 0; k < 2; ++k) dst[m][k] = *(const PG8_LAS bf16x8*)(lds + PG8_SA(b, h) + aoff + m * 2048 + k * 1024); } while (0)
#define PG8_LDB(dst, b, h) do { _Pragma("unroll") for (int n = 0; n < 2; ++n) _Pragma("unroll") for (int k = 0; k < 2; ++k) dst[n][k] = *(const PG8_LAS bf16x8*)(lds + PG8_SB(b, h) + boff + n * 2048 + k * 1024); } while (0)
#define PG8_MMA(ai, bj, At, Bt) do { __builtin_amdgcn_s_setprio(1); _Pragma("unroll") for (int m = 0; m < 4; ++m) _Pragma("unroll") for (int n = 0; n < 2; ++n) _Pragma("unroll") for (int k = 0; k < 2; ++k) \
        acc[ai][bj][m][n] = __builtin_amdgcn_mfma_f32_16x16x32_bf16(Bt[n][k], At[m][k], acc[ai][bj][m][n], 0, 0, 0); __builtin_amdgcn_s_setprio(0); } while (0)
#define PG8_WAIT_V(n) asm volatile("s_waitcnt vmcnt(" #n ")" ::: "memory")
#define PG8_WAIT_L(n) asm volatile("s_waitcnt lgkmcnt(" #n ")" ::: "memory")
#define PG8_BAR __builtin_amdgcn_s_barrier()
#define PG8_SCHED __builtin_amdgcn_sched_barrier(0)
    Unit cur, nxt; int ui = 0;
    if (!S.next(0, cur)) return;
    f32x4 acc[2][2][4][2];
#pragma unroll
    for (int a = 0; a < 2; ++a)
#pragma unroll
        for (int b = 0; b < 2; ++b)
#pragma unroll
            for (int m = 0; m < 4; ++m)
#pragma unroll
                for (int n = 0; n < 2; ++n) acc[a][b][m][n] = (f32x4){0.f, 0.f, 0.f, 0.f};
    bf16x8 At[4][2], B0[2][2], B1[2][2];
    const char* cA = (const char*)g.A + (size_t)cur.pm * tstep; const char* cB = (const char*)g.Bt + (size_t)cur.pn * tstep;
    S.a_ready(cur);
    if constexpr (SP2) {
        PG8_STAGE(PG8_SB(0, 0), cB, voffB); PG8_STAGE(PG8_SB(0, 1), cB + hstep, voffB); PG8_STAGE(PG8_SA(0, 0), cA, voffA); PG8_STAGE(PG8_SA(0, 1), cA + hstep, voffA);
        if (wr == 1) PG8_BAR;
        PG8_WAIT_V(2); PG8_BAR;
        PG8_STAGE(PG8_SB(1, 0), cB + kstep, voffB); PG8_STAGE(PG8_SA(1, 0), cA + kstep, voffA); PG8_STAGE(PG8_SB(1, 1), cB + hstep + kstep, voffB);
        PG8_WAIT_V(6); PG8_BAR;
    } else {
        PG8_STAGE(PG8_SB(0, 0), cB, voffB); PG8_STAGE(PG8_SA(0, 0), cA, voffA); PG8_STAGE(PG8_SB(0, 1), cB + hstep, voffB); PG8_STAGE(PG8_SA(0, 1), cA + hstep, voffA);
        if (wr == 1) PG8_BAR;
        PG8_WAIT_V(4); PG8_BAR;
        PG8_STAGE(PG8_SB(1, 0), cB + kstep, voffB); PG8_STAGE(PG8_SA(1, 0), cA + kstep, voffA); PG8_STAGE(PG8_SB(1, 1), cB + hstep + kstep, voffB);
        PG8_WAIT_V(6); PG8_BAR;
    }
    for (;;) {
        const bool has_next = S.next(ui + 1, nxt);
        const char* nA = has_next ? (const char*)g.A + (size_t)nxt.pm * tstep : cA; const char* nB = has_next ? (const char*)g.Bt + (size_t)nxt.pn * tstep : cB;
        for (int t = 0; t < nt; t += 2) {
            const bool last = (t == nt - 2);
            const char* a1 = cA + (size_t)(t + 1) * kstep;
            const char* a2 = last ? nA : cA + (size_t)(t + 2) * kstep; const char* b2 = last ? nB : cB + (size_t)(t + 2) * kstep;
            const char* a3 = a2 + kstep; const char* b3 = b2 + kstep;
            if (last && has_next) S.a_ready(nxt);
            if constexpr (SP2) {
            PG8_LDB(B0, 0, 0); PG8_LDB(B1, 0, 1); PG8_SCHED; PG8_LDA(At, 0, 0); PG8_STAGE(PG8_SA(1, 1), a1 + hstep, voffA);
            PG8_WAIT_V(8); PG8_WAIT_L(0); PG8_BAR; PG8_MMA(0, 0, At, B0); PG8_MMA(0, 1, At, B1); PG8_BAR; PG8_SCHED;
            PG8_LDA(At, 0, 1); PG8_STAGE(PG8_SB(0, 0), b2, voffB); PG8_STAGE(PG8_SB(0, 1), b2 + hstep, voffB); PG8_STAGE(PG8_SA(0, 0), a2, voffA);
            PG8_WAIT_V(8); PG8_WAIT_L(0); PG8_BAR; PG8_MMA(1, 0, At, B0); PG8_MMA(1, 1, At, B1); PG8_BAR; PG8_SCHED;
            PG8_LDB(B0, 1, 0); PG8_LDB(B1, 1, 1); PG8_SCHED; PG8_LDA(At, 1, 0); PG8_STAGE(PG8_SA(0, 1), a2 + hstep, voffA);
            PG8_WAIT_V(8); PG8_WAIT_L(0); PG8_BAR; PG8_MMA(0, 0, At, B0); PG8_MMA(0, 1, At, B1); PG8_BAR; PG8_SCHED;
            PG8_LDA(At, 1, 1); PG8_STAGE(PG8_SB(1, 0), b3, voffB); PG8_STAGE(PG8_SB(1, 1), b3 + hstep, voffB); PG8_STAGE(PG8_SA(1, 0), a3, voffA);
            PG8_WAIT_V(8); PG8_WAIT_L(0); PG8_BAR; PG8_MMA(1, 0, At, B0); PG8_MMA(1, 1, At, B1); PG8_BAR; PG8_SCHED;
            } else {
            PG8_LDB(B0, 0, 0); PG8_SCHED; PG8_LDA(At, 0, 0); PG8_STAGE(PG8_SA(1, 1), a1 + hstep, voffA);
            PG8_WAIT_L(8); PG8_BAR; PG8_WAIT_L(0); PG8_MMA(0, 0, At, B0); PG8_BAR; PG8_SCHED;
            PG8_LDB(B1, 0, 1); PG8_STAGE(PG8_SB(0, 0), b2, voffB);
            PG8_BAR; PG8_WAIT_L(0); PG8_MMA(0, 1, At, B1); PG8_BAR;
            PG8_LDA(At, 0, 1); PG8_STAGE(PG8_SA(0, 0), a2, voffA);
            PG8_BAR; PG8_WAIT_L(0); PG8_MMA(1, 0, At, B0); PG8_BAR; PG8_SCHED;
            PG8_STAGE(PG8_SB(0, 1), b2 + hstep, voffB);
            PG8_WAIT_V(6); PG8_BAR; PG8_MMA(1, 1, At, B1); PG8_BAR;
            PG8_LDB(B0, 1, 0); PG8_SCHED; PG8_LDA(At, 1, 0); PG8_STAGE(PG8_SA(0, 1), a2 + hstep, voffA);
            PG8_WAIT_L(8); PG8_BAR; PG8_WAIT_L(0); PG8_MMA(0, 0, At, B0); PG8_BAR; PG8_SCHED;
            PG8_LDB(B1, 1, 1); PG8_STAGE(PG8_SB(1, 0), b3, voffB);
            PG8_BAR; PG8_WAIT_L(0); PG8_MMA(0, 1, At, B1); PG8_BAR;
            PG8_LDA(At, 1, 1); PG8_STAGE(PG8_SA(1, 0), a3, voffA);
            PG8_BAR; PG8_WAIT_L(0); PG8_MMA(1, 0, At, B0); PG8_BAR; PG8_SCHED;
            PG8_STAGE(PG8_SB(1, 1), b3 + hstep, voffB);
            PG8_WAIT_V(6); PG8_BAR; PG8_MMA(1, 1, At, B1); PG8_BAR;
            }
        }
        if constexpr (ALIGN_EPI) { if (wr == 0) PG8_BAR; }
        if constexpr (!Epi::AFTER_DRAIN) { E(acc, cur, wr, wc, fr, fq); S.done(cur); }
        if (!has_next) break;
#pragma unroll
        for (int a = 0; a < 2; ++a)
#pragma unroll
            for (int b = 0; b < 2; ++b)
#pragma unroll
                for (int m = 0; m < 4; ++m)
#pragma unroll
                    for (int n = 0; n < 2; ++n) acc[a][b][m][n] = (f32x4){0.f, 0.f, 0.f, 0.f};
        cur = nxt; cA = nA; cB = nB; ++ui;
        if constexpr (ALIGN_EPI) { if (wr == 1) PG8_BAR; }
    }
    PG8_WAIT_V(0);
    if constexpr (!ALIGN_EPI) { if (wr == 0) PG8_BAR; }
    PG8_BAR;
    if constexpr (Epi::AFTER_DRAIN) { E.fused(acc, cur, wr, wc, fr, fq, lds, wid, lane); S.done(cur); }
#undef PG8_SA
#undef PG8_SB
#undef PG8_STAGE
#undef PG8_LDA
#undef PG8_LDB
#undef PG8_MMA
#undef PG8_WAIT_V
#undef PG8_WAIT_L
#undef PG8_BAR
#undef PG8_SCHED
}
}
#define GAS __attribute__((address_space(1)))
#define LAS __attribute__((address_space(3)))
typedef unsigned short bf16;
typedef unsigned v4u __attribute__((ext_vector_type(4)));
typedef float f32x4 __attribute__((ext_vector_type(4)));
typedef short bf16x8 __attribute__((ext_vector_type(8)));
typedef GAS unsigned gu32;
typedef GAS unsigned long long gu64;
#define RLX_AGENT __ATOMIC_RELAXED, __HIP_MEMORY_SCOPE_AGENT
#define LDS_WAIT() asm volatile("s_waitcnt lgkmcnt(0)" ::: "memory")
#define VM_WAIT() asm volatile("s_waitcnt vmcnt(0)" ::: "memory")
__device__ __forceinline__ unsigned long long rt() { return __builtin_amdgcn_s_memrealtime(); }
__device__ __forceinline__ unsigned f2bf(float f) { unsigned u = __builtin_bit_cast(unsigned, f); return (u + 0x7fffu + ((u >> 16) & 1u)) >> 16; }
__device__ __forceinline__ unsigned pk2(float lo, float hi) { return f2bf(lo) | (f2bf(hi) << 16); }

#define XB_TMO      128
#define XB_XCNT(j)  (256  + 64 * (j))
#define XB_XSUB(j)  (1280 + 64 * (j))
#define XB_XGEN(j)  (2304 + 64 * (j))
#define XB_TOP      3328
#define XB_TOPGEN   3392
#define XCD_BAR_WORDS 3456
#define XB_SPIN_CAP (1u << 18)

__device__ __forceinline__ unsigned xb_ld(unsigned* p)              { return __hip_atomic_load(p, __ATOMIC_RELAXED, __HIP_MEMORY_SCOPE_AGENT); }
__device__ __forceinline__ unsigned xb_add(unsigned* p, unsigned v) { return __hip_atomic_fetch_add(p, v, __ATOMIC_RELAXED, __HIP_MEMORY_SCOPE_AGENT); }
__device__ __forceinline__ unsigned xb_xcc_id() { return (unsigned)__builtin_amdgcn_s_getreg((3 << 11) | 20) & 0xFu; }
#define XB_SPIN(cond, bar) do { unsigned _sp = 0; while (cond) { __builtin_amdgcn_s_sleep(1); \
    if ((++_sp & 255u) == 0u) { if (xb_ld(&(bar)[XB_TMO])) break; if (_sp > XB_SPIN_CAP) { atomicAdd(&(bar)[XB_TMO], 1u); break; } } } } while (0)

struct XcdBarrier {
    unsigned* bar; unsigned x;
    volatile LAS unsigned* st;
};

__device__ __forceinline__ XcdBarrier xcd_barrier_post(unsigned* bar, volatile LAS unsigned* st) {
    XcdBarrier b; b.bar = bar; b.x = xb_xcc_id(); b.st = st;
    if (threadIdx.x == 0) (void)xb_add(&bar[XB_XCNT(b.x)], 1u);
    return b;
}
__device__ __forceinline__ void xcd_barrier_complete(unsigned* bar, unsigned x, unsigned& nloc, unsigned& nx) {
    const unsigned G = gridDim.x * gridDim.y * gridDim.z;
    unsigned sum, cnt, mine, sp = 0u;
    for (;;) {
        sum = 0u; cnt = 0u; mine = 0u;
#pragma unroll
        for (unsigned j = 0; j < 16; ++j) { const unsigned c = xb_ld(&bar[XB_XCNT(j)]); sum += c; cnt += (c > 0u) ? 1u : 0u; mine = (j == x) ? c : mine; }
        if (sum == G) break;
        __builtin_amdgcn_s_sleep(1);
        if ((++sp & 255u) == 0u) { if (xb_ld(&bar[XB_TMO])) break; if (sp > XB_SPIN_CAP) { atomicAdd(&bar[XB_TMO], 1u); break; } }
    }
    nloc = mine > 0u ? mine : 1u; nx = cnt > 0u ? cnt : 1u;
}

__device__ __forceinline__ void xcd_barrier(const XcdBarrier& b) {
    asm volatile("s_waitcnt vmcnt(0)" ::: "memory");
    __syncthreads();
    if (threadIdx.x == 0) {
        unsigned* bar = b.bar;
        __builtin_amdgcn_s_waitcnt(0);
        unsigned nloc = b.st[0], nx = b.st[1];
        if (nloc == 0u) { xcd_barrier_complete(bar, b.x, nloc, nx); b.st[0] = nloc; b.st[1] = nx; }
        const unsigned old = xb_add(&bar[XB_XSUB(b.x)], 1u);
        const unsigned gen = old / nloc;
        if (old + 1u == (gen + 1u) * nloc) {
            __builtin_amdgcn_fence(__ATOMIC_RELEASE, "agent");
            asm volatile("s_waitcnt vmcnt(0)" ::: "memory");
            const unsigned og = xb_add(&bar[XB_TOP], 1u);
            const unsigned tg = og / nx;
            if (og + 1u == (tg + 1u) * nx) xb_add(&bar[XB_TOPGEN], 1u);
            else XB_SPIN(xb_ld(&bar[XB_TOPGEN]) == tg, bar);
            __builtin_amdgcn_fence(__ATOMIC_ACQUIRE, "agent");
            xb_add(&bar[XB_XGEN(b.x)], 1u);
            asm volatile("s_waitcnt vmcnt(0)" ::: "memory");
        } else {
            XB_SPIN(xb_ld(&bar[XB_XGEN(b.x)]) == gen, bar);
            __builtin_amdgcn_fence(__ATOMIC_ACQUIRE, "agent");
            asm volatile("s_waitcnt vmcnt(0)" ::: "memory");
        }
    }
    __syncthreads();
}
__device__ __forceinline__ float wave_sum(float v) {
#pragma unroll
    for (int o = 1; o < 64; o <<= 1) v += __shfl_xor(v, o);
    return v;
}
template <bool GV>
__device__ __forceinline__ void p0_transpose_item_t(const float* W, int K, int N, bf16* WT, int row_off, LAS float* scr, int kb, int nb, int lane, const float* sh, float (&ca)[8]) {
    const int k0 = 64 * kb, n0 = 32 * nb;
    f32x4 wv[8];
#pragma unroll
    for (int i = 0; i < 8; ++i) wv[i] = __builtin_nontemporal_load((const GAS f32x4*)(W + (size_t)(k0 + 8 * i + (lane >> 3)) * N + n0 + 4 * (lane & 7)));
#pragma unroll
    for (int i = 0; i < 8; ++i) { LAS float* d = scr + (8 * i + (lane >> 3)) * 33 + 4 * (lane & 7); d[0] = wv[i].x; d[1] = wv[i].y; d[2] = wv[i].z; d[3] = wv[i].w; }
    LDS_WAIT(); asm volatile("" ::: "memory");
    const int c = lane & 7;
    f32x4 s0[2], s1[2];
    if constexpr (GV) { const GAS f32x4* q0 = (const GAS f32x4*)(sh + k0 + 8 * c); const GAS f32x4* q1 = (const GAS f32x4*)(sh + 12288 + k0 + 8 * c); s0[0] = q0[0]; s0[1] = q0[1]; s1[0] = q1[0]; s1[1] = q1[1]; }
#pragma unroll
    for (int j = 0; j < 4; ++j) { const int n = (lane >> 3) + 8 * j; const LAS float* s = scr + (8 * c) * 33 + n;
        if constexpr (GV) { const float t0 = s[0 * 33], t1 = s[1 * 33], t2 = s[2 * 33], t3 = s[3 * 33], t4 = s[4 * 33], t5 = s[5 * 33], t6 = s[6 * 33], t7 = s[7 * 33];
            ca[j] += (t0 * s0[0].x + t1 * s0[0].y + t2 * s0[0].z + t3 * s0[0].w) + (t4 * s0[1].x + t5 * s0[1].y + t6 * s0[1].z + t7 * s0[1].w);
            ca[4 + j] += (t0 * s1[0].x + t1 * s1[0].y + t2 * s1[0].z + t3 * s1[0].w) + (t4 * s1[1].x + t5 * s1[1].y + t6 * s1[1].z + t7 * s1[1].w); }
        v4u o; o.x = pk2(s[0 * 33], s[1 * 33]); o.y = pk2(s[2 * 33], s[3 * 33]); o.z = pk2(s[4 * 33], s[5 * 33]); o.w = pk2(s[6 * 33], s[7 * 33]);
        __builtin_nontemporal_store(o, (GAS v4u*)(WT + (size_t)(row_off + n0 + n) * K + k0 + 8 * c)); }
    LDS_WAIT(); asm volatile("" ::: "memory");
}
__device__ __forceinline__ void p0_transpose_item(const float* W, int K, int N, bf16* WT, int row_off, LAS float* scr, int item, int lane) {
    const int nblk = N / 32; float ca[8];
    p0_transpose_item_t<false>(W, K, N, WT, row_off, scr, item / nblk, item % nblk, lane, nullptr, ca);
}

#define DI __device__ __forceinline__
typedef float f32x2 __attribute__((ext_vector_type(2)));
typedef float f32x16 __attribute__((ext_vector_type(16)));
typedef unsigned v2u __attribute__((ext_vector_type(2)));
typedef __bf16 bf16x2_t __attribute__((ext_vector_type(2)));
#define MFMA32(a, b, c) __builtin_amdgcn_mfma_f32_32x32x16_bf16((a), (b), (c), 0, 0, 0)

constexpr int DM = 2048, SEQ = 4096, MPROMPT = 8192, MSAMP = 128, MTOK = 8320, MP = 8448;
constexpr int NQKV = 2560, DFF = 5632, NUP = 11264, NGIN = 12352, NGINP = 12544, GVAL = 4096;
constexpr int MODW = 12288, NMODROW = 34;
constexpr float NORM_EPS = 1e-6f;

constexpr size_t O_Y = 0;
constexpr size_t O_WKP = (size_t)MTOK * DM;
constexpr size_t O_WVP = O_WKP + 65536;
constexpr size_t O_WKS = O_WVP + 65536;
constexpr size_t O_WVS = O_WKS + 1048576;
constexpr size_t O_GDNP = O_WVS + 1048576;
constexpr size_t O_GDNS = O_GDNP + 1048576;
constexpr size_t O_GCP = O_GDNS + 16777216;
constexpr size_t O_GCS = O_GCP + 49152;
constexpr size_t O_FCP = O_GCS + 786432;
constexpr size_t O_FCS = O_FCP + 90112;
constexpr size_t O_END = O_FCS + 1441792;

constexpr size_t MiB = 1u << 20;
constexpr size_t WS_CTL = 0, CTL_ZERO_BYTES = 1 * MiB;
constexpr size_t WS_MOD = 1 * MiB;
constexpr size_t WS_WQKV = 5 * MiB, WS_WO = 15 * MiB, WS_WGIN = 23 * MiB, WS_WGOUT = 72 * MiB;
constexpr size_t WS_WUP0 = 88 * MiB, WS_WUP1 = 132 * MiB, WS_WDN0 = 176 * MiB, WS_WDN1 = 198 * MiB;
constexpr size_t WS_H = 220 * MiB;
constexpr size_t WS_BIG = 253 * MiB;
constexpr size_t WS_R = 456 * MiB;
constexpr size_t WS_QKV = WS_R;
constexpr size_t WS_AO = 498 * MiB;
constexpr size_t WS_ACT = 531 * MiB;
constexpr size_t WS_KQ = WS_R;
constexpr size_t WS_TH = 552 * MiB;
constexpr size_t WS_VEC = 680 * MiB;
constexpr size_t WS_BA = 684 * MiB;
constexpr size_t WS_GO = 687 * MiB;
constexpr size_t WS_END = 753 * MiB;
static_assert(WS_H + (size_t)MP * DM * 2 <= WS_BIG && WS_BIG + (size_t)MP * NGINP * 2 <= WS_R, "ws map");
static_assert(WS_QKV + (size_t)MP * NQKV * 2 <= WS_AO && WS_AO + (size_t)MP * DM * 2 <= WS_ACT && WS_ACT + (size_t)MP * DFF * 2 <= WS_VEC, "ws map");
static_assert(WS_KQ + (size_t)2048 * 49152 <= WS_TH && WS_TH + (size_t)4096 * 32768 <= WS_VEC && WS_VEC + (size_t)4096 * 1024 <= WS_BA, "ws map");
static_assert(WS_BA + (size_t)MP * 64 * 4 <= WS_GO && WS_GO + (size_t)MP * GVAL * 2 <= WS_END, "ws map");
constexpr int CW_QUEUE = 64;
constexpr int CW_BAR = 4096;
constexpr int CW_SNC = 24576;
constexpr int CW_SSQ = 65536;
constexpr int CW_CV = 131072;
constexpr int CV_UP0 = 0, CV_GIN = 2 * 11264, CV_UP1 = CV_GIN + 2 * 12352;
static_assert(CW_CV + CV_UP1 + 2 * 11264 <= 262144, "control region is 1 MiB");
constexpr int CW_PROG = 16384;

constexpr int LDS_BYTES = 155648;
constexpr int MISC_OFF = 151552;

DI float bflo(unsigned w) { return __uint_as_float(w << 16); }
DI float bfhi(unsigned w) { return __uint_as_float(w & 0xffff0000u); }
DI float bf2f(unsigned short b) { return __uint_as_float((unsigned)b << 16); }
DI unsigned pkbf(float lo, float hi) { f32x2 v = {lo, hi}; bf16x2_t b = __builtin_convertvector(v, bf16x2_t); return __builtin_bit_cast(unsigned, b); }
DI unsigned short f2bf16(float f) { return (unsigned short)(pkbf(f, 0.f) & 0xffffu); }
DI void unpack8(v4u w, float (&x)[8]) { x[0] = bflo(w.x); x[1] = bfhi(w.x); x[2] = bflo(w.y); x[3] = bfhi(w.y); x[4] = bflo(w.z); x[5] = bfhi(w.z); x[6] = bflo(w.w); x[7] = bfhi(w.w); }
DI v4u pack8f(const float (&x)[8]) { v4u w; w.x = pkbf(x[0], x[1]); w.y = pkbf(x[2], x[3]); w.z = pkbf(x[4], x[5]); w.w = pkbf(x[6], x[7]); return w; }
DI float silu_f(float x) { return x * __builtin_amdgcn_rcpf(1.f + __expf(-x)); }
DI float sigmoid_f(float x) { return __builtin_amdgcn_rcpf(1.f + __expf(-x)); }
DI float softplus_f(float x) { return fmaxf(x, 0.f) + log1pf(__expf(-fabsf(x))); }
DI int crow(int reg, int h) { return (reg & 3) + 8 * (reg >> 2) + 4 * h; }
DI int rho32(int p) { return (p & ~12) | ((p & 4) << 1) | ((p & 8) >> 1); }
DI int pos64(int j) { return (j & ~31) | rho32(j & 31); }
template <int S_> DI bf16x8 pack_acc(const f32x16& x) {
    v4u p; p.x = pkbf(x[8 * S_ + 0], x[8 * S_ + 1]); p.y = pkbf(x[8 * S_ + 2], x[8 * S_ + 3]); p.z = pkbf(x[8 * S_ + 4], x[8 * S_ + 5]); p.w = pkbf(x[8 * S_ + 6], x[8 * S_ + 7]);
    return __builtin_bit_cast(bf16x8, p);
}
DI f32x16 zero16() { f32x16 z; _Pragma("unroll") for (int i = 0; i < 16; ++i) z[i] = 0.f; return z; }

struct P {
    const float *x_prompt, *x_sample, *c_prompt, *c_sample, *cache_k, *cache_v, *state_gdn, *state_gconv, *state_fconv, *rel_table;
    const float *w_ada, *b_ada, *norm_mix, *norm_ffn, *w_qkv, *q_norm, *k_norm, *sinks, *w_o, *w_gin, *gconv_w, *a_log, *dt_bias, *out_norm, *w_gout;
    const float *w_up, *fconv_w, *fconv_b, *w_dn;
    float* out; unsigned char* ws;
};

namespace pg8 {
constexpr int PF_OFF = 131072, PF_IMG = 6144;
__device__ __forceinline__ void norm_fixup(const f32x4 (&acc)[2][2][4][2], const PG8_LAS float* pfb, int rowl, int coll) {
    f32x4 (&a)[2][2][4][2] = const_cast<f32x4 (&)[2][2][4][2]>(acc);
    f32x4 c4[2][2];
#pragma unroll
    for (int bj = 0; bj < 2; ++bj)
#pragma unroll
        for (int n = 0; n < 2; ++n) c4[bj][n] = *(const PG8_LAS f32x4*)(pfb + 256 + coll + bj * HALF + 4 * n);
#pragma unroll
    for (int ai = 0; ai < 2; ++ai)
#pragma unroll
        for (int m = 0; m < 4; ++m) { const float rs = rsqrtf(pfb[rowl + ai * HALF + m * 16] * (1.f / 2048.f) + 1e-6f);
#pragma unroll
            for (int bj = 0; bj < 2; ++bj)
#pragma unroll
                for (int n = 0; n < 2; ++n) a[ai][bj][m][n] = a[ai][bj][m][n] * rs + c4[bj][n]; }
}
struct PrefOrder {
    StaticOrder S; PG8_LAS unsigned char* lds; const float* ssq; const float* cv; int ldcv; const float* cw; const float* cb;
    __device__ __forceinline__ bool next_inl(int i, Unit& u) const {
        const long L = (long)i * S.G + S.c; if (L >= S.nwg) return false;
        int wgid = (int)L; { const int q = S.nwg / NXCD, r = S.nwg % NXCD, xcd = wgid % NXCD, off = wgid / NXCD; wgid = (xcd < r ? xcd * (q + 1) : r * (q + 1) + (xcd - r) * q) + off; }
        const int nig = WGM * S.nN, gid = wgid / nig, fm = gid * WGM, gsz = (S.nM - fm) < WGM ? (S.nM - fm) : WGM;
        u.pm = fm + ((wgid % nig) % gsz); u.pn = (wgid % nig) / gsz; u.ui = i; return true;
    }
    __device__ __forceinline__ bool next(int i, Unit& u) const {
        const bool ok = next_inl(i, u);
        Unit c;
        if (i >= 1 && next_inl(i - 1, c)) { const int t = threadIdx.x;
            const float* src = t < 256 ? ssq + c.pm * BM + t : cv + (size_t)(c.pm >> 4) * ldcv + c.pn * BM + (t - 256);
            const int wv = __builtin_amdgcn_readfirstlane(t >> 6);
            __builtin_amdgcn_global_load_lds((const unsigned*)src, (PG8_LAS unsigned*)(lds + PF_OFF + ((i - 1) & 1) * PF_IMG + wv * 256), 4, 0, 0);
            if (cw != nullptr) {
#pragma unroll
                for (int q = 0; q < 2; ++q) { const int jj = 2 * q + (wv >> 2), col = (wv & 3) * 64 + (t & 63);
                    const float* s2 = (jj < 3 ? cw + (size_t)jj * 11264 : cb) + (col < 128 ? c.pn * 128 + col : 5632 + c.pn * 128 + col - 128);
                    __builtin_amdgcn_global_load_lds((const unsigned*)s2, (PG8_LAS unsigned*)(lds + PF_OFF + ((i - 1) & 1) * PF_IMG + 2048 + jj * 1024 + (wv & 3) * 256), 4, 0, 0); } } }
        return ok;
    }
    __device__ __forceinline__ void a_ready(const Unit&) const {}
    __device__ __forceinline__ void done(const Unit&) const {}
};
template <bool NRM>
struct EpiStoreT {
    static constexpr bool PERM = true, AFTER_DRAIN = false;
    bf16_t* O; int ldc; float* side; int sidepn; PG8_LAS unsigned char* lds;
    __device__ __forceinline__ void operator()(const f32x4 (&acc)[2][2][4][2], const Unit& u, int wr, int wc, int fr, int fq) const {
        const int row0 = u.pm * BM + wr * 64 + fr;
        if constexpr (NRM) norm_fixup(acc, (const PG8_LAS float*)(lds + PF_OFF + (u.ui & 1) * PF_IMG), wr * 64 + fr, wc * 32 + 8 * fq);
#if defined(NULLEPI)
        if (O == nullptr) {
#pragma unroll
            for (int ai = 0; ai < 2; ++ai)
#pragma unroll
                for (int bj = 0; bj < 2; ++bj)
#pragma unroll
                    for (int m = 0; m < 4; ++m)
#pragma unroll
                        for (int n = 0; n < 2; ++n) asm volatile("" :: "v"(acc[ai][bj][m][n]));
            return;
        }
#endif
        if (side != nullptr && u.pn == sidepn) {
            if (wc < 2) {
#pragma unroll
                for (int ai = 0; ai < 2; ++ai)
#pragma unroll
                    for (int m = 0; m < 4; ++m) { float* rp = side + (size_t)(row0 + ai * HALF + m * 16) * 64 + wc * 32 + 8 * fq;
                        *(f32x4*)(rp) = acc[ai][0][m][0]; *(f32x4*)(rp + 4) = acc[ai][0][m][1]; }
            }
            return;
        }
        const int col0 = u.pn * BM + wc * 32 + 8 * fq;
#pragma unroll
        for (int ai = 0; ai < 2; ++ai)
#pragma unroll
            for (int m = 0; m < 4; ++m) { bf16_t* rowp = O + (size_t)(row0 + ai * HALF + m * 16) * ldc + col0;
#pragma unroll
                for (int bj = 0; bj < 2; ++bj) { const f32x4 v0 = acc[ai][bj][m][0], v1 = acc[ai][bj][m][1];
                    u32x4 w; w.x = cvt_pk_bf16(v0[0], v0[1]); w.y = cvt_pk_bf16(v0[2], v0[3]); w.z = cvt_pk_bf16(v1[0], v1[1]); w.w = cvt_pk_bf16(v1[2], v1[3]);
                    *(u32x4*)(rowp + bj * HALF) = w; } }
    }
};
using EpiStore = EpiStoreT<false>;
using EpiStoreN = EpiStoreT<true>;
struct EpiResid {
    static constexpr bool PERM = false, AFTER_DRAIN = false;
    const float* xin_p; const float* xin_s; float* xout; const float* gate;
    __device__ __forceinline__ void operator()(const f32x4 (&acc)[2][2][4][2], const Unit& u, int wr, int wc, int fr, int fq) const {
#if defined(NULLEPI)
        if (xout == nullptr) {
#pragma unroll
            for (int ai = 0; ai < 2; ++ai)
#pragma unroll
                for (int bj = 0; bj < 2; ++bj)
#pragma unroll
                    for (int m = 0; m < 4; ++m)
#pragma unroll
                        for (int n = 0; n < 2; ++n) asm volatile("" :: "v"(acc[ai][bj][m][n]));
            return;
        }
#endif
        const int col0 = u.pn * BM + wc * 32 + 4 * fq;
        if (u.pm < 32) {
            const float* g = gate + (size_t)(u.pm >> 4) * 12288 + col0;
            f32x4 gv[2][2];
#pragma unroll
            for (int bj = 0; bj < 2; ++bj)
#pragma unroll
                for (int n = 0; n < 2; ++n) gv[bj][n] = *(const f32x4*)(g + bj * HALF + n * 16);
#pragma unroll
            for (int ai = 0; ai < 2; ++ai)
#pragma unroll
                for (int m = 0; m < 4; ++m) { const size_t off = (size_t)(u.pm * BM + ai * HALF + wr * 64 + m * 16 + fr) * 2048 + col0;
#pragma unroll
                    for (int bj = 0; bj < 2; ++bj)
#pragma unroll
                        for (int n = 0; n < 2; ++n) { const f32x4 xv = *(const f32x4*)(xin_p + off + bj * HALF + n * 16);
                            *(f32x4*)(xout + off + bj * HALF + n * 16) = xv + gv[bj][n] * acc[ai][bj][m][n]; }
                    asm volatile("" ::: "memory"); }
        } else {
#pragma unroll
            for (int m = 0; m < 4; ++m) { const int rs = wr * 64 + m * 16 + fr;
                const float* g = gate + (size_t)(2 + (rs >> 2)) * 12288 + col0; const size_t off = (size_t)rs * 2048 + col0;
#pragma unroll
                for (int bj = 0; bj < 2; ++bj)
#pragma unroll
                    for (int n = 0; n < 2; ++n) { const f32x4 gvv = *(const f32x4*)(g + bj * HALF + n * 16); const f32x4 xv = *(const f32x4*)(xin_s + off + bj * HALF + n * 16);
                        *(f32x4*)(xout + (size_t)8192 * 2048 + off + bj * HALF + n * 16) = xv + gvv * acc[0][bj][m][n]; }
                asm volatile("" ::: "memory"); }
        }
    }
};
typedef unsigned u32x2 __attribute__((ext_vector_type(2)));
struct EpiResidN {
    static constexpr bool PERM = false, AFTER_DRAIN = false;
    const float* xin_p; float* xout; const float* gate; bf16_t* Hs; const float* ng; const float* nmod; float* ssq;
    __device__ __forceinline__ void operator()(const f32x4 (&acc)[2][2][4][2], const Unit& u, int wr, int wc, int fr, int fq) const {
        const int col0 = u.pn * BM + wc * 32 + 4 * fq;
        const float* g = gate + (size_t)(u.pm >> 4) * 12288 + col0;
        const float* sc = nmod + (size_t)(u.pm >> 4) * 12288 + 2048 + col0;
        f32x4 gv[2][2], wv[2][2];
#pragma unroll
        for (int bj = 0; bj < 2; ++bj)
#pragma unroll
            for (int n = 0; n < 2; ++n) { gv[bj][n] = *(const f32x4*)(g + bj * HALF + 16 * n); wv[bj][n] = *(const f32x4*)(ng + col0 + bj * HALF + 16 * n) * (*(const f32x4*)(sc + bj * HALF + 16 * n) + 1.f); }
#pragma unroll
        for (int ai = 0; ai < 2; ++ai)
#pragma unroll
            for (int m = 0; m < 4; ++m) { const int row = u.pm * BM + ai * HALF + wr * 64 + m * 16 + fr; const size_t off = (size_t)row * 2048 + col0; float ss = 0.f;
#pragma unroll
                for (int bj = 0; bj < 2; ++bj)
#pragma unroll
                    for (int n = 0; n < 2; ++n) { const f32x4 xv = *(const f32x4*)(xin_p + off + bj * HALF + 16 * n); f32x4 y = xv + gv[bj][n] * acc[ai][bj][m][n];
                        *(f32x4*)(xout + off + bj * HALF + 16 * n) = y; ss += (y[0] * y[0] + y[1] * y[1]) + (y[2] * y[2] + y[3] * y[3]); y = y * wv[bj][n];
                        u32x2 w; w.x = cvt_pk_bf16(y[0], y[1]); w.y = cvt_pk_bf16(y[2], y[3]);
                        *(u32x2*)(Hs + off + bj * HALF + 16 * n) = w; }
                ss += __shfl_xor(ss, 16); ss += __shfl_xor(ss, 32);
                if (fq == 0) atomicAdd(ssq + row, ss);
                asm volatile("" ::: "memory"); }
    }
};
}

template <int CTRL> DI float dpp1(float x) { return __builtin_bit_cast(float, __builtin_amdgcn_update_dpp(0, __builtin_bit_cast(int, x), CTRL, 0xf, 0xf, true)); }
template <int CTRL> DI f32x4 dpp4(f32x4 v) { return (f32x4){dpp1<CTRL>(v.x), dpp1<CTRL>(v.y), dpp1<CTRL>(v.z), dpp1<CTRL>(v.w)}; }
namespace pg8 {
struct EpiAct {
    static constexpr bool PERM = true, AFTER_DRAIN = false;
    bf16_t* ACT; bf16_t* U; const float* cw; const float* cb;
    PG8_LAS unsigned char* lds;
    __device__ __forceinline__ void operator()(const f32x4 (&acc)[2][2][4][2], const Unit& u, int wr, int wc, int fr, int fq) const {
        const int rowg = u.pm * BM + wr * 64, jc = u.pn * 128 + wc * 32 + 8 * fq;
        norm_fixup(acc, (const PG8_LAS float*)(lds + PF_OFF + (u.ui & 1) * PF_IMG), wr * 64 + fr, wc * 32 + 8 * fq);
#if defined(EPIACT_RAW)
#pragma unroll
        for (int ai = 0; ai < 2; ++ai)
#pragma unroll
            for (int m = 0; m < 4; ++m)
#pragma unroll
                for (int bj = 0; bj < 2; ++bj) { const f32x4 v0 = acc[ai][bj][m][0], v1 = acc[ai][bj][m][1];
                    u32x4 w; w.x = cvt_pk_bf16(v0[0], v0[1]); w.y = cvt_pk_bf16(v0[2], v0[3]); w.z = cvt_pk_bf16(v1[0], v1[1]); w.w = cvt_pk_bf16(v1[2], v1[3]);
                    *(u32x4*)(U + (size_t)(rowg + ai * HALF + m * 16 + fr) * 11264 + bj * 5632 + jc) = w; }
        return;
#endif
        if (fr < 2 || fr >= 14) { const int m = fr < 2 ? 0 : 3;
#pragma unroll
            for (int ai = 0; ai < 2; ++ai)
#pragma unroll
                for (int bj = 0; bj < 2; ++bj) { const f32x4 v0 = fr < 2 ? acc[ai][bj][0][0] : acc[ai][bj][3][0], v1 = fr < 2 ? acc[ai][bj][0][1] : acc[ai][bj][3][1];
                    u32x4 w; w.x = cvt_pk_bf16(v0[0], v0[1]); w.y = cvt_pk_bf16(v0[2], v0[3]); w.z = cvt_pk_bf16(v1[0], v1[1]); w.w = cvt_pk_bf16(v1[2], v1[3]);
                    *(u32x4*)(U + (size_t)(rowg + ai * HALF + m * 16 + fr) * 11264 + bj * 5632 + jc) = w; } }
        const PG8_LAS float* cim = (const PG8_LAS float*)(lds + PF_OFF + (u.ui & 1) * PF_IMG + 2048) + wc * 32 + 8 * fq;
        unsigned hold[2][4][2][2];
#pragma unroll
        for (int n = 0; n < 2; ++n) {
            f32x4 wg[3], wv[3], bg, bv;
#pragma unroll
            for (int j = 0; j < 3; ++j) { wg[j] = *(const PG8_LAS f32x4*)(cim + j * 256 + 4 * n); wv[j] = *(const PG8_LAS f32x4*)(cim + j * 256 + 128 + 4 * n); }
            bg = *(const PG8_LAS f32x4*)(cim + 3 * 256 + 4 * n); bv = *(const PG8_LAS f32x4*)(cim + 3 * 256 + 128 + 4 * n);
#pragma unroll
            for (int ai = 0; ai < 2; ++ai)
#pragma unroll
                for (int m = 0; m < 4; ++m) { f32x4 y[2];
#pragma unroll
                    for (int bj = 0; bj < 2; ++bj) { const f32x4 cur = acc[ai][bj][m][n], prv = acc[ai][bj][m > 0 ? m - 1 : 0][n];
                        const f32x4 x1 = m > 0 ? (fr == 15 ? prv : cur) : cur, x2 = m > 0 ? (fr >= 14 ? prv : cur) : cur;
                        const f32x4 u1 = dpp4<0x121>(x1), u2 = dpp4<0x122>(x2);
                        y[bj] = bj == 0 ? wg[0] * u2 + wg[1] * u1 + wg[2] * cur + bg : wv[0] * u2 + wv[1] * u1 + wv[2] * cur + bv; }
                    f32x4 av;
#pragma unroll
                    for (int e = 0; e < 4; ++e) av[e] = y[0][e] * __builtin_amdgcn_rcpf(1.f + __expf(-y[0][e])) * y[1][e];
                    hold[ai][m][n][0] = cvt_pk_bf16(av[0], av[1]); hold[ai][m][n][1] = cvt_pk_bf16(av[2], av[3]); }
        }
#pragma unroll
        for (int ai = 0; ai < 2; ++ai)
#pragma unroll
            for (int m = 0; m < 4; ++m) if (m > 0 || fr >= 2) { u32x4 w; w.x = hold[ai][m][0][0]; w.y = hold[ai][m][0][1]; w.z = hold[ai][m][1][0]; w.w = hold[ai][m][1][1];
                *(u32x4*)(ACT + (size_t)(rowg + ai * HALF + m * 16 + fr) * 5632 + jc) = w; }
    }
};
}

constexpr int I_QKV = 32 * 80, I_O = 32 * 64, I_GIN = 32 * 386, I_GOUT = 64 * 64, I_UP = 32 * 352, I_DN = 88 * 64;
constexpr int IT_O = I_QKV, IT_UP0 = IT_O + I_O, IT_DN0 = IT_UP0 + I_UP, IT_GIN = IT_DN0 + I_DN, IT_GOUT = IT_GIN + I_GIN, IT_UP1 = IT_GOUT + I_GOUT, IT_DN1 = IT_UP1 + I_UP, NITEMS = IT_DN1 + I_DN;
constexpr int IT_GIN_MID = IT_GIN + I_GIN / 2;
DI int up_row_off(int nb) { const int n0 = 32 * nb; const int nn = n0 < DFF ? n0 : n0 - DFF; return 256 * (nn >> 7) + (n0 < DFF ? 0 : 128) + (nn & 127) - n0; }
DI void p0_item(const P& p, int it, LAS float* scr, int lane) {
    unsigned char* ws = p.ws;
    if (it < IT_O) { p0_transpose_item(p.w_qkv, 2048, NQKV, (bf16*)(ws + WS_WQKV), 0, scr, it, lane); return; }
    if (it < IT_UP0) { p0_transpose_item(p.w_o, 2048, 2048, (bf16*)(ws + WS_WO), 0, scr, it - IT_O, lane); return; }
    if (it < IT_DN0) { const int r = it - IT_UP0; p0_transpose_item(p.w_up, 2048, NUP, (bf16*)(ws + WS_WUP0), up_row_off(r % (NUP / 32)), scr, r, lane); return; }
    if (it < IT_GIN) { p0_transpose_item(p.w_dn, DFF, 2048, (bf16*)(ws + WS_WDN0), 0, scr, it - IT_DN0, lane); return; }
    if (it < IT_GOUT) { p0_transpose_item(p.w_gin, 2048, NGIN, (bf16*)(ws + WS_WGIN), 0, scr, it - IT_GIN, lane); return; }
    if (it < IT_UP1) { p0_transpose_item(p.w_gout, 4096, 2048, (bf16*)(ws + WS_WGOUT), 0, scr, it - IT_GOUT, lane); return; }
    if (it < IT_DN1) { const int r = it - IT_UP1; p0_transpose_item(p.w_up + (size_t)2048 * NUP, 2048, NUP, (bf16*)(ws + WS_WUP1), up_row_off(r % (NUP / 32)), scr, r, lane); return; }
    p0_transpose_item(p.w_dn + (size_t)DFF * 2048, DFF, 2048, (bf16*)(ws + WS_WDN1), 0, scr, it - IT_DN1, lane);
}
DI int gv_kind(int it) { return (it >= IT_UP0 && it < IT_DN0) ? 0 : (it >= IT_GIN && it < IT_GOUT) ? 1 : (it >= IT_UP1 && it < IT_DN1) ? 2 : -1; }
DI void p0_item_gv(const P& p, int kind, int it, LAS float* scr, int lane, float (&ca)[8]) {
    unsigned char* ws = p.ws; const float* mod = (const float*)(ws + WS_MOD);
    const int r = it - (kind == 0 ? IT_UP0 : kind == 1 ? IT_GIN : IT_UP1), nblk = kind == 1 ? NGIN / 32 : NUP / 32, g = r >> 2, nb = g % nblk, kb = 4 * (g / nblk) + (r & 3);
    if (kind == 0) p0_transpose_item_t<true>(p.w_up, 2048, NUP, (bf16*)(ws + WS_WUP0), up_row_off(nb), scr, kb, nb, lane, mod + 3 * DM, ca);
    else if (kind == 1) p0_transpose_item_t<true>(p.w_gin, 2048, NGIN, (bf16*)(ws + WS_WGIN), 0, scr, kb, nb, lane, mod + (size_t)NMODROW * MODW, ca);
    else p0_transpose_item_t<true>(p.w_up + (size_t)2048 * NUP, 2048, NUP, (bf16*)(ws + WS_WUP1), up_row_off(nb), scr, kb, nb, lane, mod + (size_t)NMODROW * MODW + 3 * DM, ca);
}
DI void p0_gv_flush(const P& p, int kind, int it, int lane, float (&ca)[8]) {
    const int r = it - (kind == 0 ? IT_UP0 : kind == 1 ? IT_GIN : IT_UP1), nblk = kind == 1 ? NGIN / 32 : NUP / 32, nb = (r >> 2) % nblk, ldcv = kind == 1 ? NGIN : NUP;
    float* cv = (float*)(p.ws + WS_CTL) + CW_CV + (kind == 0 ? CV_UP0 : kind == 1 ? CV_GIN : CV_UP1);
#pragma unroll
    for (int i = 0; i < 8; ++i) { ca[i] += __shfl_xor(ca[i], 1); ca[i] += __shfl_xor(ca[i], 2); ca[i] += __shfl_xor(ca[i], 4); }
    const int c = lane & 7;
    float v = ca[0];
#pragma unroll
    for (int i = 1; i < 8; ++i) v = c == i ? ca[i] : v;
    atomicAdd(cv + (size_t)(c >> 2) * ldcv + (kind == 1 ? 0 : up_row_off(nb)) + 32 * nb + (lane >> 3) + 8 * (c & 3), v);
}
DI void convert_queue(const P& p, int qi, int lo, int hi, LAS unsigned char* lds, volatile LAS unsigned* misc, int tid, int wave, int lane, int max_batches = 1 << 30) {
    asm volatile("" : "+v"(tid), "+v"(lane));
    gu32* q = (gu32*)(p.ws + WS_CTL) + CW_QUEUE + 64 * qi;
    LAS float* scr = (LAS float*)(lds + wave * 16384);
    __syncthreads();
    for (int nb_ = 0; nb_ < max_batches; ++nb_) {
        if (tid == 0) misc[0] = __hip_atomic_fetch_add(q, 32u, __ATOMIC_RELAXED, __HIP_MEMORY_SCOPE_AGENT);
        __syncthreads();
        const int base = lo + (int)misc[0];
        __syncthreads();
        if (base >= hi) break;
        const int kind = gv_kind(base);
        if (kind < 0) {
#pragma unroll 1
            for (int i = 0; i < 4; ++i) { const int it = base + wave * 4 + i; if (it < hi) p0_item(p, it, scr, lane); }
        } else { float ca[8] = {0.f, 0.f, 0.f, 0.f, 0.f, 0.f, 0.f, 0.f};
#pragma unroll 1
            for (int i = 0; i < 4; ++i) p0_item_gv(p, kind, base + wave * 4 + i, scr, lane, ca);
            p0_gv_flush(p, kind, base + wave * 4, lane, ca); }
    }
}
constexpr int AD_ST = 0, AD_ST_LD = 1040;
constexpr int AD_WS = 64 * AD_ST_LD, AD_WS_LD = 400, AD_WS_SZ = 16 * AD_WS_LD;
constexpr int AD_RED = 0;
static_assert(AD_WS + 8 * AD_WS_SZ <= MISC_OFF && 8 * 34 * 96 * 4 <= MISC_OFF, "adaLN LDS");
DI void p0_adaln_unit(const P& p, int unit, LAS unsigned char* lds, int tid, int wave, int lane) {
    const int layer = unit >> 7, n0 = (unit & 127) * 96;
    const int c = lane & 31, h = lane >> 5;
    const float* wbase = p.w_ada + (size_t)layer * 2048 * MODW + n0;
    LAS unsigned char* wst = lds + AD_WS + wave * AD_WS_SZ;
    f32x16 acc[2][3];
#pragma unroll
    for (int mt = 0; mt < 2; ++mt)
#pragma unroll
        for (int nt = 0; nt < 3; ++nt) acc[mt][nt] = zero16();
    unsigned voff[6], loff[6];
#pragma unroll
    for (int i = 0; i < 6; ++i) { const int id = lane + 64 * i, sr = id / 24, sc4 = (id % 24) * 4; voff[i] = (unsigned)(sr * MODW + sc4) * 4u; loff[i] = (unsigned)(sr * AD_WS_LD + sc4 * 4); }
    __syncthreads();
    for (int i = tid; i < 30 * (AD_ST_LD / 4); i += 512) ((LAS unsigned*)(lds + AD_ST + 34 * AD_ST_LD))[i] = 0u;
    f32x4 wv[2][6];
#define AD_LOAD(slot, kstep) do { const GAS unsigned char* wk_ = (const GAS unsigned char*)wbase + (size_t)(kstep) * (16 * MODW * 4); \
        _Pragma("unroll") for (int i_ = 0; i_ < 6; ++i_) wv[slot][i_] = __builtin_nontemporal_load((const GAS f32x4*)(wk_ + voff[i_])); } while (0)
    AD_LOAD(0, 4 * wave + 0); AD_LOAD(1, 4 * wave + 1);
    for (int kc = 0; kc < 4; ++kc) {
        __syncthreads();
        for (int idx = tid; idx < 34 * 512; idx += 512) { const int r = idx >> 9, kk = idx & 511;
            const float cv = (r < 2) ? p.c_prompt[r * 2048 + kc * 512 + kk] : p.c_sample[(r - 2) * 2048 + kc * 512 + kk];
            *(LAS unsigned short*)(lds + AD_ST + r * AD_ST_LD + kk * 2) = f2bf16(silu_f(cv)); }
        __syncthreads();
#pragma unroll
        for (int j = 0; j < 4; ++j) {
            const int slot = j & 1;
#pragma unroll
            for (int i = 0; i < 6; ++i) *(LAS f32x4*)(wst + loff[i]) = wv[slot][i];
            { const int nj = j + 2, nkc = kc + (nj >> 2); if (nkc < 4) AD_LOAD(slot, nkc * 32 + 4 * wave + (nj & 3)); }
            const bf16x8 a0 = *(const LAS bf16x8*)(lds + AD_ST + c * AD_ST_LD + ((4 * wave + j) * 16 + 8 * h) * 2);
            const bf16x8 a1 = *(const LAS bf16x8*)(lds + AD_ST + (32 + c) * AD_ST_LD + ((4 * wave + j) * 16 + 8 * h) * 2);
#pragma unroll
            for (int nt = 0; nt < 3; ++nt) { float e[8];
#pragma unroll
                for (int q = 0; q < 8; ++q) e[q] = *(const LAS float*)(wst + (8 * h + q) * AD_WS_LD + (32 * nt + c) * 4);
                const bf16x8 bfr = __builtin_bit_cast(bf16x8, pack8f(e));
                acc[0][nt] = MFMA32(a0, bfr, acc[0][nt]); acc[1][nt] = MFMA32(a1, bfr, acc[1][nt]); }
        }
    }
#undef AD_LOAD
    __syncthreads();
    LAS float* red = (LAS float*)(lds + AD_RED);
#pragma unroll
    for (int nt = 0; nt < 3; ++nt) {
#pragma unroll
        for (int r = 0; r < 16; ++r) { red[(wave * 34 + crow(r, h)) * 96 + 32 * nt + c] = acc[0][nt][r];
            const int row1 = 32 + crow(r, h); if (row1 < 34) red[(wave * 34 + row1) * 96 + 32 * nt + c] = acc[1][nt][r]; } }
    __syncthreads();
    float* mod = (float*)(p.ws + WS_MOD);
    for (int idx = tid; idx < 34 * 96; idx += 512) { const int r = idx / 96, ci = idx - r * 96; float v = p.b_ada[layer * MODW + n0 + ci];
#pragma unroll
        for (int w = 0; w < 8; ++w) v += red[(w * 34 + r) * 96 + ci];
        mod[((size_t)layer * NMODROW + r) * MODW + n0 + ci] = v; }
    __syncthreads();
}
DI void p0_phase(const P& p, LAS unsigned char* lds, volatile LAS unsigned* misc, int tid, int wave, int lane, int rep) {
    const int G = gridDim.x, bx = blockIdx.x;
    { GAS v4u* z = (GAS v4u*)(p.ws + WS_WGIN + (size_t)NGIN * 2048 * 2); const int n = (NGINP - NGIN) * 2048 * 2 / 16;
      for (int i = bx * 512 + tid; i < n; i += G * 512) z[i] = (v4u){0u, 0u, 0u, 0u}; }
    for (int u = bx; u < 256; u += G) p0_adaln_unit(p, u, lds, tid, wave, lane);
    convert_queue(p, 2 * 0 + rep, 0, IT_UP0, lds, misc, tid, wave, lane);
}

DI void norm_phase(const float* xp, const float* xs, const float* gain, const float* modl, int shc, bf16* H, int tid, int wave, int lane, float* seed_s = nullptr, int row_lo = 0, int row_hi = MP, int bid = -1) {
    const int gw = (bid < 0 ? (int)blockIdx.x : bid) * 8 + wave, NGW = gridDim.x * 8;
    for (int row0 = row_lo + gw; row0 < row_hi; row0 += 2 * NGW) {
        f32x4 v[2][8]; float ss[2] = {0.f, 0.f}; bool live[2];
#pragma unroll
        for (int q = 0; q < 2; ++q) { const int row = row0 + q * NGW; live[q] = row < MTOK;
            if (live[q]) { const float* src = row < MPROMPT ? xp + (size_t)row * DM : xs + (size_t)(row - MPROMPT) * DM; const GAS f32x4* s4 = (const GAS f32x4*)src + lane;
#pragma unroll
                for (int j = 0; j < 8; ++j) v[q][j] = s4[64 * j]; } }
#pragma unroll
        for (int q = 0; q < 2; ++q) { const int row = row0 + q * NGW; if (row >= row_hi) continue;
            GAS v2u* o = (GAS v2u*)(H + (size_t)row * DM) + lane;
            if (!live[q]) {
#pragma unroll
                for (int j = 0; j < 8; ++j) o[64 * j] = (v2u){0u, 0u};
                continue; }
#pragma unroll
            for (int j = 0; j < 8; ++j) ss[q] += (v[q][j].x * v[q][j].x + v[q][j].y * v[q][j].y) + (v[q][j].z * v[q][j].z + v[q][j].w * v[q][j].w);
            if (seed_s != nullptr && row >= MPROMPT) {
#pragma unroll
                for (int j = 0; j < 8; ++j) ((GAS f32x4*)(seed_s + (size_t)(row - MPROMPT) * DM))[lane + 64 * j] = v[q][j]; }
            const int mr = row < MPROMPT ? (row >> 12) : 2 + ((row - MPROMPT) >> 2);
            const float rstd = rsqrtf(wave_sum(ss[q]) * (1.f / DM) + NORM_EPS);
            const GAS f32x4* g4 = (const GAS f32x4*)gain + lane;
            const GAS f32x4* sh4 = (const GAS f32x4*)(modl + (size_t)mr * MODW + shc * DM) + lane;
            const GAS f32x4* sc4 = sh4 + DM / 4;
#pragma unroll
            for (int j = 0; j < 8; ++j) { const f32x4 y = v[q][j] * rstd * g4[64 * j] * (sc4[64 * j] + 1.f) + sh4[64 * j];
                o[64 * j] = (v2u){pkbf(y.x, y.y), pkbf(y.z, y.w)}; }
        }
    }
}

DI void sample_prenorm(const P& p, int slot, const float* XR, const float* gain, const float* modl, int shc, bf16* H, int tid, int wave, int lane) {
    const int rb = (int)gridDim.x - 1 - (int)blockIdx.x;
    if (rb * 8 >= MTOK - MPROMPT) return;
    norm_phase(XR, XR + (size_t)MPROMPT * DM, gain, modl, shc, H, tid, wave, lane, nullptr, MPROMPT, MTOK, rb);
    asm volatile("s_waitcnt vmcnt(0)" ::: "memory");
    __syncthreads();
    if (tid == 0) { __builtin_amdgcn_fence(__ATOMIC_RELEASE, "agent"); asm volatile("s_waitcnt vmcnt(0)" ::: "memory");
        __hip_atomic_fetch_add((gu32*)(p.ws + WS_CTL) + CW_SNC + 64 * slot, 1u, __ATOMIC_RELAXED, __HIP_MEMORY_SCOPE_AGENT); }
}
DI void sample_prenorm_wait(const P& p, int slot, int tid) {
    const unsigned need = (unsigned)(((int)gridDim.x * 8 >= MTOK - MPROMPT) ? (MTOK - MPROMPT) / 8 : (int)gridDim.x);
    if (tid == 0) { gu32* cnt = (gu32*)(p.ws + WS_CTL) + CW_SNC + 64 * slot; unsigned spins = 0;
        while (__hip_atomic_load(cnt, __ATOMIC_RELAXED, __HIP_MEMORY_SCOPE_AGENT) < need && spins < (1u << 20)) { __builtin_amdgcn_s_sleep(4); ++spins; }
        __builtin_amdgcn_fence(__ATOMIC_ACQUIRE, "agent"); asm volatile("s_waitcnt vmcnt(0)" ::: "memory"); }
    __syncthreads();
}

constexpr int AT_KS = 144, AT_VT = 528;
constexpr int AT_KS_OFF = 0, AT_VT_OFF = 256 * AT_KS, AT_LUT_OFF = AT_VT_OFF + 64 * AT_VT, AT_END = AT_LUT_OFF + 8 * 132 * 4;
static_assert(AT_END <= MISC_OFF, "attention LDS");

template <bool SAMPLE>
DI void attn_tile(const P& p, LAS unsigned char* lds, int b, int kvh, int qb, int qt, int wave, int lane) {
    const int c = lane & 31, h = lane >> 5;
    const bf16* QKV = (const bf16*)(p.ws + WS_QKV);
    bf16* AO = (bf16*)(p.ws + WS_AO);
    int qrow, gq;
    if (!SAMPLE) { qrow = b * SEQ + qb * 128 + 32 * qt + c; gq = wave; } else { qrow = MPROMPT + 4 * b + (c >> 3); gq = c & 7; }
    const int head = kvh * 8 + gq;
    const float sinkv = p.sinks[head];
    bf16x8 qfr[4];
    {
        const bf16* qp = QKV + (size_t)qrow * NQKV + head * 64 + 8 * h;
        float qf[4][8]; float ss = 0.f;
#pragma unroll
        for (int s = 0; s < 4; ++s) { const v4u w = *(const GAS v4u*)(qp + 16 * s); unpack8(w, qf[s]);
#pragma unroll
            for (int j = 0; j < 8; ++j) ss += qf[s][j] * qf[s][j]; }
        ss += __shfl_xor(ss, 32);
        const float rs = rsqrtf(ss * (1.f / 64.f) + NORM_EPS) * 0.125f;
#pragma unroll
        for (int s = 0; s < 4; ++s) { float y[8];
#pragma unroll
            for (int j = 0; j < 8; ++j) y[j] = qf[s][j] * rs * p.q_norm[16 * s + 8 * h + j];
            qfr[s] = __builtin_bit_cast(bf16x8, pack8f(y)); }
    }
    const int kt0 = SAMPLE ? 0 : qt;
    f32x16 sc[5];
#pragma unroll
    for (int i = 0; i < 5; ++i) { f32x16 acc = zero16();
#pragma unroll
        for (int s = 0; s < 4; ++s) { const bf16x8 a = *(const LAS bf16x8*)(lds + AT_KS_OFF + (32 * (kt0 + i) + c) * AT_KS + (16 * s + 8 * h) * 2); acc = MFMA32(a, qfr[s], acc); }
        sc[i] = acc; }
    const LAS float* lut = (const LAS float*)(lds + AT_LUT_OFF) + gq * 132;
    float m = sinkv;
#pragma unroll
    for (int i = 0; i < 5; ++i)
#pragma unroll
        for (int r = 0; r < 16; ++r) { const int key = 32 * (kt0 + i) + crow(r, h); int dist; bool valid;
            if (!SAMPLE) { dist = 32 * qt + c + 128 - key; valid = (dist >= 0) && (dist <= 128) && (qb > 0 || key >= 128); }
            else { dist = (c >> 3) + 128 - key; valid = (dist >= 0) && (dist <= 128) && (key < 132); }
            const int dcl = dist < 0 ? 0 : (dist > 128 ? 128 : dist);
            const float v = valid ? sc[i][r] + lut[dcl] : -1e30f; sc[i][r] = v; m = fmaxf(m, v); }
    m = fmaxf(m, __shfl_xor(m, 32));
    float l = 0.f;
#pragma unroll
    for (int i = 0; i < 5; ++i)
#pragma unroll
        for (int r = 0; r < 16; ++r) { const float e = __expf(sc[i][r] - m); sc[i][r] = e; l += e; }
    l += __shfl_xor(l, 32);
    l += __expf(sinkv - m);
    f32x16 o[2]; o[0] = zero16(); o[1] = zero16();
#pragma unroll
    for (int i = 0; i < 5; ++i) {
        const bf16x8 b0 = pack_acc<0>(sc[i]), b1 = pack_acc<1>(sc[i]);
#pragma unroll
        for (int dt = 0; dt < 2; ++dt) {
            const LAS unsigned char* vp = lds + AT_VT_OFF + (32 * dt + c) * AT_VT + (32 * (kt0 + i) + 8 * h) * 2;
            const bf16x8 a0 = *(const LAS bf16x8*)(vp), a1 = *(const LAS bf16x8*)(vp + 32);
            o[dt] = MFMA32(a0, b0, o[dt]); o[dt] = MFMA32(a1, b1, o[dt]); }
    }
    const float inv = 1.f / l;
    bf16* op = AO + (size_t)qrow * DM + head * 64;
#pragma unroll
    for (int dt = 0; dt < 2; ++dt)
#pragma unroll
        for (int q4 = 0; q4 < 4; ++q4) { const int d0 = 32 * dt + 8 * q4 + 4 * h;
            *(GAS v2u*)(op + d0) = (v2u){pkbf(o[dt][4 * q4] * inv, o[dt][4 * q4 + 1] * inv), pkbf(o[dt][4 * q4 + 2] * inv, o[dt][4 * q4 + 3] * inv)}; }
}

template <bool SAMPLE>
DI void attn_unit(const P& p, int unit, LAS unsigned char* lds, int tid, int wave, int lane) {
    int b, kvh, qb;
    if (!SAMPLE) { kvh = unit & 3; qb = (unit >> 2) & 31; b = unit >> 7; } else { kvh = unit & 3; b = unit >> 2; qb = 0; }
    const bf16* QKV = (const bf16*)(p.ws + WS_QKV);
    __syncthreads();
    constexpr int NK = SAMPLE ? 160 : 256;
    for (int cidx = tid; cidx < NK * 8; cidx += 512) {
        const int key = cidx >> 3, part = cidx & 7;
        float kx[8], vx[8]; bool need_norm = false, have = false;
#pragma unroll
        for (int e = 0; e < 8; ++e) { kx[e] = 0.f; vx[e] = 0.f; }
        if (!SAMPLE) {
            const int pos = qb * 128 - 128 + key;
            if (pos >= 0) { const bf16* rp = QKV + (size_t)(b * SEQ + pos) * NQKV + 2048 + kvh * 64 + part * 8;
                unpack8(*(const GAS v4u*)rp, kx); unpack8(*(const GAS v4u*)(rp + 256), vx); need_norm = true; have = true; }
        } else {
            if (key < 128) { const size_t off = ((size_t)(b * 128 + key) * 4 + kvh) * 64 + part * 8;
                const f32x4 k0 = *(const GAS f32x4*)(p.cache_k + off), k1 = *(const GAS f32x4*)(p.cache_k + off + 4), v0 = *(const GAS f32x4*)(p.cache_v + off), v1 = *(const GAS f32x4*)(p.cache_v + off + 4);
                kx[0] = k0.x; kx[1] = k0.y; kx[2] = k0.z; kx[3] = k0.w; kx[4] = k1.x; kx[5] = k1.y; kx[6] = k1.z; kx[7] = k1.w;
                vx[0] = v0.x; vx[1] = v0.y; vx[2] = v0.z; vx[3] = v0.w; vx[4] = v1.x; vx[5] = v1.y; vx[6] = v1.z; vx[7] = v1.w; have = true; }
            else if (key < 132) { const bf16* rp = QKV + (size_t)(MPROMPT + 4 * b + key - 128) * NQKV + 2048 + kvh * 64 + part * 8;
                unpack8(*(const GAS v4u*)rp, kx); unpack8(*(const GAS v4u*)(rp + 256), vx); need_norm = true; have = true; }
        }
        float ss = 0.f;
#pragma unroll
        for (int e = 0; e < 8; ++e) ss += kx[e] * kx[e];
        ss += __shfl_xor(ss, 1); ss += __shfl_xor(ss, 2); ss += __shfl_xor(ss, 4);
        if (need_norm) { const float rs = rsqrtf(ss * (1.f / 64.f) + NORM_EPS);
#pragma unroll
            for (int e = 0; e < 8; ++e) kx[e] = kx[e] * rs * p.k_norm[part * 8 + e]; }
        *(LAS v4u*)(lds + AT_KS_OFF + key * AT_KS + part * 16) = pack8f(kx);
        const int kpos = pos64(key);
#pragma unroll
        for (int e = 0; e < 8; ++e) *(LAS unsigned short*)(lds + AT_VT_OFF + (part * 8 + e) * AT_VT + kpos * 2) = f2bf16(vx[e]);
        if (!SAMPLE) {
            if (qb == 31 && key >= 128) { const size_t off = ((size_t)(b * 128 + key - 128) * 4 + kvh) * 64 + part * 8;
                float* ok = p.out + O_WKP + off; float* ov = p.out + O_WVP + off;
                *(GAS f32x4*)ok = (f32x4){kx[0], kx[1], kx[2], kx[3]}; *(GAS f32x4*)(ok + 4) = (f32x4){kx[4], kx[5], kx[6], kx[7]};
                *(GAS f32x4*)ov = (f32x4){vx[0], vx[1], vx[2], vx[3]}; *(GAS f32x4*)(ov + 4) = (f32x4){vx[4], vx[5], vx[6], vx[7]}; }
        } else {
            if (have && key >= 4) { const size_t off = ((size_t)(b * 128 + key - 4) * 4 + kvh) * 64 + part * 8;
                float* ok = p.out + O_WKS + off; float* ov = p.out + O_WVS + off;
                *(GAS f32x4*)ok = (f32x4){kx[0], kx[1], kx[2], kx[3]}; *(GAS f32x4*)(ok + 4) = (f32x4){kx[4], kx[5], kx[6], kx[7]};
                *(GAS f32x4*)ov = (f32x4){vx[0], vx[1], vx[2], vx[3]}; *(GAS f32x4*)(ov + 4) = (f32x4){vx[4], vx[5], vx[6], vx[7]}; }
        }
    }
    for (int i = tid; i < 8 * 132; i += 512) { const int g = i / 132, d = i - g * 132; float v = 0.f;
        if (d <= 128) { int bk = d;
            if (d >= 16) { bk = 16 + (int)(__logf((float)d * (1.f / 16.f)) / 2.0794415416798357f * 16.f); bk = bk > 31 ? 31 : bk; }
            v = p.rel_table[bk * 32 + kvh * 8 + g]; }
        ((LAS float*)(lds + AT_LUT_OFF))[i] = v; }
    __syncthreads();
    if (!SAMPLE) {
#pragma unroll 1
        for (int qt = 0; qt < 4; ++qt) attn_tile<false>(p, lds, b, kvh, qb, qt, wave, lane);
    } else { if (wave == 0) attn_tile<true>(p, lds, b, kvh, 0, 0, wave, lane); }
}
DI void attn_phase(const P& p, LAS unsigned char* lds, int tid, int wave, int lane) {
    const int G = gridDim.x;
    for (int u = blockIdx.x; u < 256 + 128; u += G) { if (u < 256) attn_unit<false>(p, u, lds, tid, wave, lane); else attn_unit<true>(p, u - 256, lds, tid, wave, lane); }
    __syncthreads();
}

DI void ffn_act_phase(const P& p, int layer, int tid) {
    const bf16* U = (const bf16*)(p.ws + WS_BIG);
    bf16* ACT = (bf16*)(p.ws + WS_ACT);
    const float* cw = p.fconv_w + (size_t)layer * 3 * NUP; const float* cb = p.fconv_b + (size_t)layer * NUP;
    constexpr int NOCT = DFF / 8, NPR = (MPROMPT / 64) * NOCT, NTASK = NPR + 32 * NOCT, NCPY = 2 * 2 * (NUP / 8);
    for (int task = blockIdx.x * 512 + tid; task < NTASK; task += gridDim.x * 512) {
        int row0, nrows, oct; bool samp; int sb = 0;
#if defined(EPIACT_RAW)
        if (task < NPR) { const int run = task / NOCT; oct = task - run * NOCT; row0 = run * 64; nrows = 64; samp = false; }
#else
        if (task < NPR) { const int run = task / NOCT; oct = task - run * NOCT; row0 = run * 64; nrows = 2; samp = false; }
#endif
        else { const int t2 = task - NPR; sb = t2 / NOCT; oct = t2 - sb * NOCT; row0 = MPROMPT + 4 * sb; nrows = 4; samp = true; }
        const int cg = oct * 8, cv = DFF + oct * 8;
        float wg[3][8], wv[3][8], bg[8], bv[8];
#pragma unroll
        for (int j = 0; j < 3; ++j)
#pragma unroll
            for (int e = 0; e < 8; ++e) { wg[j][e] = cw[j * NUP + cg + e]; wv[j][e] = cw[j * NUP + cv + e]; }
#pragma unroll
        for (int e = 0; e < 8; ++e) { bg[e] = cb[cg + e]; bv[e] = cb[cv + e]; }
        float g0[8], g1[8], v0[8], v1[8];
        if (samp) { const float* h0 = p.state_fconv + ((size_t)(layer * 32 + sb) * 2) * NUP;
#pragma unroll
            for (int e = 0; e < 8; ++e) { g0[e] = h0[cg + e]; v0[e] = h0[cv + e]; g1[e] = h0[NUP + cg + e]; v1[e] = h0[NUP + cv + e]; } }
        else if ((row0 & (SEQ - 1)) == 0) {
#pragma unroll
            for (int e = 0; e < 8; ++e) { g0[e] = 0.f; g1[e] = 0.f; v0[e] = 0.f; v1[e] = 0.f; } }
        else { unpack8(*(const GAS v4u*)(U + (size_t)(row0 - 2) * NUP + cg), g0); unpack8(*(const GAS v4u*)(U + (size_t)(row0 - 2) * NUP + cv), v0);
               unpack8(*(const GAS v4u*)(U + (size_t)(row0 - 1) * NUP + cg), g1); unpack8(*(const GAS v4u*)(U + (size_t)(row0 - 1) * NUP + cv), v1); }
#pragma unroll 4
        for (int i = 0; i < nrows; ++i) {
            const int row = row0 + i; float g2[8], v2[8], a[8];
            unpack8(*(const GAS v4u*)(U + (size_t)row * NUP + cg), g2); unpack8(*(const GAS v4u*)(U + (size_t)row * NUP + cv), v2);
#pragma unroll
            for (int e = 0; e < 8; ++e) { const float yg = wg[0][e] * g0[e] + wg[1][e] * g1[e] + wg[2][e] * g2[e] + bg[e];
                const float yv = wv[0][e] * v0[e] + wv[1][e] * v1[e] + wv[2][e] * v2[e] + bv[e]; a[e] = silu_f(yg) * yv; }
            *(GAS v4u*)(ACT + (size_t)row * DFF + cg) = pack8f(a);
            int orow = -1; float* ob = nullptr;
            if (samp) { if (i >= 2) { orow = i - 2; ob = p.out + O_FCS + ((size_t)(layer * 32 + sb) * 2) * NUP; } }

            if (orow >= 0) { float* o = ob + (size_t)orow * NUP;
                *(GAS f32x4*)(o + cg) = (f32x4){g2[0], g2[1], g2[2], g2[3]}; *(GAS f32x4*)(o + cg + 4) = (f32x4){g2[4], g2[5], g2[6], g2[7]};
                *(GAS f32x4*)(o + cv) = (f32x4){v2[0], v2[1], v2[2], v2[3]}; *(GAS f32x4*)(o + cv + 4) = (f32x4){v2[4], v2[5], v2[6], v2[7]}; }
#pragma unroll
            for (int e = 0; e < 8; ++e) { g0[e] = g1[e]; g1[e] = g2[e]; v0[e] = v1[e]; v1[e] = v2[e]; }
        }
    }
    for (int t = blockIdx.x * 512 + tid; t < NCPY; t += gridDim.x * 512) { const int c8 = t % (NUP / 8), rr = (t / (NUP / 8)) & 1, bb = t / (2 * (NUP / 8));
        float x[8]; unpack8(*(const GAS v4u*)(U + (size_t)(bb * SEQ + SEQ - 2 + rr) * NUP + c8 * 8), x);
        float* o = p.out + O_FCP + ((size_t)(layer * 2 + bb) * 2 + rr) * NUP + c8 * 8;
        *(GAS f32x4*)o = (f32x4){x[0], x[1], x[2], x[3]}; *(GAS f32x4*)(o + 4) = (f32x4){x[4], x[5], x[6], x[7]}; }
}

constexpr int CH_VB = 0, CH_VB_LD = 528;
constexpr int CH_KB = 33792, CH_QB = 51200, CH_KQ_LD = 272;
constexpr int CH_VEC = 68608;
constexpr int CH_A = 69632, CH_A_LD = 68;
static_assert(CH_A + 2 * 64 * CH_A_LD * 4 <= MISC_OFF, "chunk LDS");

DI void gdn_tsolve(const LAS float* Am, bf16* Tg, int lane) {
    asm volatile("" : "+v"(lane));
    const int pc = pos64(lane);
    f32x2 T2[32];
#pragma unroll
    for (int k = 0; k < 32; ++k) T2[k] = (f32x2){0.f, 0.f};
    f32x4 an[16];
#pragma unroll
    for (int q = 0; q < 16; ++q) an[q] = (f32x4){0.f, 0.f, 0.f, 0.f};
#pragma unroll
    for (int i = 0; i < 64; ++i) {
        f32x4 ac[16];
        if (i < 40) {
#pragma unroll
            for (int q = 0; q < 16; ++q) ac[q] = an[q];
            if (i + 1 < 40) {
#pragma unroll
                for (int q = 0; q < (i + 1 + 3) / 4; ++q) an[q] = *(const LAS f32x4*)(Am + (i + 1) * CH_A_LD + 4 * q); }
        } else {
#pragma unroll
            for (int q = 0; q < (i + 3) / 4; ++q) ac[q] = *(const LAS f32x4*)(Am + i * CH_A_LD + 4 * q);
        }
        __builtin_amdgcn_sched_barrier(0);
        f32x2 s0 = (f32x2){0.f, 0.f}, s1 = (f32x2){0.f, 0.f};
#pragma unroll
        for (int q = 0; q < (i + 3) / 4; ++q) { s0 += (f32x2){ac[q].x, ac[q].y} * T2[2 * q]; s1 += (f32x2){ac[q].z, ac[q].w} * T2[2 * q + 1]; }
        const float ti = ((i == lane) ? 1.f : 0.f) - ((s0.x + s0.y) + (s1.x + s1.y));
        T2[i >> 1][i & 1] = ti;
        Tg[i * 64 + pc] = f2bf16(ti);
        __builtin_amdgcn_sched_barrier(0);
    }
}

#ifndef CHUNK_DUP
#define CHUNK_DUP 0
#endif
template <bool NOST>
DI void gdn_chunk_phase(const P& p, LAS unsigned char* lds, int tid, int wave, int lane) {
    const bf16* PROJ = (const bf16*)(p.ws + WS_BIG);
    const float* BA = (const float*)(p.ws + WS_BA);
    LAS float* vec = (LAS float*)(lds + CH_VEC);
    const bool solver = wave < 2;
    int wt = solver ? 0 : (wave - 2) * 64 + lane;
    const int G = gridDim.x;
    int prev_unit = -1;
    v4u xs[2][10];
#define CH_LOADU(XN, tsk, un) do { const int un_ = (un), n_ = un_ & 63, kh_ = (un_ >> 6) & 15, b_ = (un_ >> 10) & 1, cg_ = wt & 31, tp_ = (tsk) >> 5; \
        const int pc_ = cg_ < 8 ? kh_ * 128 + cg_ * 16 : (cg_ < 16 ? 2048 + kh_ * 128 + (cg_ - 8) * 16 : 4096 + 2 * kh_ * 128 + (cg_ - 16) * 16); \
        _Pragma("unroll") for (int k_ = 0; k_ < 5; ++k_) { int tr_ = n_ * 64 + 2 * tp_ - 3 + k_; tr_ = tr_ < 0 ? 0 : tr_; \
            const bf16* rp_ = PROJ + (size_t)(b_ * SEQ + tr_) * NGINP + pc_; XN[2 * k_] = *(const GAS v4u*)rp_; XN[2 * k_ + 1] = *(const GAS v4u*)(rp_ + 8); } } while (0)
    if (!solver) { const int u0_ = (int)blockIdx.x < 2048 ? (int)blockIdx.x : 2047; CH_LOADU(xs[0], wt, u0_); CH_LOADU(xs[1], wt + 384, u0_); }
    __syncthreads();
    if (solver) {
    for (int unit = blockIdx.x; ; unit += G) {
        asm volatile("" : "+v"(tid), "+v"(lane));
        const bool live = unit < 2048;
        const int n = unit & 63, kh = (unit >> 6) & 15, b = (unit >> 10) & 1;
        const int R0 = b * SEQ + n * 64;
        {
            if (prev_unit >= 0) { const int pn = prev_unit & 63, pkh = (prev_unit >> 6) & 15, pb = prev_unit >> 10, hh = wave;
                gdn_tsolve((const LAS float*)(lds + CH_A) + hh * 64 * CH_A_LD, (bf16*)(p.ws + WS_TH + (size_t)((pb * 32 + 2 * pkh + hh) * 64 + pn) * 32768), lane); }
        }
        __syncthreads();
        if (!live) break;
        {
            unsigned char* kq = p.ws + WS_KQ + (size_t)((b * 16 + kh) * 64 + n) * 49152;
#pragma unroll
            for (int i = 0; i < 2; ++i) { const int cc = tid + 512 * i, t = cc >> 4, ch = cc & 15;
                const int dlo = 32 * (ch >> 2) + 16 * ((ch >> 1) & 1) + 4 * (ch & 1);
                const v2u ka = *(const LAS v2u*)(lds + CH_KB + t * CH_KQ_LD + dlo * 2), kb2 = *(const LAS v2u*)(lds + CH_KB + t * CH_KQ_LD + (dlo + 8) * 2);
                const v2u qa = *(const LAS v2u*)(lds + CH_QB + t * CH_KQ_LD + dlo * 2), qb2 = *(const LAS v2u*)(lds + CH_QB + t * CH_KQ_LD + (dlo + 8) * 2);
                { const v4u s_ = (v4u){ka.x, ka.y, kb2.x, kb2.y}; if constexpr (NOST) asm volatile("" :: "v"(s_)); else *(GAS v4u*)(kq + (size_t)t * 256 + ch * 16) = s_; }
                { const v4u s_ = (v4u){qa.x, qa.y, qb2.x, qb2.y}; if constexpr (NOST) asm volatile("" :: "v"(s_)); else *(GAS v4u*)(kq + 16384 + (size_t)t * 256 + ch * 16) = s_; } }
            if (tid < 256) {
#pragma unroll
                for (int q = 0; q < 4; ++q) { const int item = q * 256 + tid, d = item >> 3, ch = item & 7; const int tlo = 32 * (ch >> 2) + 16 * ((ch >> 1) & 1) + 4 * (ch & 1); unsigned short e[8];
#pragma unroll
                    for (int j = 0; j < 8; ++j) e[j] = *(const LAS unsigned short*)(lds + CH_KB + (tlo + 8 * (j >> 2) + (j & 3)) * CH_KQ_LD + d * 2);
                    { const v4u s_ = (v4u){(unsigned)e[0] | ((unsigned)e[1] << 16), (unsigned)e[2] | ((unsigned)e[3] << 16), (unsigned)e[4] | ((unsigned)e[5] << 16), (unsigned)e[6] | ((unsigned)e[7] << 16)}; if constexpr (NOST) asm volatile("" :: "v"(s_)); else *(GAS v4u*)(kq + 32768 + (size_t)d * 128 + ch * 16) = s_; } } }
            {
#pragma unroll
                for (int q = 0; q < 4; ++q) { const int item = q * 512 + tid, hh = item >> 10, v = (item >> 3) & 127, ch = item & 7; const int tlo = 32 * (ch >> 2) + 16 * ((ch >> 1) & 1) + 4 * (ch & 1); float e[8];
                    unsigned char* th = p.ws + WS_TH + (size_t)((b * 32 + 2 * kh + hh) * 64 + n) * 32768;
#pragma unroll
                    for (int j = 0; j < 8; ++j) { const int tj = tlo + 8 * (j >> 2) + (j & 3); e[j] = bf2f(*(const LAS unsigned short*)(lds + CH_VB + tj * CH_VB_LD + (hh * 128 + v) * 2)) * vec[hh * 64 + tj]; }
                    { const v4u s_ = pack8f(e); if constexpr (NOST) asm volatile("" :: "v"(s_)); else *(GAS v4u*)(th + 16384 + (size_t)v * 128 + ch * 16) = s_; } } }
            if (tid < 128) { const int hh = tid >> 6, t = tid & 63; float* vo = (float*)(p.ws + WS_VEC) + (size_t)((b * 32 + 2 * kh + hh) * 64 + n) * 256;
                const float beta = vec[hh * 64 + t], gc = vec[128 + hh * 64 + t], gl = vec[128 + hh * 64 + 63];
                vo[t] = __expf(gc); vo[64 + t] = beta * __expf(gc); vo[128 + t] = __expf(gl - gc); vo[192 + t] = __expf(gl); }
        }
        {
            f32x16 accK = zero16(), accQ = zero16();
            const int hh = wave >> 2, mt = (wave >> 1) & 1, nt = wave & 1, c = lane & 31, h = lane >> 5;
#pragma unroll
            for (int s8 = 0; s8 < 8; ++s8) {
                const bf16x8 bk = *(const LAS bf16x8*)(lds + CH_KB + (32 * nt + c) * CH_KQ_LD + (16 * s8 + 8 * h) * 2);
                const bf16x8 ak = *(const LAS bf16x8*)(lds + CH_KB + (32 * mt + c) * CH_KQ_LD + (16 * s8 + 8 * h) * 2);
                const bf16x8 aq = *(const LAS bf16x8*)(lds + CH_QB + (32 * mt + c) * CH_KQ_LD + (16 * s8 + 8 * h) * 2);
                accK = MFMA32(ak, bk, accK); accQ = MFMA32(aq, bk, accQ); }
            const int j = 32 * nt + c; const float gj = vec[128 + hh * 64 + j];
            bf16* qkg = (bf16*)(p.ws + WS_TH + (size_t)((b * 32 + 2 * kh + hh) * 64 + n) * 32768 + 8192);
            LAS float* Am = (LAS float*)(lds + CH_A) + hh * 64 * CH_A_LD;
#pragma unroll
            for (int r = 0; r < 16; ++r) { const int i = 32 * mt + crow(r, h);
                const float gi = vec[128 + hh * 64 + i], bi = vec[hh * 64 + i];
                const float dec = __expf(fminf(gi - gj, 0.f));
                Am[i * CH_A_LD + j] = (i > j) ? bi * accK[r] * dec : 0.f;
                qkg[i * 64 + pos64(j)] = f2bf16((i >= j) ? accQ[r] * dec : 0.f); }
        }
        __syncthreads();
        prev_unit = unit;
    }
    } else {
    for (int unit = blockIdx.x; ; unit += G) {
        asm volatile("" : "+v"(tid), "+v"(lane));
        const bool live = unit < 2048;
        const int n = unit & 63, kh = (unit >> 6) & 15, b = (unit >> 10) & 1;
        const int R0 = b * SEQ + n * 64;
        if (live) {
            asm volatile("" : "+v"(wt));
            if (wt < 128) { const int hh = wt >> 6, t = wt & 63, hd = 2 * kh + hh;
                const float bv = BA[(size_t)(R0 + t) * 64 + hd], av = BA[(size_t)(R0 + t) * 64 + 32 + hd];
                const float beta = sigmoid_f(bv);
                float g = -__expf(p.a_log[hd]) * softplus_f(av + p.dt_bias[hd]);
#pragma unroll
                for (int o = 1; o < 64; o <<= 1) { const float up = __shfl_up(g, o); if (t >= o) g += up; }
                vec[hh * 64 + t] = beta; vec[128 + hh * 64 + t] = g; }
            const int cgi = wt & 31;
            const int pc0 = cgi < 8 ? kh * 128 + cgi * 16 : (cgi < 16 ? 2048 + kh * 128 + (cgi - 8) * 16 : 4096 + 2 * kh * 128 + (cgi - 16) * 16);
#define CH_LOADX(XN, tsk) do { const int tp_ = (tsk) >> 5; _Pragma("unroll") for (int k_ = 0; k_ < 5; ++k_) { int tr_ = n * 64 + 2 * tp_ - 3 + k_; tr_ = tr_ < 0 ? 0 : tr_; \
                const bf16* rp_ = PROJ + (size_t)(b * SEQ + tr_) * NGINP + pc0; XN[2 * k_] = *(const GAS v4u*)rp_; XN[2 * k_ + 1] = *(const GAS v4u*)(rp_ + 8); } } while (0)
#pragma unroll
            for (int it3 = 0; it3 < 3; ++it3) { const int it = it3 & 1;
                const int task = wt + 384 * it3; const int tp = task >> 5;
                const bool act = task < 1024;
                f32x2 y0p[8], y1p[8];
#pragma unroll
                for (int e = 0; e < 8; ++e) { y0p[e] = (f32x2){0.f, 0.f}; y1p[e] = (f32x2){0.f, 0.f}; }
                f32x4 wprev[4];
#pragma unroll
                for (int k = 0; k < 5; ++k) { const int tr = 2 * tp - 3 + k;
                    f32x4 wcur[4];
                    if (k < 4) { int woff = k * 8192 + pc0; asm volatile("" : "+v"(woff));
#pragma unroll
                        for (int q = 0; q < 4; ++q) wcur[q] = *(const GAS f32x4*)(p.gconv_w + woff + 4 * q); }
                    const unsigned km = (n > 0 || tr >= 0) ? 0xFFFFFFFFu : 0u;
                    const v4u wa = xs[it][2 * k], wb = xs[it][2 * k + 1];
                    f32x2 x2[8];
                    x2[0] = (f32x2){bflo(wa.x & km), bfhi(wa.x & km)}; x2[1] = (f32x2){bflo(wa.y & km), bfhi(wa.y & km)}; x2[2] = (f32x2){bflo(wa.z & km), bfhi(wa.z & km)}; x2[3] = (f32x2){bflo(wa.w & km), bfhi(wa.w & km)};
                    x2[4] = (f32x2){bflo(wb.x & km), bfhi(wb.x & km)}; x2[5] = (f32x2){bflo(wb.y & km), bfhi(wb.y & km)}; x2[6] = (f32x2){bflo(wb.z & km), bfhi(wb.z & km)}; x2[7] = (f32x2){bflo(wb.w & km), bfhi(wb.w & km)};
                    if (k < 4) {
#pragma unroll
                        for (int e = 0; e < 8; ++e) y0p[e] += (f32x2){wcur[e >> 1][2 * (e & 1)], wcur[e >> 1][2 * (e & 1) + 1]} * x2[e]; }
                    if (k >= 1) {
#pragma unroll
                        for (int e = 0; e < 8; ++e) y1p[e] += (f32x2){wprev[e >> 1][2 * (e & 1)], wprev[e >> 1][2 * (e & 1) + 1]} * x2[e]; }
#pragma unroll
                    for (int q = 0; q < 4; ++q) wprev[q] = wcur[q];
                    if (k >= 3 && act && n == 63 && tr >= 61) { float* o = p.out + O_GCP + (size_t)(b * 3 + (tr - 61)) * 8192 + pc0;
#pragma unroll
                        for (int q = 0; q < 4; ++q) *(GAS f32x4*)(o + 4 * q) = (f32x4){x2[2 * q].x, x2[2 * q].y, x2[2 * q + 1].x, x2[2 * q + 1].y}; } }
                float y0[16], y1[16];
                f32x2 sp0 = (f32x2){0.f, 0.f}, sp1 = (f32x2){0.f, 0.f};
#pragma unroll
                for (int e = 0; e < 8; ++e) {
                    f32x2 a = y0p[e], c2 = y1p[e];
                    a = a * (f32x2){__builtin_amdgcn_rcpf(1.f + __expf(-a.x)), __builtin_amdgcn_rcpf(1.f + __expf(-a.y))};
                    c2 = c2 * (f32x2){__builtin_amdgcn_rcpf(1.f + __expf(-c2.x)), __builtin_amdgcn_rcpf(1.f + __expf(-c2.y))};
                    sp0 += a * a; sp1 += c2 * c2;
                    y0[2 * e] = a.x; y0[2 * e + 1] = a.y; y1[2 * e] = c2.x; y1[2 * e + 1] = c2.y; }
                float ss0 = sp0.x + sp0.y, ss1 = sp1.x + sp1.y;
                ss0 += __shfl_xor(ss0, 1); ss0 += __shfl_xor(ss0, 2); ss0 += __shfl_xor(ss0, 4);
                ss1 += __shfl_xor(ss1, 1); ss1 += __shfl_xor(ss1, 2); ss1 += __shfl_xor(ss1, 4);
                if (act) {
                    float r0 = 1.f, r1 = 1.f; LAS unsigned char* dst; int ld;
                    if (cgi < 8) { r0 = rsqrtf(ss0 + NORM_EPS) * 0.08838834764831845f; r1 = rsqrtf(ss1 + NORM_EPS) * 0.08838834764831845f; dst = lds + CH_QB + 2 * tp * CH_KQ_LD + cgi * 32; ld = CH_KQ_LD; }
                    else if (cgi < 16) { r0 = rsqrtf(ss0 + NORM_EPS); r1 = rsqrtf(ss1 + NORM_EPS); dst = lds + CH_KB + 2 * tp * CH_KQ_LD + (cgi - 8) * 32; ld = CH_KQ_LD; }
                    else { dst = lds + CH_VB + 2 * tp * CH_VB_LD + (cgi - 16) * 32; ld = CH_VB_LD; }
                    v4u o0, o1;
                    o0.x = pkbf(y0[0] * r0, y0[1] * r0); o0.y = pkbf(y0[2] * r0, y0[3] * r0); o0.z = pkbf(y0[4] * r0, y0[5] * r0); o0.w = pkbf(y0[6] * r0, y0[7] * r0);
                    o1.x = pkbf(y0[8] * r0, y0[9] * r0); o1.y = pkbf(y0[10] * r0, y0[11] * r0); o1.z = pkbf(y0[12] * r0, y0[13] * r0); o1.w = pkbf(y0[14] * r0, y0[15] * r0);
                    *(LAS v4u*)dst = o0; *(LAS v4u*)(dst + 16) = o1;
                    o0.x = pkbf(y1[0] * r1, y1[1] * r1); o0.y = pkbf(y1[2] * r1, y1[3] * r1); o0.z = pkbf(y1[4] * r1, y1[5] * r1); o0.w = pkbf(y1[6] * r1, y1[7] * r1);
                    o1.x = pkbf(y1[8] * r1, y1[9] * r1); o1.y = pkbf(y1[10] * r1, y1[11] * r1); o1.z = pkbf(y1[12] * r1, y1[13] * r1); o1.w = pkbf(y1[14] * r1, y1[15] * r1);
                    *(LAS v4u*)(dst + ld) = o0; *(LAS v4u*)(dst + ld + 16) = o1;
                }
                if (it3 == 0) { int tk_ = wt + 768; tk_ = tk_ < 1024 ? tk_ : 1023; asm volatile("" : "+v"(tk_)); CH_LOADX(xs[0], tk_); }
            }
#undef CH_LOADX
        }
        __syncthreads();
        if (!live) break;
        { int nxu = unit + G; nxu = nxu < 2048 ? nxu : unit; asm volatile("" : "+v"(wt)); CH_LOADU(xs[0], wt, nxu); CH_LOADU(xs[1], wt + 384, nxu); }
        {
            unsigned char* kq = p.ws + WS_KQ + (size_t)((b * 16 + kh) * 64 + n) * 49152;
#pragma unroll
            for (int i = 0; i < 2; ++i) { const int cc = tid + 512 * i, t = cc >> 4, ch = cc & 15;
                const int dlo = 32 * (ch >> 2) + 16 * ((ch >> 1) & 1) + 4 * (ch & 1);
                const v2u ka = *(const LAS v2u*)(lds + CH_KB + t * CH_KQ_LD + dlo * 2), kb2 = *(const LAS v2u*)(lds + CH_KB + t * CH_KQ_LD + (dlo + 8) * 2);
                const v2u qa = *(const LAS v2u*)(lds + CH_QB + t * CH_KQ_LD + dlo * 2), qb2 = *(const LAS v2u*)(lds + CH_QB + t * CH_KQ_LD + (dlo + 8) * 2);
                { const v4u s_ = (v4u){ka.x, ka.y, kb2.x, kb2.y}; if constexpr (NOST) asm volatile("" :: "v"(s_)); else *(GAS v4u*)(kq + (size_t)t * 256 + ch * 16) = s_; }
                { const v4u s_ = (v4u){qa.x, qa.y, qb2.x, qb2.y}; if constexpr (NOST) asm volatile("" :: "v"(s_)); else *(GAS v4u*)(kq + 16384 + (size_t)t * 256 + ch * 16) = s_; } }
            if (tid < 256) {
#pragma unroll
                for (int q = 0; q < 4; ++q) { const int item = q * 256 + tid, d = item >> 3, ch = item & 7; const int tlo = 32 * (ch >> 2) + 16 * ((ch >> 1) & 1) + 4 * (ch & 1); unsigned short e[8];
#pragma unroll
                    for (int j = 0; j < 8; ++j) e[j] = *(const LAS unsigned short*)(lds + CH_KB + (tlo + 8 * (j >> 2) + (j & 3)) * CH_KQ_LD + d * 2);
                    { const v4u s_ = (v4u){(unsigned)e[0] | ((unsigned)e[1] << 16), (unsigned)e[2] | ((unsigned)e[3] << 16), (unsigned)e[4] | ((unsigned)e[5] << 16), (unsigned)e[6] | ((unsigned)e[7] << 16)}; if constexpr (NOST) asm volatile("" :: "v"(s_)); else *(GAS v4u*)(kq + 32768 + (size_t)d * 128 + ch * 16) = s_; } } }
            {
#pragma unroll
                for (int q = 0; q < 4; ++q) { const int item = q * 512 + tid, hh = item >> 10, v = (item >> 3) & 127, ch = item & 7; const int tlo = 32 * (ch >> 2) + 16 * ((ch >> 1) & 1) + 4 * (ch & 1); float e[8];
                    unsigned char* th = p.ws + WS_TH + (size_t)((b * 32 + 2 * kh + hh) * 64 + n) * 32768;
#pragma unroll
                    for (int j = 0; j < 8; ++j) { const int tj = tlo + 8 * (j >> 2) + (j & 3); e[j] = bf2f(*(const LAS unsigned short*)(lds + CH_VB + tj * CH_VB_LD + (hh * 128 + v) * 2)) * vec[hh * 64 + tj]; }
                    { const v4u s_ = pack8f(e); if constexpr (NOST) asm volatile("" :: "v"(s_)); else *(GAS v4u*)(th + 16384 + (size_t)v * 128 + ch * 16) = s_; } } }
            if (tid < 128) { const int hh = tid >> 6, t = tid & 63; float* vo = (float*)(p.ws + WS_VEC) + (size_t)((b * 32 + 2 * kh + hh) * 64 + n) * 256;
                const float beta = vec[hh * 64 + t], gc = vec[128 + hh * 64 + t], gl = vec[128 + hh * 64 + 63];
                vo[t] = __expf(gc); vo[64 + t] = beta * __expf(gc); vo[128 + t] = __expf(gl - gc); vo[192 + t] = __expf(gl); }
        }
        {
            f32x16 accK = zero16(), accQ = zero16();
            const int hh = wave >> 2, mt = (wave >> 1) & 1, nt = wave & 1, c = lane & 31, h = lane >> 5;
#pragma unroll
            for (int s8 = 0; s8 < 8; ++s8) {
                const bf16x8 bk = *(const LAS bf16x8*)(lds + CH_KB + (32 * nt + c) * CH_KQ_LD + (16 * s8 + 8 * h) * 2);
                const bf16x8 ak = *(const LAS bf16x8*)(lds + CH_KB + (32 * mt + c) * CH_KQ_LD + (16 * s8 + 8 * h) * 2);
                const bf16x8 aq = *(const LAS bf16x8*)(lds + CH_QB + (32 * mt + c) * CH_KQ_LD + (16 * s8 + 8 * h) * 2);
                accK = MFMA32(ak, bk, accK); accQ = MFMA32(aq, bk, accQ); }
            const int j = 32 * nt + c; const float gj = vec[128 + hh * 64 + j];
            bf16* qkg = (bf16*)(p.ws + WS_TH + (size_t)((b * 32 + 2 * kh + hh) * 64 + n) * 32768 + 8192);
            LAS float* Am = (LAS float*)(lds + CH_A) + hh * 64 * CH_A_LD;
#pragma unroll
            for (int r = 0; r < 16; ++r) { const int i = 32 * mt + crow(r, h);
                const float gi = vec[128 + hh * 64 + i], bi = vec[hh * 64 + i];
                const float dec = __expf(fminf(gi - gj, 0.f));
                Am[i * CH_A_LD + j] = (i > j) ? bi * accK[r] * dec : 0.f;
                qkg[i * 64 + pos64(j)] = f2bf16((i >= j) ? accQ[r] * dec : 0.f); }
        }
        __syncthreads();
        prev_unit = unit;
    }
    }
}

constexpr int SC_KP = 0, SC_QP = 17408, SC_KT = 34816, SC_T = 53248, SC_QK = 62464, SC_VBT = 71680, SC_VEC = 90112, SC_OST = 91136, SC_OST_LD = 272  , SC_OST_SZ = 64 * SC_OST_LD, SC_ON = SC_OST + 2 * SC_OST_SZ  , SC_PFD = SC_ON + 512  , SC_END = SC_PFD + 1024;
static_assert(SC_END <= MISC_OFF, "scan LDS");

#ifndef SCAN_DUP
#define SCAN_DUP 0
#endif
#undef CH_LOADU
DI void gdn_scan_unit(const P& p, int unit, LAS unsigned char* lds, int tid, int wave, int lane) {
    asm volatile("" : "+v"(tid), "+v"(lane));
    const int h_ = unit & 31, b = unit >> 5, kh = h_ >> 1;
    const int c = lane & 31, h = lane >> 5;
    const bf16* PROJ = (const bf16*)(p.ws + WS_BIG);
    bf16* GO = (bf16*)(p.ws + WS_GO);
    const int lt = tid - 256;
    const int lb16 = (lt >> 4) * 272 + (lt & 15) * 16, lb8 = (lt >> 3) * 144 + (lt & 7) * 16;
    const unsigned lt16 = (unsigned)lt * 16u;
#define SCAN_FETCH(PF, PFV, nn) do { const int nn_ = (nn) < 63 ? (nn) : 63;     \
        const GAS unsigned char* kq_ = (const GAS unsigned char*)(p.ws + WS_KQ + (size_t)((b * 16 + kh) * 64 + nn_) * 49152);     \
        const GAS unsigned char* th_ = (const GAS unsigned char*)(p.ws + WS_TH + (size_t)((b * 32 + h_) * 64 + nn_) * 32768); \
        unsigned lo_ = lt16; asm volatile("" : "+v"(lo_)); \
        _Pragma("unroll") for (int i_ = 0; i_ < 12; ++i_) PF[i_] = *(const GAS v4u*)(kq_ + i_ * 4096 + lo_); \
        _Pragma("unroll") for (int i_ = 0; i_ < 8; ++i_) PF[12 + i_] = *(const GAS v4u*)(th_ + i_ * 4096 + lo_); \
        PFV = *(const GAS v4u*)((const GAS unsigned char*)(p.ws + WS_VEC + (size_t)((b * 32 + h_) * 64 + nn_) * 1024) + (lo_ & 1023u)); } while (0)
#define SCAN_PUT(PF, PFV) do { \
        _Pragma("unroll") for (int i_ = 0; i_ < 4; ++i_) { *(LAS v4u*)(lds + SC_KP + lb16 + i_ * 16 * 272) = PF[i_]; *(LAS v4u*)(lds + SC_QP + lb16 + i_ * 16 * 272) = PF[4 + i_]; \
            *(LAS v4u*)(lds + SC_KT + lb8 + i_ * 32 * 144) = PF[8 + i_]; *(LAS v4u*)(lds + SC_VBT + lb8 + i_ * 32 * 144) = PF[16 + i_]; } \
        _Pragma("unroll") for (int i_ = 0; i_ < 2; ++i_) { *(LAS v4u*)(lds + SC_T + lb8 + i_ * 32 * 144) = PF[12 + i_]; *(LAS v4u*)(lds + SC_QK + lb8 + i_ * 32 * 144) = PF[14 + i_]; } \
        if (lt < 64) *(LAS v4u*)(lds + SC_VEC + lt * 16) = PFV; } while (0)
    __syncthreads();
    const LAS float* vec = (const LAS float*)(lds + SC_VEC);
    gu32* prog = (gu32*)(p.ws + WS_CTL) + CW_PROG + 64 * unit;
    if (wave >= 4) {
        v4u pfA[20], pfB[20]; v4u pvA = (v4u){0u, 0u, 0u, 0u}, pvB = (v4u){0u, 0u, 0u, 0u};
        SCAN_FETCH(pfA, pvA, 0); SCAN_PUT(pfA, pvA);
        SCAN_FETCH(pfA, pvA, 1); SCAN_FETCH(pfB, pvB, 2);
        __syncthreads();
#pragma unroll 1
        for (int n = 0; n < 64; n += 2) {
            __syncthreads();
            if (lt == 0) __hip_atomic_store(prog, (unsigned)(n + 1), __ATOMIC_RELAXED, __HIP_MEMORY_SCOPE_AGENT);
            SCAN_PUT(pfA, pvA);
            __syncthreads();
            SCAN_FETCH(pfA, pvA, n + 3);
            __syncthreads();
            if (lt == 0) __hip_atomic_store(prog, (unsigned)(n + 2), __ATOMIC_RELAXED, __HIP_MEMORY_SCOPE_AGENT);
            if (n + 2 < 64) SCAN_PUT(pfB, pvB);
            __syncthreads();
            SCAN_FETCH(pfB, pvB, n + 4);
        }
        __syncthreads();
    } else {
        f32x16 S[4]; S[0] = zero16(); S[1] = zero16(); S[2] = zero16(); S[3] = zero16();
        __syncthreads();
#pragma unroll 1
        for (int n = 0; n < 64; ++n) {
            {
            const int w = wave;
#define SB() __builtin_amdgcn_sched_barrier(0)
#define FRAG(base, ld, row, col) (*(const LAS bf16x8*)(lds + (base) + (row) * (ld) + (col) * 2))
            bf16x8 fbuf[2][4];
            f32x16 ks0, ks1, vn0, vn1, qs0, qs1;
            bf16x8 tb[2][2], vb[2][2], vs[2][2];
#if (SCAN_DUP & 8)
            fbuf[0][0] = FRAG(SC_KP, 272, 0 + c, 0 + 8 * h);
            fbuf[0][1] = FRAG(SC_KP, 272, 0 + c, 16 + 8 * h);
            fbuf[0][2] = FRAG(SC_KP, 272, 0 + c, 32 + 8 * h);
            fbuf[0][3] = FRAG(SC_KP, 272, 0 + c, 48 + 8 * h);
            SB();
            fbuf[1][0] = FRAG(SC_KP, 272, 0 + c, 64 + 8 * h);
            fbuf[1][1] = FRAG(SC_KP, 272, 0 + c, 80 + 8 * h);
            fbuf[1][2] = FRAG(SC_KP, 272, 0 + c, 96 + 8 * h);
            fbuf[1][3] = FRAG(SC_KP, 272, 0 + c, 112 + 8 * h);
            SB();
            ks0 = MFMA32(fbuf[0][0], pack_acc<0>(S[0]), zero16());
            ks0 = MFMA32(fbuf[0][1], pack_acc<1>(S[0]), ks0);
            ks0 = MFMA32(fbuf[0][2], pack_acc<0>(S[1]), ks0);
            ks0 = MFMA32(fbuf[0][3], pack_acc<1>(S[1]), ks0);
            SB();
            fbuf[0][0] = FRAG(SC_KP, 272, 32 + c, 0 + 8 * h);
            fbuf[0][1] = FRAG(SC_KP, 272, 32 + c, 16 + 8 * h);
            fbuf[0][2] = FRAG(SC_KP, 272, 32 + c, 32 + 8 * h);
            fbuf[0][3] = FRAG(SC_KP, 272, 32 + c, 48 + 8 * h);
            SB();
            ks0 = MFMA32(fbuf[1][0], pack_acc<0>(S[2]), ks0);
            ks0 = MFMA32(fbuf[1][1], pack_acc<1>(S[2]), ks0);
            ks0 = MFMA32(fbuf[1][2], pack_acc<0>(S[3]), ks0);
            ks0 = MFMA32(fbuf[1][3], pack_acc<1>(S[3]), ks0);
            SB();
            fbuf[1][0] = FRAG(SC_KP, 272, 32 + c, 64 + 8 * h);
            fbuf[1][1] = FRAG(SC_KP, 272, 32 + c, 80 + 8 * h);
            fbuf[1][2] = FRAG(SC_KP, 272, 32 + c, 96 + 8 * h);
            fbuf[1][3] = FRAG(SC_KP, 272, 32 + c, 112 + 8 * h);
            SB();
            ks1 = MFMA32(fbuf[0][0], pack_acc<0>(S[0]), zero16());
            ks1 = MFMA32(fbuf[0][1], pack_acc<1>(S[0]), ks1);
            ks1 = MFMA32(fbuf[0][2], pack_acc<0>(S[1]), ks1);
            ks1 = MFMA32(fbuf[0][3], pack_acc<1>(S[1]), ks1);
            SB();
            fbuf[0][0] = FRAG(SC_T, 144, 0 + c, 0 + 8 * h);
            fbuf[0][1] = FRAG(SC_T, 144, 0 + c, 16 + 8 * h);
            fbuf[0][2] = FRAG(SC_VBT, 144, 32 * w + c, 0 + 8 * h);
            fbuf[0][3] = FRAG(SC_VBT, 144, 32 * w + c, 16 + 8 * h);
            SB();
            ks1 = MFMA32(fbuf[1][0], pack_acc<0>(S[2]), ks1);
            ks1 = MFMA32(fbuf[1][1], pack_acc<1>(S[2]), ks1);
            ks1 = MFMA32(fbuf[1][2], pack_acc<0>(S[3]), ks1);
            ks1 = MFMA32(fbuf[1][3], pack_acc<1>(S[3]), ks1);
            SB();
            fbuf[1][0] = FRAG(SC_T, 144, 32 + c, 0 + 8 * h);
            fbuf[1][1] = FRAG(SC_T, 144, 32 + c, 16 + 8 * h);
            fbuf[1][2] = FRAG(SC_VBT, 144, 32 * w + c, 0 + 8 * h);
            fbuf[1][3] = FRAG(SC_VBT, 144, 32 * w + c, 16 + 8 * h);
            SB();
            _Pragma("unroll") for (int q4 = 0; q4 < 4; ++q4) { const f32x4 g4 = *(const LAS f32x4*)(vec + 64 + 0 + 8 * q4 + 4 * h);
                ks0[4 * q4] *= -g4.x; ks0[4 * q4 + 1] *= -g4.y; ks0[4 * q4 + 2] *= -g4.z; ks0[4 * q4 + 3] *= -g4.w; }
            _Pragma("unroll") for (int q4 = 0; q4 < 4; ++q4) { const f32x4 g4 = *(const LAS f32x4*)(vec + 64 + 32 + 8 * q4 + 4 * h);
                ks1[4 * q4] *= -g4.x; ks1[4 * q4 + 1] *= -g4.y; ks1[4 * q4 + 2] *= -g4.z; ks1[4 * q4 + 3] *= -g4.w; }
            tb[0][0] = pack_acc<0>(ks0); tb[0][1] = pack_acc<1>(ks0); tb[1][0] = pack_acc<0>(ks1); tb[1][1] = pack_acc<1>(ks1);
            vn0 = MFMA32(fbuf[0][0], tb[0][0], zero16());
            vn0 = MFMA32(fbuf[0][0], fbuf[0][2], vn0);
            vn0 = MFMA32(fbuf[0][1], tb[0][1], vn0);
            vn0 = MFMA32(fbuf[0][1], fbuf[0][3], vn0);
            SB();
            fbuf[0][0] = FRAG(SC_T, 144, 32 + c, 32 + 8 * h);
            fbuf[0][1] = FRAG(SC_T, 144, 32 + c, 48 + 8 * h);
            fbuf[0][2] = FRAG(SC_VBT, 144, 32 * w + c, 32 + 8 * h);
            fbuf[0][3] = FRAG(SC_VBT, 144, 32 * w + c, 48 + 8 * h);
            SB();
            vn1 = MFMA32(fbuf[1][0], tb[0][0], zero16());
            vn1 = MFMA32(fbuf[1][0], fbuf[1][2], vn1);
            vn1 = MFMA32(fbuf[1][1], tb[0][1], vn1);
            vn1 = MFMA32(fbuf[1][1], fbuf[1][3], vn1);
            SB();
            fbuf[1][0] = FRAG(SC_QP, 272, 0 + c, 0 + 8 * h);
            fbuf[1][1] = FRAG(SC_QP, 272, 0 + c, 16 + 8 * h);
            fbuf[1][2] = FRAG(SC_QP, 272, 0 + c, 32 + 8 * h);
            fbuf[1][3] = FRAG(SC_QP, 272, 0 + c, 48 + 8 * h);
            SB();
            vn1 = MFMA32(fbuf[0][0], tb[1][0], vn1);
            vn1 = MFMA32(fbuf[0][0], fbuf[0][2], vn1);
            vn1 = MFMA32(fbuf[0][1], tb[1][1], vn1);
            vn1 = MFMA32(fbuf[0][1], fbuf[0][3], vn1);
            SB();
            fbuf[0][0] = FRAG(SC_QP, 272, 0 + c, 64 + 8 * h);
            fbuf[0][1] = FRAG(SC_QP, 272, 0 + c, 80 + 8 * h);
            fbuf[0][2] = FRAG(SC_QP, 272, 0 + c, 96 + 8 * h);
            fbuf[0][3] = FRAG(SC_QP, 272, 0 + c, 112 + 8 * h);
            SB();
            asm volatile("" : "+v"(S[0]), "+v"(S[1]), "+v"(S[2]), "+v"(S[3]));
            vb[0][0] = pack_acc<0>(vn0); vb[0][1] = pack_acc<1>(vn0); vb[1][0] = pack_acc<0>(vn1); vb[1][1] = pack_acc<1>(vn1);
            _Pragma("unroll") for (int q4 = 0; q4 < 4; ++q4) { const f32x4 g4 = *(const LAS f32x4*)(vec + 128 + 0 + 8 * q4 + 4 * h);
                vn0[4 * q4] *= g4.x; vn0[4 * q4 + 1] *= g4.y; vn0[4 * q4 + 2] *= g4.z; vn0[4 * q4 + 3] *= g4.w; }
            _Pragma("unroll") for (int q4 = 0; q4 < 4; ++q4) { const f32x4 g4 = *(const LAS f32x4*)(vec + 128 + 32 + 8 * q4 + 4 * h);
                vn1[4 * q4] *= g4.x; vn1[4 * q4 + 1] *= g4.y; vn1[4 * q4 + 2] *= g4.z; vn1[4 * q4 + 3] *= g4.w; }
            vs[0][0] = pack_acc<0>(vn0); vs[0][1] = pack_acc<1>(vn0); vs[1][0] = pack_acc<0>(vn1); vs[1][1] = pack_acc<1>(vn1);
            qs0 = MFMA32(fbuf[1][0], pack_acc<0>(S[0]), zero16());
            qs0 = MFMA32(fbuf[1][1], pack_acc<1>(S[0]), qs0);
            qs0 = MFMA32(fbuf[1][2], pack_acc<0>(S[1]), qs0);
            qs0 = MFMA32(fbuf[1][3], pack_acc<1>(S[1]), qs0);
            SB();
            fbuf[1][0] = FRAG(SC_QP, 272, 32 + c, 0 + 8 * h);
            fbuf[1][1] = FRAG(SC_QP, 272, 32 + c, 16 + 8 * h);
            fbuf[1][2] = FRAG(SC_QP, 272, 32 + c, 32 + 8 * h);
            fbuf[1][3] = FRAG(SC_QP, 272, 32 + c, 48 + 8 * h);
            SB();
            qs0 = MFMA32(fbuf[0][0], pack_acc<0>(S[2]), qs0);
            qs0 = MFMA32(fbuf[0][1], pack_acc<1>(S[2]), qs0);
            qs0 = MFMA32(fbuf[0][2], pack_acc<0>(S[3]), qs0);
            qs0 = MFMA32(fbuf[0][3], pack_acc<1>(S[3]), qs0);
            SB();
            fbuf[0][0] = FRAG(SC_QP, 272, 32 + c, 64 + 8 * h);
            fbuf[0][1] = FRAG(SC_QP, 272, 32 + c, 80 + 8 * h);
            fbuf[0][2] = FRAG(SC_QP, 272, 32 + c, 96 + 8 * h);
            fbuf[0][3] = FRAG(SC_QP, 272, 32 + c, 112 + 8 * h);
            SB();
            qs1 = MFMA32(fbuf[1][0], pack_acc<0>(S[0]), zero16());
            qs1 = MFMA32(fbuf[1][1], pack_acc<1>(S[0]), qs1);
            qs1 = MFMA32(fbuf[1][2], pack_acc<0>(S[1]), qs1);
            qs1 = MFMA32(fbuf[1][3], pack_acc<1>(S[1]), qs1);
            SB();
            fbuf[1][0] = FRAG(SC_QK, 144, 0 + c, 0 + 8 * h);
            fbuf[1][1] = FRAG(SC_QK, 144, 0 + c, 16 + 8 * h);
            fbuf[1][2] = FRAG(SC_QK, 144, 32 + c, 0 + 8 * h);
            fbuf[1][3] = FRAG(SC_QK, 144, 32 + c, 16 + 8 * h);
            SB();
            qs1 = MFMA32(fbuf[0][0], pack_acc<0>(S[2]), qs1);
            qs1 = MFMA32(fbuf[0][1], pack_acc<1>(S[2]), qs1);
            qs1 = MFMA32(fbuf[0][2], pack_acc<0>(S[3]), qs1);
            qs1 = MFMA32(fbuf[0][3], pack_acc<1>(S[3]), qs1);
            SB();
            fbuf[0][0] = FRAG(SC_QK, 144, 32 + c, 32 + 8 * h);
            fbuf[0][1] = FRAG(SC_QK, 144, 32 + c, 48 + 8 * h);
            SB();
            _Pragma("unroll") for (int q4 = 0; q4 < 4; ++q4) { const f32x4 g4 = *(const LAS f32x4*)(vec + 0 + 0 + 8 * q4 + 4 * h);
                qs0[4 * q4] *= g4.x; qs0[4 * q4 + 1] *= g4.y; qs0[4 * q4 + 2] *= g4.z; qs0[4 * q4 + 3] *= g4.w; }
            _Pragma("unroll") for (int q4 = 0; q4 < 4; ++q4) { const f32x4 g4 = *(const LAS f32x4*)(vec + 0 + 32 + 8 * q4 + 4 * h);
                qs1[4 * q4] *= g4.x; qs1[4 * q4 + 1] *= g4.y; qs1[4 * q4 + 2] *= g4.z; qs1[4 * q4 + 3] *= g4.w; }
            qs0 = MFMA32(fbuf[1][0], vb[0][0], qs0);
            qs0 = MFMA32(fbuf[1][1], vb[0][1], qs0);
            qs1 = MFMA32(fbuf[1][2], vb[0][0], qs1);
            qs1 = MFMA32(fbuf[1][3], vb[0][1], qs1);
            SB();
            qs1 = MFMA32(fbuf[0][0], vb[1][0], qs1);
            qs1 = MFMA32(fbuf[0][1], vb[1][1], qs1);
            SB();
#endif
            fbuf[0][0] = FRAG(SC_KP, 272, 0 + c, 0 + 8 * h);
            fbuf[0][1] = FRAG(SC_KP, 272, 0 + c, 16 + 8 * h);
            fbuf[0][2] = FRAG(SC_KP, 272, 0 + c, 32 + 8 * h);
            fbuf[0][3] = FRAG(SC_KP, 272, 0 + c, 48 + 8 * h);
            SB();
            fbuf[1][0] = FRAG(SC_KP, 272, 0 + c, 64 + 8 * h);
            fbuf[1][1] = FRAG(SC_KP, 272, 0 + c, 80 + 8 * h);
            fbuf[1][2] = FRAG(SC_KP, 272, 0 + c, 96 + 8 * h);
            fbuf[1][3] = FRAG(SC_KP, 272, 0 + c, 112 + 8 * h);
            SB();
            ks0 = MFMA32(fbuf[0][0], pack_acc<0>(S[0]), zero16());
            ks0 = MFMA32(fbuf[0][1], pack_acc<1>(S[0]), ks0);
            ks0 = MFMA32(fbuf[0][2], pack_acc<0>(S[1]), ks0);
            ks0 = MFMA32(fbuf[0][3], pack_acc<1>(S[1]), ks0);
            SB();
            fbuf[0][0] = FRAG(SC_KP, 272, 32 + c, 0 + 8 * h);
            fbuf[0][1] = FRAG(SC_KP, 272, 32 + c, 16 + 8 * h);
            fbuf[0][2] = FRAG(SC_KP, 272, 32 + c, 32 + 8 * h);
            fbuf[0][3] = FRAG(SC_KP, 272, 32 + c, 48 + 8 * h);
            SB();
            ks0 = MFMA32(fbuf[1][0], pack_acc<0>(S[2]), ks0);
            ks0 = MFMA32(fbuf[1][1], pack_acc<1>(S[2]), ks0);
            ks0 = MFMA32(fbuf[1][2], pack_acc<0>(S[3]), ks0);
            ks0 = MFMA32(fbuf[1][3], pack_acc<1>(S[3]), ks0);
            SB();
            fbuf[1][0] = FRAG(SC_KP, 272, 32 + c, 64 + 8 * h);
            fbuf[1][1] = FRAG(SC_KP, 272, 32 + c, 80 + 8 * h);
            fbuf[1][2] = FRAG(SC_KP, 272, 32 + c, 96 + 8 * h);
            fbuf[1][3] = FRAG(SC_KP, 272, 32 + c, 112 + 8 * h);
            SB();
            ks1 = MFMA32(fbuf[0][0], pack_acc<0>(S[0]), zero16());
            ks1 = MFMA32(fbuf[0][1], pack_acc<1>(S[0]), ks1);
            ks1 = MFMA32(fbuf[0][2], pack_acc<0>(S[1]), ks1);
            ks1 = MFMA32(fbuf[0][3], pack_acc<1>(S[1]), ks1);
            SB();
            fbuf[0][0] = FRAG(SC_T, 144, 0 + c, 0 + 8 * h);
            fbuf[0][1] = FRAG(SC_T, 144, 0 + c, 16 + 8 * h);
            fbuf[0][2] = FRAG(SC_VBT, 144, 32 * w + c, 0 + 8 * h);
            fbuf[0][3] = FRAG(SC_VBT, 144, 32 * w + c, 16 + 8 * h);
            SB();
            ks1 = MFMA32(fbuf[1][0], pack_acc<0>(S[2]), ks1);
            ks1 = MFMA32(fbuf[1][1], pack_acc<1>(S[2]), ks1);
            ks1 = MFMA32(fbuf[1][2], pack_acc<0>(S[3]), ks1);
            ks1 = MFMA32(fbuf[1][3], pack_acc<1>(S[3]), ks1);
            SB();
            fbuf[1][0] = FRAG(SC_T, 144, 32 + c, 0 + 8 * h);
            fbuf[1][1] = FRAG(SC_T, 144, 32 + c, 16 + 8 * h);
            fbuf[1][2] = FRAG(SC_VBT, 144, 32 * w + c, 0 + 8 * h);
            fbuf[1][3] = FRAG(SC_VBT, 144, 32 * w + c, 16 + 8 * h);
            SB();
            _Pragma("unroll") for (int q4 = 0; q4 < 4; ++q4) { const f32x4 g4 = *(const LAS f32x4*)(vec + 64 + 0 + 8 * q4 + 4 * h);
                ks0[4 * q4] *= -g4.x; ks0[4 * q4 + 1] *= -g4.y; ks0[4 * q4 + 2] *= -g4.z; ks0[4 * q4 + 3] *= -g4.w; }
            _Pragma("unroll") for (int q4 = 0; q4 < 4; ++q4) { const f32x4 g4 = *(const LAS f32x4*)(vec + 64 + 32 + 8 * q4 + 4 * h);
                ks1[4 * q4] *= -g4.x; ks1[4 * q4 + 1] *= -g4.y; ks1[4 * q4 + 2] *= -g4.z; ks1[4 * q4 + 3] *= -g4.w; }
            tb[0][0] = pack_acc<0>(ks0); tb[0][1] = pack_acc<1>(ks0); tb[1][0] = pack_acc<0>(ks1); tb[1][1] = pack_acc<1>(ks1);
            vn0 = MFMA32(fbuf[0][0], tb[0][0], zero16());
            vn0 = MFMA32(fbuf[0][0], fbuf[0][2], vn0);
            vn0 = MFMA32(fbuf[0][1], tb[0][1], vn0);
            vn0 = MFMA32(fbuf[0][1], fbuf[0][3], vn0);
            SB();
            fbuf[0][0] = FRAG(SC_T, 144, 32 + c, 32 + 8 * h);
            fbuf[0][1] = FRAG(SC_T, 144, 32 + c, 48 + 8 * h);
            fbuf[0][2] = FRAG(SC_VBT, 144, 32 * w + c, 32 + 8 * h);
            fbuf[0][3] = FRAG(SC_VBT, 144, 32 * w + c, 48 + 8 * h);
            SB();
            vn1 = MFMA32(fbuf[1][0], tb[0][0], zero16());
            vn1 = MFMA32(fbuf[1][0], fbuf[1][2], vn1);
            vn1 = MFMA32(fbuf[1][1], tb[0][1], vn1);
            vn1 = MFMA32(fbuf[1][1], fbuf[1][3], vn1);
            SB();
            fbuf[1][0] = FRAG(SC_QP, 272, 0 + c, 0 + 8 * h);
            fbuf[1][1] = FRAG(SC_QP, 272, 0 + c, 16 + 8 * h);
            fbuf[1][2] = FRAG(SC_QP, 272, 0 + c, 32 + 8 * h);
            fbuf[1][3] = FRAG(SC_QP, 272, 0 + c, 48 + 8 * h);
            SB();
            vn1 = MFMA32(fbuf[0][0], tb[1][0], vn1);
            vn1 = MFMA32(fbuf[0][0], fbuf[0][2], vn1);
            vn1 = MFMA32(fbuf[0][1], tb[1][1], vn1);
            vn1 = MFMA32(fbuf[0][1], fbuf[0][3], vn1);
            SB();
            fbuf[0][0] = FRAG(SC_QP, 272, 0 + c, 64 + 8 * h);
            fbuf[0][1] = FRAG(SC_QP, 272, 0 + c, 80 + 8 * h);
            fbuf[0][2] = FRAG(SC_QP, 272, 0 + c, 96 + 8 * h);
            fbuf[0][3] = FRAG(SC_QP, 272, 0 + c, 112 + 8 * h);
            SB();
            asm volatile("" : "+v"(S[0]), "+v"(S[1]), "+v"(S[2]), "+v"(S[3]));
            vb[0][0] = pack_acc<0>(vn0); vb[0][1] = pack_acc<1>(vn0); vb[1][0] = pack_acc<0>(vn1); vb[1][1] = pack_acc<1>(vn1);
            _Pragma("unroll") for (int q4 = 0; q4 < 4; ++q4) { const f32x4 g4 = *(const LAS f32x4*)(vec + 128 + 0 + 8 * q4 + 4 * h);
                vn0[4 * q4] *= g4.x; vn0[4 * q4 + 1] *= g4.y; vn0[4 * q4 + 2] *= g4.z; vn0[4 * q4 + 3] *= g4.w; }
            _Pragma("unroll") for (int q4 = 0; q4 < 4; ++q4) { const f32x4 g4 = *(const LAS f32x4*)(vec + 128 + 32 + 8 * q4 + 4 * h);
                vn1[4 * q4] *= g4.x; vn1[4 * q4 + 1] *= g4.y; vn1[4 * q4 + 2] *= g4.z; vn1[4 * q4 + 3] *= g4.w; }
            vs[0][0] = pack_acc<0>(vn0); vs[0][1] = pack_acc<1>(vn0); vs[1][0] = pack_acc<0>(vn1); vs[1][1] = pack_acc<1>(vn1);
            qs0 = MFMA32(fbuf[1][0], pack_acc<0>(S[0]), zero16());
            qs0 = MFMA32(fbuf[1][1], pack_acc<1>(S[0]), qs0);
            qs0 = MFMA32(fbuf[1][2], pack_acc<0>(S[1]), qs0);
            qs0 = MFMA32(fbuf[1][3], pack_acc<1>(S[1]), qs0);
            SB();
            fbuf[1][0] = FRAG(SC_QP, 272, 32 + c, 0 + 8 * h);
            fbuf[1][1] = FRAG(SC_QP, 272, 32 + c, 16 + 8 * h);
            fbuf[1][2] = FRAG(SC_QP, 272, 32 + c, 32 + 8 * h);
            fbuf[1][3] = FRAG(SC_QP, 272, 32 + c, 48 + 8 * h);
            SB();
            qs0 = MFMA32(fbuf[0][0], pack_acc<0>(S[2]), qs0);
            qs0 = MFMA32(fbuf[0][1], pack_acc<1>(S[2]), qs0);
            qs0 = MFMA32(fbuf[0][2], pack_acc<0>(S[3]), qs0);
            qs0 = MFMA32(fbuf[0][3], pack_acc<1>(S[3]), qs0);
            SB();
            fbuf[0][0] = FRAG(SC_QP, 272, 32 + c, 64 + 8 * h);
            fbuf[0][1] = FRAG(SC_QP, 272, 32 + c, 80 + 8 * h);
            fbuf[0][2] = FRAG(SC_QP, 272, 32 + c, 96 + 8 * h);
            fbuf[0][3] = FRAG(SC_QP, 272, 32 + c, 112 + 8 * h);
            SB();
            qs1 = MFMA32(fbuf[1][0], pack_acc<0>(S[0]), zero16());
            qs1 = MFMA32(fbuf[1][1], pack_acc<1>(S[0]), qs1);
            qs1 = MFMA32(fbuf[1][2], pack_acc<0>(S[1]), qs1);
            qs1 = MFMA32(fbuf[1][3], pack_acc<1>(S[1]), qs1);
            SB();
            fbuf[1][0] = FRAG(SC_QK, 144, 0 + c, 0 + 8 * h);
            fbuf[1][1] = FRAG(SC_QK, 144, 0 + c, 16 + 8 * h);
            fbuf[1][2] = FRAG(SC_QK, 144, 32 + c, 0 + 8 * h);
            fbuf[1][3] = FRAG(SC_QK, 144, 32 + c, 16 + 8 * h);
            SB();
            qs1 = MFMA32(fbuf[0][0], pack_acc<0>(S[2]), qs1);
            qs1 = MFMA32(fbuf[0][1], pack_acc<1>(S[2]), qs1);
            qs1 = MFMA32(fbuf[0][2], pack_acc<0>(S[3]), qs1);
            qs1 = MFMA32(fbuf[0][3], pack_acc<1>(S[3]), qs1);
            SB();
            fbuf[0][0] = FRAG(SC_QK, 144, 32 + c, 32 + 8 * h);
            fbuf[0][1] = FRAG(SC_QK, 144, 32 + c, 48 + 8 * h);
            SB();
            _Pragma("unroll") for (int q4 = 0; q4 < 4; ++q4) { const f32x4 g4 = *(const LAS f32x4*)(vec + 0 + 0 + 8 * q4 + 4 * h);
                qs0[4 * q4] *= g4.x; qs0[4 * q4 + 1] *= g4.y; qs0[4 * q4 + 2] *= g4.z; qs0[4 * q4 + 3] *= g4.w; }
            _Pragma("unroll") for (int q4 = 0; q4 < 4; ++q4) { const f32x4 g4 = *(const LAS f32x4*)(vec + 0 + 32 + 8 * q4 + 4 * h);
                qs1[4 * q4] *= g4.x; qs1[4 * q4 + 1] *= g4.y; qs1[4 * q4 + 2] *= g4.z; qs1[4 * q4 + 3] *= g4.w; }
            qs0 = MFMA32(fbuf[1][0], vb[0][0], qs0);
            qs0 = MFMA32(fbuf[1][1], vb[0][1], qs0);
            qs1 = MFMA32(fbuf[1][2], vb[0][0], qs1);
            qs1 = MFMA32(fbuf[1][3], vb[0][1], qs1);
            SB();
            fbuf[1][0] = FRAG(SC_KT, 144, 0 + c, 0 + 8 * h);
            fbuf[1][1] = FRAG(SC_KT, 144, 0 + c, 16 + 8 * h);
            fbuf[1][2] = FRAG(SC_KT, 144, 0 + c, 32 + 8 * h);
            fbuf[1][3] = FRAG(SC_KT, 144, 0 + c, 48 + 8 * h);
            SB();
            qs1 = MFMA32(fbuf[0][0], vb[1][0], qs1);
            qs1 = MFMA32(fbuf[0][1], vb[1][1], qs1);
            SB();
            fbuf[0][0] = FRAG(SC_KT, 144, 32 + c, 0 + 8 * h);
            fbuf[0][1] = FRAG(SC_KT, 144, 32 + c, 16 + 8 * h);
            fbuf[0][2] = FRAG(SC_KT, 144, 32 + c, 32 + 8 * h);
            fbuf[0][3] = FRAG(SC_KT, 144, 32 + c, 48 + 8 * h);
            SB();
            { const float dec = vec[192];
            _Pragma("unroll") for (int dt = 0; dt < 4; ++dt) _Pragma("unroll") for (int r = 0; r < 16; ++r) S[dt][r] *= dec; }
            S[0] = MFMA32(fbuf[1][0], vs[0][0], S[0]);
            S[0] = MFMA32(fbuf[1][1], vs[0][1], S[0]);
            S[0] = MFMA32(fbuf[1][2], vs[1][0], S[0]);
            S[0] = MFMA32(fbuf[1][3], vs[1][1], S[0]);
            SB();
            fbuf[1][0] = FRAG(SC_KT, 144, 64 + c, 0 + 8 * h);
            fbuf[1][1] = FRAG(SC_KT, 144, 64 + c, 16 + 8 * h);
            fbuf[1][2] = FRAG(SC_KT, 144, 64 + c, 32 + 8 * h);
            fbuf[1][3] = FRAG(SC_KT, 144, 64 + c, 48 + 8 * h);
            SB();
            S[1] = MFMA32(fbuf[0][0], vs[0][0], S[1]);
            S[1] = MFMA32(fbuf[0][1], vs[0][1], S[1]);
            S[1] = MFMA32(fbuf[0][2], vs[1][0], S[1]);
            S[1] = MFMA32(fbuf[0][3], vs[1][1], S[1]);
            SB();
            fbuf[0][0] = FRAG(SC_KT, 144, 96 + c, 0 + 8 * h);
            fbuf[0][1] = FRAG(SC_KT, 144, 96 + c, 16 + 8 * h);
            fbuf[0][2] = FRAG(SC_KT, 144, 96 + c, 32 + 8 * h);
            fbuf[0][3] = FRAG(SC_KT, 144, 96 + c, 48 + 8 * h);
            SB();
            S[2] = MFMA32(fbuf[1][0], vs[0][0], S[2]);
            S[2] = MFMA32(fbuf[1][1], vs[0][1], S[2]);
            S[2] = MFMA32(fbuf[1][2], vs[1][0], S[2]);
            S[2] = MFMA32(fbuf[1][3], vs[1][1], S[2]);
            SB();
            S[3] = MFMA32(fbuf[0][0], vs[0][0], S[3]);
            S[3] = MFMA32(fbuf[0][1], vs[0][1], S[3]);
            S[3] = MFMA32(fbuf[0][2], vs[1][0], S[3]);
            S[3] = MFMA32(fbuf[0][3], vs[1][1], S[3]);
            SB();
#pragma unroll
            for (int r = 0; r < 16; ++r) { *(LAS unsigned short*)(lds + SC_OST + crow(r, h) * SC_OST_LD + (32 * w + c) * 2) = f2bf16(qs0[r]);
                *(LAS unsigned short*)(lds + SC_OST + (32 + crow(r, h)) * SC_OST_LD + (32 * w + c) * 2) = f2bf16(qs1[r]); }
#undef SB
#undef FRAG
            }
            asm volatile("s_waitcnt vmcnt(0)" ::: "memory");
            __syncthreads();
            if (tid == 0 && n > 0) __hip_atomic_store(prog + 1, (unsigned)n, __ATOMIC_RELAXED, __HIP_MEMORY_SCOPE_AGENT);
            { GAS unsigned char* ob_ = (GAS unsigned char*)(GO + (size_t)(b * SEQ + n * 64) * GVAL + h_ * 128);
              unsigned to_ = (unsigned)tid; asm volatile("" : "+v"(to_));
#pragma unroll
              for (int i = 0; i < 4; ++i) { const unsigned id = to_ + 256u * i, row = id >> 4, ch = id & 15u;
                  const v4u v = *(const LAS v4u*)(lds + SC_OST + row * SC_OST_LD + ch * 16);
                  GAS unsigned char* ga = ob_ + (size_t)row * (GVAL * 2) + ch * 16;
                  asm volatile("global_store_dwordx4 %0, %1, off sc1\n\ts_nop 1" :: "v"(ga), "v"(v) : "memory"); } }
            __syncthreads();
        }
        asm volatile("s_waitcnt vmcnt(0)" ::: "memory");
        __syncthreads();
        if (tid == 0) __hip_atomic_store(prog + 1, 64u, __ATOMIC_RELAXED, __HIP_MEMORY_SCOPE_AGENT);
        { float* so = p.out + O_GDNP + (size_t)(b * 32 + h_) * 128 * 128;
#pragma unroll
          for (int dt = 0; dt < 4; ++dt)
#pragma unroll
              for (int r = 0; r < 16; ++r) so[(size_t)(32 * dt + crow(r, h)) * 128 + 32 * wave + c] = S[dt][r]; }
    }
#undef SCAN_FETCH
#undef SCAN_PUT
}

DI void gdn_sample_unit(const P& p, int unit, LAS unsigned char* lds, int tid, int wave, int lane) {
    asm volatile("" : "+v"(tid), "+v"(lane));
    const int h_ = unit & 31, b = unit >> 5, kh = h_ >> 1;
    const bf16* PROJ = (const bf16*)(p.ws + WS_BIG);
    const float* BA = (const float*)(p.ws + WS_BA);
    bf16* GO = (bf16*)(p.ws + WS_GO);
    LAS float* L = (LAS float*)lds;
    __syncthreads();
    if (tid < 384) { const int which = tid >> 7, i = tid & 127;
        const int pc = which == 0 ? kh * 128 + i : (which == 1 ? 2048 + kh * 128 + i : 4096 + h_ * 128 + i);
        float x[7];
#pragma unroll
        for (int j = 0; j < 3; ++j) x[j] = p.state_gconv[(size_t)(b * 3 + j) * 8192 + pc];
#pragma unroll
        for (int t = 0; t < 4; ++t) x[3 + t] = bf2f(PROJ[(size_t)(MPROMPT + 4 * b + t) * NGINP + pc]);
        const float w0 = p.gconv_w[pc], w1 = p.gconv_w[8192 + pc], w2 = p.gconv_w[2 * 8192 + pc], w3 = p.gconv_w[3 * 8192 + pc];
#pragma unroll
        for (int t = 0; t < 4; ++t) L[which * 512 + t * 128 + i] = silu_f(w0 * x[t] + w1 * x[t + 1] + w2 * x[t + 2] + w3 * x[t + 3]);
#pragma unroll
        for (int r = 0; r < 3; ++r) p.out[O_GCS + (size_t)(b * 3 + r) * 8192 + pc] = x[4 + r];
    } else if (tid < 388) { const int t = tid - 384; const size_t row = MPROMPT + 4 * b + t;
        const float bv = BA[row * 64 + h_], av = BA[row * 64 + 32 + h_];
        L[2560 + t] = sigmoid_f(bv); L[2564 + t] = __expf(-__expf(p.a_log[h_]) * softplus_f(av + p.dt_bias[h_])); }
    __syncthreads();
    { LAS float* r = L + (wave < 4 ? 0 : 512) + (wave & 3) * 128; const float a = r[lane], c2 = r[lane + 64];
      const float rs = rsqrtf(wave_sum(a * a + c2 * c2) + NORM_EPS) * (wave < 4 ? 0.08838834764831845f : 1.f);
      r[lane] = a * rs; r[lane + 64] = c2 * rs; }
    __syncthreads();
    const int v = tid & 127, dg = tid >> 7;
    float S[32];
    const float* s0 = p.state_gdn + ((size_t)(b * 32 + h_) * 128 + 32 * dg) * 128 + v;
#pragma unroll
    for (int i = 0; i < 32; ++i) S[i] = __builtin_nontemporal_load(s0 + (size_t)i * 128);
#pragma unroll 1
    for (int t = 0; t < 4; ++t) {
        const float eg = L[2564 + t], beta = L[2560 + t];
        const LAS float* kk = L + 512 + t * 128 + 32 * dg; const LAS float* qq = L + t * 128 + 32 * dg;
        float part = 0.f;
#pragma unroll
        for (int i = 0; i < 32; ++i) { S[i] *= eg; part += S[i] * kk[i]; }
        L[1536 + dg * 128 + v] = part;
        __syncthreads();
        const float kv = (L[1536 + v] + L[1536 + 128 + v]) + (L[1536 + 256 + v] + L[1536 + 384 + v]);
        const float vnew = beta * (L[1024 + t * 128 + v] - kv);
        __syncthreads();
        float part2 = 0.f;
#pragma unroll
        for (int i = 0; i < 32; ++i) { S[i] += kk[i] * vnew; part2 += S[i] * qq[i]; }
        L[1536 + dg * 128 + v] = part2;
        __syncthreads();
        if (dg == 0) L[2048 + t * 128 + v] = (L[1536 + v] + L[1536 + 128 + v]) + (L[1536 + 256 + v] + L[1536 + 384 + v]);
        __syncthreads();
    }
    float* so = p.out + O_GDNS + ((size_t)(b * 32 + h_) * 128 + 32 * dg) * 128 + v;
#pragma unroll
    for (int i = 0; i < 32; ++i) __builtin_nontemporal_store(S[i], so + (size_t)i * 128);
    if (wave < 4) { const int t = wave; const size_t row = MPROMPT + 4 * b + t;
        const float o1 = L[2048 + t * 128 + lane], o2 = L[2048 + t * 128 + lane + 64];
        const float rs = rsqrtf(wave_sum(o1 * o1 + o2 * o2) * (1.f / 128.f) + NORM_EPS);
        const float z1 = bf2f(PROJ[row * NGINP + 8192 + h_ * 128 + lane]), z2 = bf2f(PROJ[row * NGINP + 8192 + h_ * 128 + lane + 64]);
        GO[row * GVAL + h_ * 128 + lane] = f2bf16(o1 * rs * p.out_norm[lane] * silu_f(z1));
        GO[row * GVAL + h_ * 128 + lane + 64] = f2bf16(o2 * rs * p.out_norm[lane + 64] * silu_f(z2)); }
}

DI void gdn_gate_phase(const P& p, int tid) {
    const bf16* PROJ = (const bf16*)(p.ws + WS_BIG);
    bf16* GO = (bf16*)(p.ws + WS_GO);
    const int NT = gridDim.x * 512;
    float gn[32];
#pragma unroll
    for (int i = 0; i < 32; ++i) gn[i] = p.out_norm[(tid & 3) * 32 + i];
    for (int t = blockIdx.x * 512 + tid; t < MPROMPT * 128; t += NT) {
        const int part = t & 3, hd = (t >> 2) & 31, row = t >> 7;
        bf16* gp = GO + (size_t)row * GVAL + hd * 128 + part * 32;
        const bf16* zp = PROJ + (size_t)row * NGINP + 8192 + hd * 128 + part * 32;
        v4u ow[4], zw[4];
#pragma unroll
        for (int i = 0; i < 4; ++i) { ow[i] = *(const GAS v4u*)(gp + 8 * i); zw[i] = *(const GAS v4u*)(zp + 8 * i); }
        float x[32]; float ss = 0.f;
#pragma unroll
        for (int i = 0; i < 4; ++i) { float u[8]; unpack8(ow[i], u);
#pragma unroll
            for (int e = 0; e < 8; ++e) { x[8 * i + e] = u[e]; ss += u[e] * u[e]; } }
        ss += __shfl_xor(ss, 1); ss += __shfl_xor(ss, 2);
        const float rs = rsqrtf(ss * (1.f / 128.f) + NORM_EPS);
#pragma unroll
        for (int i = 0; i < 4; ++i) { float z[8], y[8]; unpack8(zw[i], z);
#pragma unroll
            for (int e = 0; e < 8; ++e) y[e] = x[8 * i + e] * rs * gn[8 * i + e] * z[e] * __builtin_amdgcn_rcpf(1.f + __expf(-z[e]));
            *(GAS v4u*)(gp + 8 * i) = pack8f(y); }
    }
}

struct PrefetchCursor { int next; unsigned pad; };
constexpr int PF_PAD_OFF = 143360;
DI void scan_prefetch_tick(const P& p, int u, int j, PrefetchCursor& pc, int tid) {
    if (pc.next >= 64) return;
    const gu32* prog = (const gu32*)(p.ws + WS_CTL) + CW_PROG + 64 * u;
    const int done = __builtin_amdgcn_readfirstlane((int)__hip_atomic_load(prog, __ATOMIC_RELAXED, __HIP_MEMORY_SCOPE_AGENT));
    if (pc.next < done + 2) pc.next = done + 2;
    const int h_ = u & 31, b = u >> 5, kh = h_ >> 1;
    int tq = tid; asm volatile("" : "+v"(tq));
#pragma unroll 1
    while (pc.next < 64 && pc.next <= done + 6) {
        const int n = pc.next;
        const int l = tq < 216 ? 3 * tq + j : j;
        const unsigned char* g = l < 384 ? p.ws + WS_KQ + (size_t)((b * 16 + kh) * 64 + n) * 49152 + l * 128
                               : (l < 640 ? p.ws + WS_TH + (size_t)((b * 32 + h_) * 64 + n) * 32768 + (l - 384) * 128
                                          : p.ws + WS_VEC + (size_t)((b * 32 + h_) * 64 + n) * 1024 + (l - 640) * 128);
        unsigned keep; asm volatile("s_mov_b32 %0, m0\n\ts_mov_b32 m0, %2\n\ts_nop 0\n\tglobal_load_lds_dword %1, off\n\ts_mov_b32 m0, %0" : "=&s"(keep) : "v"(g), "s"(pc.pad) : "memory");
        pc.next = n + 1;
    }
}

DI void scan_gate_chunk(const P& p, int u, int m, int tid) {
    const int h_ = u & 31, b = u >> 5;
    const bf16* PROJ = (const bf16*)(p.ws + WS_BIG);
    bf16* GO = (bf16*)(p.ws + WS_GO);
    if (tid < 256) { const int t = tid >> 2, part = tid & 3; const int row = b * SEQ + m * 64 + t;
        bf16* gp = GO + (size_t)row * GVAL + h_ * 128 + part * 32;
        const bf16* zp = PROJ + (size_t)row * NGINP + 8192 + h_ * 128 + part * 32;
        v4u ow[4], zw[4];
#pragma unroll
        for (int i = 0; i < 4; ++i) { ow[i] = *(const GAS v4u*)(gp + 8 * i); zw[i] = *(const GAS v4u*)(zp + 8 * i); }
        float x[32]; float ss = 0.f;
#pragma unroll
        for (int i = 0; i < 4; ++i) { float uu[8]; unpack8(ow[i], uu);
#pragma unroll
            for (int e = 0; e < 8; ++e) { x[8 * i + e] = uu[e]; ss += uu[e] * uu[e]; } }
        ss += __shfl_xor(ss, 1); ss += __shfl_xor(ss, 2);
        const float rs = rsqrtf(ss * (1.f / 128.f) + NORM_EPS);
#pragma unroll
        for (int i = 0; i < 4; ++i) { float z[8], y[8]; unpack8(zw[i], z);
#pragma unroll
            for (int e = 0; e < 8; ++e) y[e] = x[8 * i + e] * rs * p.out_norm[part * 32 + 8 * i + e] * z[e] * __builtin_amdgcn_rcpf(1.f + __expf(-z[e]));
            *(GAS v4u*)(gp + 8 * i) = pack8f(y); } }
}
DI void scan_gate_tick(const P& p, int u, int j, int& gnext, int tid) {
    if (gnext >= 64) return;
    const gu32* prog = (const gu32*)(p.ws + WS_CTL) + CW_PROG + 64 * u + 1;
    const int gdone = __builtin_amdgcn_readfirstlane((int)__hip_atomic_load(prog, __ATOMIC_RELAXED, __HIP_MEMORY_SCOPE_AGENT));
    if (gnext >= gdone) return;
    __builtin_amdgcn_fence(__ATOMIC_ACQUIRE, "agent");
    asm volatile("s_waitcnt vmcnt(0)" ::: "memory");
#pragma unroll 1
    while (gnext < gdone) { scan_gate_chunk(p, u, gnext, tid); gnext += 3; }
}

constexpr int SG_LD = 144;
constexpr int SG_A = 0, SG_B = 2 * 128 * SG_LD, SG_END = SG_B + 2 * 64 * SG_LD;
template <class Epi>
DI void small_gemm_tile(LAS unsigned char* lds, const bf16* A, int lda, int row0, const bf16* Bt, int K, int col0, int kbeg, int nk, const Epi& E, int tid, int wave, int lane) {
    const int c = lane & 31, h = lane >> 5, wm = wave >> 1, wn = wave & 1;
    const int ar0 = tid >> 3, part = tid & 7;
    const bf16* ga0 = A + (size_t)(row0 + ar0) * lda + kbeg + part * 8;
    const bf16* ga1 = ga0 + (size_t)64 * lda;
    const bf16* gb = Bt + (size_t)(col0 + ar0) * K + kbeg + part * 8;
    v4u ra0[4], ra1[4], rb[4];
#pragma unroll
    for (int j = 0; j < 4; ++j) { ra0[j] = *(const GAS v4u*)(ga0 + (size_t)j * 64); ra1[j] = *(const GAS v4u*)(ga1 + (size_t)j * 64); rb[j] = *(const GAS v4u*)(gb + (size_t)j * 64); }
    __syncthreads();
    *(LAS v4u*)(lds + SG_A + ar0 * SG_LD + part * 16) = ra0[0]; *(LAS v4u*)(lds + SG_A + (ar0 + 64) * SG_LD + part * 16) = ra1[0]; *(LAS v4u*)(lds + SG_B + ar0 * SG_LD + part * 16) = rb[0];
    __syncthreads();
    f32x16 acc = zero16();
#pragma unroll 1
    for (int ks0 = 0; ks0 < nk; ks0 += 4) {
#pragma unroll
        for (int j = 0; j < 4; ++j) {
            const int ks = ks0 + j, cur = j & 1, nx = cur ^ 1, jn = (j + 1) & 3;
            if (ks + 4 < nk) { ra0[j] = *(const GAS v4u*)(ga0 + (size_t)(ks + 4) * 64); ra1[j] = *(const GAS v4u*)(ga1 + (size_t)(ks + 4) * 64); rb[j] = *(const GAS v4u*)(gb + (size_t)(ks + 4) * 64); }
            const LAS unsigned char* ap = lds + SG_A + cur * 128 * SG_LD + (32 * wm + c) * SG_LD + 16 * h;
            const LAS unsigned char* bp = lds + SG_B + cur * 64 * SG_LD + (32 * wn + c) * SG_LD + 16 * h;
#pragma unroll
            for (int s = 0; s < 4; ++s) { const bf16x8 a = *(const LAS bf16x8*)(ap + 32 * s), b = *(const LAS bf16x8*)(bp + 32 * s); acc = MFMA32(a, b, acc); }
            if (ks + 1 < nk) {
                *(LAS v4u*)(lds + SG_A + nx * 128 * SG_LD + ar0 * SG_LD + part * 16) = ra0[jn]; *(LAS v4u*)(lds + SG_A + nx * 128 * SG_LD + (ar0 + 64) * SG_LD + part * 16) = ra1[jn];
                *(LAS v4u*)(lds + SG_B + nx * 64 * SG_LD + ar0 * SG_LD + part * 16) = rb[jn]; }
            __syncthreads();
        }
    }
#pragma unroll
    for (int r = 0; r < 16; ++r) E(row0 + 32 * wm + crow(r, h), col0 + 32 * wn + c, acc[r]);
}
struct SEpiBf16 { bf16* O; int ldc; DI void operator()(int row, int col, float v) const { O[(size_t)row * ldc + col] = f2bf16(v); } };
struct SEpiUpSample { bf16* U; DI void operator()(int row, int col, float v) const { const int t = col >> 8, r = col & 255; U[(size_t)row * NUP + (r < 128 ? 128 * t + r : DFF + 128 * t + (r - 128))] = f2bf16(v); } };
struct SEpiF32 { float* O; int ldc; int col_off; DI void operator()(int row, int col, float v) const { O[(size_t)row * ldc + col - col_off] = v; } };
struct SEpiF32N { float* O; int ldc; int col_off; const float* ssq; const float* cv; int ldcv; DI void operator()(int row, int col, float v) const {
    if (row < MPROMPT) v = v * rsqrtf(ssq[row] * (1.f / DM) + NORM_EPS) + cv[(size_t)(row >> 12) * ldcv + col];
    O[(size_t)row * ldc + col - col_off] = v; } };
struct SEpiResid { const float* xin_s; float* xout_s; const float* gate; DI void operator()(int row, int col, float v) const { const int rs = row - MPROMPT;
    xout_s[(size_t)rs * DM + col] = xin_s[(size_t)rs * DM + col] + gate[(size_t)(2 + (rs >> 2)) * MODW + col] * v; } };
struct SEpiResidAdd { float* xs; const float* gate; DI void operator()(int row, int col, float v) const { const int rs = row - MPROMPT;
    atomicAdd(xs + (size_t)rs * DM + col, gate[(size_t)(2 + (rs >> 2)) * MODW + col] * v); } };
template <class Epi>
DI void small_gemm_phase(LAS unsigned char* lds, const bf16* A, int lda, int rowbase, int nrb, const bf16* Bt, int K, int colbase, int ncb, const Epi& E, int tid, int wave, int lane, int ksplit = 1, int rot = 0) {
    const int G = gridDim.x, first = (2 * G - 1 - (int)blockIdx.x - rot % G) % G, nt = nrb * ncb * ksplit, nks = (K >> 6) / ksplit;
    for (int i = first; i < nt; i += G) { const int ks = i % ksplit, t = i / ksplit, rb = t / ncb, cb = t - rb * ncb;
        small_gemm_tile(lds, A, lda, rowbase + 128 * rb, Bt, K, colbase + 64 * cb, ks * nks * 64, nks, E, tid, wave, lane); }
}

#ifndef MK_N_LAUNCHES
#define MK_N_LAUNCHES 1
#endif
constexpr int N_PHASES = 19;
#ifndef PROBE_MASK
#define PROBE_MASK 0u
#endif
#define REPS(k) (((PROBE_MASK >> (k)) & 1u) ? 2 : 1)
#ifndef CHUNK_STAGGER
#define CHUNK_STAGGER 0
#endif
#ifndef CHUNK_NOST
#define CHUNK_NOST 0
#endif
#ifndef STAGGER_BATCHES
#define STAGGER_BATCHES 2
#endif
struct Args { const float* in[29]; float* out; unsigned char* ws; int ph_lo, ph_hi, one, pad; };
static_assert(sizeof(Args) == 31 * 8 + 16, "Args has no padding");

__global__ void __launch_bounds__(512, 2) hybrid_fwd(Args args) {
    extern __shared__ __attribute__((aligned(16))) unsigned char lds_raw[];
    LAS unsigned char* lds = (LAS unsigned char*)lds_raw;
    volatile LAS unsigned* MISC = (volatile LAS unsigned*)(lds + MISC_OFF);
    const int tid0 = threadIdx.x;
    const int G = gridDim.x;
#define PHASE_IDS int tid = tid0; asm volatile("" : "+v"(tid)); const int lane = tid & 63, wave = __builtin_amdgcn_readfirstlane(tid >> 6); (void)lane; (void)wave;
    P p;     p.x_prompt = args.in[0]; p.x_sample = args.in[1]; p.c_prompt = args.in[2]; p.c_sample = args.in[3]; p.cache_k = args.in[4]; p.cache_v = args.in[5];     p.state_gdn = args.in[6]; p.state_gconv = args.in[7]; p.state_fconv = args.in[8]; p.rel_table = args.in[9]; p.w_ada = args.in[10]; p.b_ada = args.in[11];     p.norm_mix = args.in[12]; p.norm_ffn = args.in[13]; p.w_qkv = args.in[14]; p.q_norm = args.in[15]; p.k_norm = args.in[16]; p.sinks = args.in[17]; p.w_o = args.in[18];     p.w_gin = args.in[19]; p.gconv_w = args.in[20]; p.a_log = args.in[21]; p.dt_bias = args.in[22]; p.out_norm = args.in[23]; p.w_gout = args.in[24];     p.w_up = args.in[25]; p.fconv_w = args.in[26]; p.fconv_b = args.in[27]; p.w_dn = args.in[28];     p.out = args.out; p.ws = args.ws;
    unsigned char* ws = args.ws;
    for (int u = tid0; u < (LDS_BYTES - MISC_OFF) / 4; u += 512) ((LAS unsigned*)(lds + MISC_OFF))[u] = 0u;
    __syncthreads();
    XcdBarrier bar; bar.bar = (unsigned*)(ws + WS_CTL) + CW_BAR; bar.x = 0; bar.st = nullptr;
    if (MK_N_LAUNCHES == 1) bar = xcd_barrier_post((unsigned*)(ws + WS_CTL) + CW_BAR, MISC + 8);
    const int lo = args.ph_lo, hi = args.ph_hi;
    const int hot1 = args.one;
#ifndef ONLY_MASK
#define ONLY_MASK 0x7FFFFu
#endif
#define IN(k) (((ONLY_MASK >> (k)) & 1u) && lo <= (k) && (k) < hi)
#ifndef BARRIER_DUP
#define BARRIER_DUP 1
#endif
#define SEAM(k) do { if (IN(k) && IN((k) + 1)) { _Pragma("unroll") for (int bd_ = 0; bd_ < BARRIER_DUP; ++bd_) xcd_barrier(bar); } } while (0)
    float* XR = args.out + O_Y;
    const float* mod = (const float*)(ws + WS_MOD);
    bf16* H = (bf16*)(ws + WS_H);
    float* SSQ = (float*)(ws + WS_CTL) + CW_SSQ; const float* CV = (const float*)(ws + WS_CTL) + CW_CV;

    if (IN(0)) _Pragma("unroll") for (int rep = 0; rep < REPS(0); ++rep) { PHASE_IDS p0_phase(p, lds, MISC, tid, wave, lane, rep); } SEAM(0);
    if (IN(1)) _Pragma("unroll") for (int rep = 0; rep < REPS(1); ++rep) { PHASE_IDS norm_phase(p.x_prompt, p.x_sample, p.norm_mix, mod, 0, H, tid, wave, lane, XR + (size_t)MPROMPT * DM); } SEAM(1);
    if (IN(2)) _Pragma("unroll") for (int rep = 0; rep < REPS(2); ++rep) { PHASE_IDS pg8::Gemm g{H, (const bf16*)(ws + WS_WQKV), MPROMPT, NQKV, DM}; pg8::StaticOrder S; S.init(MPROMPT, NQKV, G, (int)blockIdx.x);
        pg8::EpiStore E{(bf16*)(ws + WS_QKV), NQKV, nullptr, -1};
        pg8::gemm_phase<pg8::EpiStore, pg8::StaticOrder, true, true>(lds, g, S, E);
        small_gemm_phase(lds, H, DM, MPROMPT, 1, (const bf16*)(ws + WS_WQKV), DM, 0, NQKV / 64, SEpiBf16{(bf16*)(ws + WS_QKV), NQKV}, tid, wave, lane);
        convert_queue(p, 2 * 1 + rep, IT_UP0, IT_DN0, lds, MISC, tid, wave, lane); } SEAM(2);
    if (IN(3)) _Pragma("unroll") for (int rep = 0; rep < REPS(3); ++rep) { PHASE_IDS attn_phase(p, lds, tid, wave, lane); } SEAM(3);
    if (IN(4)) _Pragma("unroll") for (int rep = 0; rep < REPS(4); ++rep) { PHASE_IDS pg8::Gemm g{(const bf16*)(ws + WS_AO), (const bf16*)(ws + WS_WO), MPROMPT, DM, DM}; pg8::StaticOrder S; S.init(MPROMPT, DM, G, (int)blockIdx.x);
        pg8::EpiResidN E{p.x_prompt, XR, mod + 2 * DM, H, p.norm_ffn, mod + 3 * DM, SSQ};
        pg8::gemm_phase<pg8::EpiResidN, pg8::StaticOrder, true, true>(lds, g, S, E);
        small_gemm_phase(lds, (const bf16*)(ws + WS_AO), DM, MPROMPT, 1, (const bf16*)(ws + WS_WO), DM, 0, DM / 64, SEpiResidAdd{XR + (size_t)MPROMPT * DM, mod + 2 * DM}, tid, wave, lane, 8);
        convert_queue(p, 2 * 2 + rep, IT_DN0, IT_GIN, lds, MISC, tid, wave, lane); } SEAM(4);
    if (IN(6)) _Pragma("unroll") for (int rep = 0; rep < REPS(6); ++rep) { PHASE_IDS sample_prenorm(p, 0, XR, p.norm_ffn, mod, 3, H, tid, wave, lane);
        pg8::Gemm g{H, (const bf16*)(ws + WS_WUP0), MPROMPT, NUP, DM}; pg8::StaticOrder S; S.init(MPROMPT, NUP, G, (int)blockIdx.x);
        pg8::EpiAct E{(bf16*)(ws + WS_ACT), (bf16*)(ws + WS_BIG), p.fconv_w + (size_t)0 * 3 * NUP, p.fconv_b + (size_t)0 * NUP, lds};
        pg8::PrefOrder PS{S, lds, SSQ, CV + CV_UP0, NUP, p.fconv_w + (size_t)0 * 3 * NUP, p.fconv_b + (size_t)0 * NUP};
        if ((int)blockIdx.x >= (MPROMPT / 256) * (NUP / 256) % G) { convert_queue(p, 2 * 3 + rep, IT_GIN, IT_GIN_MID, lds, MISC, tid, wave, lane, STAGGER_BATCHES); __syncthreads(); }
        pg8::gemm_phase<pg8::EpiAct, pg8::PrefOrder, true, true>(lds, g, PS, E);
        sample_prenorm_wait(p, 0, tid);
        small_gemm_phase(lds, H, DM, MPROMPT, 1, (const bf16*)(ws + WS_WUP0), DM, 0, NUP / 64, SEpiUpSample{(bf16*)(ws + WS_BIG)}, tid, wave, lane);
        convert_queue(p, 2 * 3 + rep, IT_GIN, IT_GIN_MID, lds, MISC, tid, wave, lane); } SEAM(6);
    if (IN(7)) _Pragma("unroll") for (int rep = 0; rep < REPS(7); ++rep) { PHASE_IDS ffn_act_phase(p, 0, tid); } SEAM(7);
    if (IN(8)) _Pragma("unroll") for (int rep = 0; rep < REPS(8); ++rep) { PHASE_IDS pg8::Gemm g{(const bf16*)(ws + WS_ACT), (const bf16*)(ws + WS_WDN0), MPROMPT, DM, DFF}; pg8::StaticOrder S; S.init(MPROMPT, DM, G, (int)blockIdx.x);
        pg8::EpiResidN E{XR, XR, mod + 5 * DM, H, p.norm_mix + DM, mod + (size_t)NMODROW * MODW, SSQ + 8192};
        pg8::gemm_phase<pg8::EpiResidN, pg8::StaticOrder, true, true>(lds, g, S, E);
        small_gemm_phase(lds, (const bf16*)(ws + WS_ACT), DFF, MPROMPT, 1, (const bf16*)(ws + WS_WDN0), DFF, 0, DM / 64, SEpiResidAdd{XR + (size_t)MPROMPT * DM, mod + 5 * DM}, tid, wave, lane, 11);
        convert_queue(p, 2 * 4 + rep, IT_GIN_MID, IT_GOUT, lds, MISC, tid, wave, lane); } SEAM(8);
    const float* mod1 = mod + (size_t)NMODROW * MODW;
    if (IN(10)) _Pragma("unroll") for (int rep = 0; rep < REPS(10); ++rep) { PHASE_IDS sample_prenorm(p, 1, XR, p.norm_mix + DM, mod1, 0, H, tid, wave, lane);
        pg8::Gemm g{H, (const bf16*)(ws + WS_WGIN), MPROMPT, 12288, DM}; pg8::StaticOrder S; S.init(MPROMPT, 12288, G, (int)blockIdx.x);
        pg8::EpiStoreN E{(bf16*)(ws + WS_BIG), NGINP, nullptr, -1, lds};
        pg8::PrefOrder PS{S, lds, SSQ + 8192, CV + CV_GIN, NGIN, nullptr, nullptr};
        const bool early = (((int)blockIdx.x >> 3) & 1) != 0;
#define P10_SMALL { sample_prenorm_wait(p, 1, tid); \
            small_gemm_phase(lds, H, DM, MPROMPT, 1, (const bf16*)(ws + WS_WGIN), DM, 0, 12288 / 64, SEpiBf16{(bf16*)(ws + WS_BIG), NGINP}, tid, wave, lane);            \
            small_gemm_phase(lds, H, DM, 0, MTOK / 128, (const bf16*)(ws + WS_WGIN), DM, 12288, 1, SEpiF32N{(float*)(ws + WS_BA), 64, 12288, SSQ + 8192, CV + CV_GIN, NGIN}, tid, wave, lane, 1, 12288 / 64);     \
            __syncthreads(); }
        if (early) P10_SMALL
        pg8::gemm_phase<pg8::EpiStoreN, pg8::PrefOrder, true, true>(lds, g, PS, E);
        if (!early) P10_SMALL
#undef P10_SMALL
        } SEAM(10);
    if (IN(11)) _Pragma("unroll") for (int rep = 0; rep < REPS(11); ++rep) { PHASE_IDS
        if (CHUNK_STAGGER > 0) { const int grp = ((int)blockIdx.x >> 3) & 7; _Pragma("unroll 1") for (int zz = 0; zz < CHUNK_STAGGER * grp; ++zz) __builtin_amdgcn_s_sleep(32); }
        if (REPS(11) == 2 && rep == 0 && CHUNK_NOST) gdn_chunk_phase<true>(p, lds, tid, wave, lane); else gdn_chunk_phase<false>(p, lds, tid, wave, lane); __syncthreads(); } SEAM(11);
    if (IN(12)) _Pragma("unroll") for (int rep = 0; rep < REPS(12); ++rep) { PHASE_IDS
        for (int u = blockIdx.x; u < 64; u += G) _Pragma("unroll 1") for (int z_ = 0; z_ < hot1; ++z_) gdn_scan_unit(p, u, lds, tid, wave, lane);
        if (G <= 64 || (int)blockIdx.x >= 64) { const int st0 = G > 64 ? (int)blockIdx.x - 64 : (int)blockIdx.x, str = G > 64 ? G - 64 : G;
            const bool helper = (G == 256);
            const int hu = st0 & 63, hj = st0 >> 6;
            PrefetchCursor pc; pc.next = helper ? 2 : 64; pc.pad = (unsigned)__builtin_amdgcn_readfirstlane((int)(unsigned)(uintptr_t)(lds + (wave & 3) * 16384 + 12288 + (wave >> 2) * 256));
            int gnext = helper ? hj : 64;
            for (int u = st0; u < 1024; u += str) { scan_prefetch_tick(p, hu, hj, pc, tid); scan_gate_tick(p, hu, hj, gnext, tid); gdn_sample_unit(p, u, lds, tid, wave, lane); }
            {
                gu32* q = (gu32*)(p.ws + WS_CTL) + CW_QUEUE + 64 * (2 * 5 + rep);
                LAS float* scr = (LAS float*)(lds + wave * 16384);
                __syncthreads();
                for (;;) {
                    scan_prefetch_tick(p, hu, hj, pc, tid); scan_gate_tick(p, hu, hj, gnext, tid);
                    if (tid == 0) MISC[0] = __hip_atomic_fetch_add(q, 32u, __ATOMIC_RELAXED, __HIP_MEMORY_SCOPE_AGENT);
                    __syncthreads();
                    const int base = IT_GOUT + (int)MISC[0];
                    __syncthreads();
                    if (base >= IT_DN1) break;
                    const int kind = gv_kind(base);
                    if (kind < 0) {
#pragma unroll 1
                        for (int i = 0; i < 4; ++i) { const int it = base + wave * 4 + i; if (it < IT_DN1) p0_item(p, it, scr, lane); }
                    } else { float ca[8] = {0.f, 0.f, 0.f, 0.f, 0.f, 0.f, 0.f, 0.f};
#pragma unroll 1
                        for (int i = 0; i < 4; ++i) p0_item_gv(p, kind, base + wave * 4 + i, scr, lane, ca);
                        p0_gv_flush(p, kind, base + wave * 4, lane, ca); }
                }
            }
            { unsigned spins = 0;
#pragma unroll 1
              while ((pc.next < 64 || gnext < 64) && spins < (1u << 22)) { scan_prefetch_tick(p, hu, hj, pc, tid); scan_gate_tick(p, hu, hj, gnext, tid); __builtin_amdgcn_s_sleep(16); ++spins; } }
        }
        __syncthreads(); } SEAM(12);
    if (IN(13)) _Pragma("unroll") for (int rep = 0; rep < REPS(13); ++rep) { PHASE_IDS if (G != 256) gdn_gate_phase(p, tid); } if (G != 256) SEAM(13);
    if (IN(14)) _Pragma("unroll") for (int rep = 0; rep < REPS(14); ++rep) { PHASE_IDS pg8::Gemm g{(const bf16*)(ws + WS_GO), (const bf16*)(ws + WS_WGOUT), MPROMPT, DM, GVAL}; pg8::StaticOrder S; S.init(MPROMPT, DM, G, (int)blockIdx.x);
        pg8::EpiResidN E{XR, XR, mod1 + 2 * DM, H, p.norm_ffn + DM, mod1 + 3 * DM, SSQ + 2 * 8192};
        pg8::gemm_phase<pg8::EpiResidN, pg8::StaticOrder, true, true>(lds, g, S, E);
        small_gemm_phase(lds, (const bf16*)(ws + WS_GO), GVAL, MPROMPT, 1, (const bf16*)(ws + WS_WGOUT), GVAL, 0, DM / 64, SEpiResidAdd{XR + (size_t)MPROMPT * DM, mod1 + 2 * DM}, tid, wave, lane, 8); } SEAM(14);
    if (IN(16)) _Pragma("unroll") for (int rep = 0; rep < REPS(16); ++rep) { PHASE_IDS sample_prenorm(p, 2, XR, p.norm_ffn + DM, mod1, 3, H, tid, wave, lane);
        pg8::Gemm g{H, (const bf16*)(ws + WS_WUP1), MPROMPT, NUP, DM}; pg8::StaticOrder S; S.init(MPROMPT, NUP, G, (int)blockIdx.x);
        pg8::EpiAct E{(bf16*)(ws + WS_ACT), (bf16*)(ws + WS_BIG), p.fconv_w + (size_t)1 * 3 * NUP, p.fconv_b + (size_t)1 * NUP, lds};
        pg8::PrefOrder PS{S, lds, SSQ + 2 * 8192, CV + CV_UP1, NUP, p.fconv_w + (size_t)1 * 3 * NUP, p.fconv_b + (size_t)1 * NUP};
        if ((int)blockIdx.x >= (MPROMPT / 256) * (NUP / 256) % G) { convert_queue(p, 2 * 6 + rep, IT_DN1, NITEMS, lds, MISC, tid, wave, lane, STAGGER_BATCHES); __syncthreads(); }
        pg8::gemm_phase<pg8::EpiAct, pg8::PrefOrder, true, true>(lds, g, PS, E);
        sample_prenorm_wait(p, 2, tid);
        small_gemm_phase(lds, H, DM, MPROMPT, 1, (const bf16*)(ws + WS_WUP1), DM, 0, NUP / 64, SEpiUpSample{(bf16*)(ws + WS_BIG)}, tid, wave, lane);
        convert_queue(p, 2 * 6 + rep, IT_DN1, NITEMS, lds, MISC, tid, wave, lane); } SEAM(16);
    if (IN(17)) _Pragma("unroll") for (int rep = 0; rep < REPS(17); ++rep) { PHASE_IDS ffn_act_phase(p, 1, tid); } SEAM(17);
    if (IN(18)) _Pragma("unroll") for (int rep = 0; rep < REPS(18); ++rep) { PHASE_IDS pg8::Gemm g{(const bf16*)(ws + WS_ACT), (const bf16*)(ws + WS_WDN1), MPROMPT, DM, DFF}; pg8::StaticOrder S; S.init(MPROMPT, DM, G, (int)blockIdx.x);
#if defined(NULLEPI)
        pg8::EpiResid E{XR, XR + (size_t)MPROMPT * DM, (REPS(18) == 2 && rep == 0) ? nullptr : XR, mod1 + 5 * DM};
#else
        pg8::EpiResid E{XR, XR + (size_t)MPROMPT * DM, (REPS(18) == 2 && rep == 0) ? (float*)(ws + WS_BIG) : XR, mod1 + 5 * DM};
#endif
        pg8::gemm_phase<pg8::EpiResid, pg8::StaticOrder, true, true>(lds, g, S, E);
        if (!(REPS(18) == 2 && rep == 0)) small_gemm_phase(lds, (const bf16*)(ws + WS_ACT), DFF, MPROMPT, 1, (const bf16*)(ws + WS_WDN1), DFF, 0, DM / 64, SEpiResidAdd{XR + (size_t)MPROMPT * DM, mod1 + 5 * DM}, tid, wave, lane, 11); }
#undef IN
#undef SEAM
}

extern "C" void kernel_launch(void* const* d_in, const int* in_sizes, int n_in, void* d_out, int out_size, void* d_ws, size_t ws_size, hipStream_t stream) {
    static int grid = 0;
    if (grid == 0) {
        if (n_in != 29 || (size_t)out_size != O_END || ws_size < WS_END) { fprintf(stderr, "kernel_launch: unexpected sizes: n_in %d out %d ws %zu (need 29, %zu, >= %zu)\n", n_in, out_size, ws_size, (size_t)O_END, (size_t)WS_END); grid = -1; return; }
        int dev = 0, cus = 0, per_cu = 0;
        if (hipGetDevice(&dev) != hipSuccess || hipDeviceGetAttribute(&cus, hipDeviceAttributeMultiprocessorCount, dev) != hipSuccess) { grid = -1; return; }
        if (hipFuncSetAttribute((const void*)hybrid_fwd, hipFuncAttributeMaxDynamicSharedMemorySize, LDS_BYTES) != hipSuccess) { fprintf(stderr, "kernel_launch: hipFuncSetAttribute failed\n"); grid = -1; return; }
        if (hipOccupancyMaxActiveBlocksPerMultiprocessor(&per_cu, (const void*)hybrid_fwd, 512, LDS_BYTES) != hipSuccess || per_cu < 1) { fprintf(stderr, "kernel_launch: occupancy query says %d\n", per_cu); per_cu = 1; }
        (void)hipGetLastError();
        grid = cus;
    }
    if (grid < 0) return;
    (void)hipMemsetAsync((char*)d_ws + WS_CTL, 0, CTL_ZERO_BYTES, stream);
    Args a{};
    for (int i = 0; i < 29; ++i) a.in[i] = (const float*)d_in[i];
    a.out = (float*)d_out; a.ws = (unsigned char*)d_ws; a.one = 1;
    if (MK_N_LAUNCHES == 1) { a.ph_lo = 0; a.ph_hi = N_PHASES; hipLaunchKernelGGL(hybrid_fwd, dim3(grid), dim3(512), LDS_BYTES, stream, a); }
    else { for (int k = 0; k < N_PHASES; ++k) { a.ph_lo = k; a.ph_hi = k + 1; hipLaunchKernelGGL(hybrid_fwd, dim3(grid), dim3(512), LDS_BYTES, stream, a); } }
}
```

```cpp
#include <hip/hip_runtime.h>
#include <cstdio>
#include <cstdint>
#define PROBE_MASK 0u
namespace pg8 {
#define PG8_LAS __attribute__((address_space(3)))
typedef unsigned short bf16_t;
typedef short bf16x8 __attribute__((ext_vector_type(8)));
typedef float f32x4 __attribute__((ext_vector_type(4)));
typedef unsigned u32x4 __attribute__((ext_vector_type(4)));
constexpr int BM = 256, BK = 64, HALF = 128, HTB = HALF * BK * 2  , STAGE_BYTES = 8 * HTB, NXCD = 8, WGM = 8;

__host__ __device__ __forceinline__ int lds_byte(int r, int c) { const int st = (r >> 4) * 2 + (c >> 5), rr = r & 15, cc = c & 31, ob = rr * 64 + cc * 2; return st * 1024 + (ob ^ (((ob >> 9) & 1) << 5)); }
__host__ __device__ __forceinline__ void stage_rc(int b, int& R, int& C) { const int st = b / 1024, sb = b % 1024, swz = sb ^ (((sb >> 9) & 1) << 5); R = (st >> 1) * 16 + swz / 64; C = (st & 1) * 32 + (swz % 64) / 2; }
__host__ __device__ __forceinline__ int perm32(int rho) { const int n = rho >> 4, i = rho & 15; return 8 * (i >> 2) + 4 * n + (i & 3); }

struct Unit { int pm, pn, ui; };
struct Gemm { const bf16_t* A; const bf16_t* Bt; int M, N, K; };

struct StaticOrder {
    int nM, nN, nwg, G, c;
    __host__ __device__ void init(int M, int N, int G_, int c_) { nM = M / BM; nN = N / BM; nwg = nM * nN; G = G_; c = c_; }
    __host__ __device__ bool next(int i, Unit& u) const {
        const long L = (long)i * G + c; if (L >= nwg) return false;
        int wgid = (int)L; { const int q = nwg / NXCD, r = nwg % NXCD, xcd = wgid % NXCD, off = wgid / NXCD; wgid = (xcd < r ? xcd * (q + 1) : r * (q + 1) + (xcd - r) * q) + off; }
        const int nig = WGM * nN, gid = wgid / nig, fm = gid * WGM, gsz = (nM - fm) < WGM ? (nM - fm) : WGM;
        u.pm = fm + ((wgid % nig) % gsz); u.pn = (wgid % nig) / gsz; return true;
    }
    __device__ __forceinline__ void a_ready(const Unit&) const {}
    __device__ __forceinline__ void done(const Unit&) const {}
};

__device__ __forceinline__ unsigned cvt_pk_bf16(float lo, float hi) { unsigned r; asm volatile("v_cvt_pk_bf16_f32 %0, %1, %2" : "=v"(r) : "v"(lo), "v"(hi)); return r; }
typedef float f32x2 __attribute__((ext_vector_type(2)));
template <class Epi, class Sched, bool ALIGN_EPI = false, bool SP2 = false>
__device__ __forceinline__ void gemm_phase(PG8_LAS unsigned char* lds, const Gemm g, const Sched& S, const Epi& E) {
    const int tid = threadIdx.x, wid = __builtin_amdgcn_readfirstlane(tid >> 6), lane = tid & 63, wr = wid >> 2, wc = wid & 3, fr = lane & 15, fq = lane >> 4;
    const int K = g.K, nt = K / BK;
    unsigned voffA[2], voffB[2];
#pragma unroll
    for (int i = 0; i < 2; ++i) { int R, C; stage_rc(tid * 16 + i * 8192, R, C); const int Rb = Epi::PERM ? ((R & ~31) + perm32(R & 31)) : R;
        voffA[i] = (unsigned)(R * K + C) * 2u; voffB[i] = (unsigned)(Rb * K + C) * 2u; }
    const size_t kstep = (size_t)(BK * 2);
    const size_t hstep = (size_t)HALF * K * 2;
    const size_t tstep = 2 * hstep;
    const unsigned ldsw = (unsigned)wid * 1024u;
    const int aoff = lds_byte(wr * 64 + fr, fq * 8), boff = lds_byte(wc * 32 + fr, fq * 8);
#define PG8_SA(b, h) (((b) * 2 + (h)) * HTB)
#define PG8_SB(b, h) ((4 + (b) * 2 + (h)) * HTB)
#define PG8_STAGE(bufoff, gbase, voff) do { _Pragma("unroll") for (int _i = 0; _i < 2; ++_i) \
        __builtin_amdgcn_global_load_lds((const unsigned*)((const char*)(gbase) + (voff)[_i]), (PG8_LAS unsigned*)(lds + (bufoff) + ldsw + _i * 8192), 16, 0, 0); } while (0)
#define PG8_LDA(dst, b, h) do { _Pragma("unroll") for (int m = 0; m < 4; ++m) _Pragma("unroll") for (int k = 0; k < 2; ++k) dst[m][k] = *(const PG8_LAS bf16x8*)(lds + PG8_SA(b, h) + aoff + m * 2048 + k * 1024); } while (0)
#define PG8_LDB(dst, b, h) do { _Pragma("unroll") for (int n = 0; n < 2; ++n) _Pragma("unroll") for (int k = 0; k < 2; ++k) dst[n][k] = *(const PG8_LAS bf16x8*)(lds + PG8_SB(b, h) + boff + n * 2048 + k * 1024); } while (0)
#define PG8_MMA(ai, bj, At, Bt) do { __builtin_amdgcn_s_setprio(1); _Pragma("unroll") for (int m = 0; m < 4; ++m) _Pragma("unroll") for (int n = 0; n < 2; ++n) _Pragma("unroll") for (int k = 0; k < 2; ++k) \
        acc[ai][bj][m][n] = __builtin_amdgcn_mfma_f32_16x16x32_bf16(Bt[n][k], At[m][k], acc[ai][bj][m][n], 0, 0, 0); __builtin_amdgcn_s_setprio(0); } while (0)
#define PG8_WAIT_V(n) asm volatile("s_waitcnt vmcnt(" #n ")" ::: "memory")
#define PG8_WAIT_L(n) asm volatile("s_waitcnt lgkmcnt(" #n ")" ::: "memory")
#define PG8_BAR __builtin_amdgcn_s_barrier()
#define PG8_SCHED __builtin_amdgcn_sched_barrier(0)
    Unit cur, nxt; int ui = 0;
    if (!S.next(0, cur)) return;
    f32x4 acc[2][2][4][2];
#pragma unroll
    for (int a = 0; a < 2; ++a)
#pragma unroll
        for (int b = 0; b < 2; ++b)
#pragma unroll
            for (int m = 0; m < 4; ++m)
#pragma unroll
                for (int n = 0; n < 2; ++n) acc[a][b][m][n] = (f32x4){0.f, 0.f, 0.f, 0.f};
    bf16x8 At[4][2], B0[2][2], B1[2][2];
    const char* cA = (const char*)g.A + (size_t)cur.pm * tstep; const char* cB = (const char*)g.Bt + (size_t)cur.pn * tstep;
    S.a_ready(cur);
    if constexpr (SP2) {
        PG8_STAGE(PG8_SB(0, 0), cB, voffB); PG8_STAGE(PG8_SB(0, 1), cB + hstep, voffB); PG8_STAGE(PG8_SA(0, 0), cA, voffA); PG8_STAGE(PG8_SA(0, 1), cA + hstep, voffA);
        if (wr == 1) PG8_BAR;
        PG8_WAIT_V(2); PG8_BAR;
        PG8_STAGE(PG8_SB(1, 0), cB + kstep, voffB); PG8_STAGE(PG8_SA(1, 0), cA + kstep, voffA); PG8_STAGE(PG8_SB(1, 1), cB + hstep + kstep, voffB);
        PG8_WAIT_V(6); PG8_BAR;
    } else {
        PG8_STAGE(PG8_SB(0, 0), cB, voffB); PG8_STAGE(PG8_SA(0, 0), cA, voffA); PG8_STAGE(PG8_SB(0, 1), cB + hstep, voffB); PG8_STAGE(PG8_SA(0, 1), cA + hstep, voffA);
        if (wr == 1) PG8_BAR;
        PG8_WAIT_V(4); PG8_BAR;
        PG8_STAGE(PG8_SB(1, 0), cB + kstep, voffB); PG8_STAGE(PG8_SA(1, 0), cA + kstep, voffA); PG8_STAGE(PG8_SB(1, 1), cB + hstep + kstep, voffB);
        PG8_WAIT_V(6); PG8_BAR;
    }
    for (;;) {
        const bool has_next = S.next(ui + 1, nxt);
        const char* nA = has_next ? (const char*)g.A + (size_t)nxt.pm * tstep : cA; const char* nB = has_next ? (const char*)g.Bt + (size_t)nxt.pn * tstep : cB;
        for (int t = 0; t < nt; t += 2) {
            const bool last = (t == nt - 2);
            const char* a1 = cA + (size_t)(t + 1) * kstep;
            const char* a2 = last ? nA : cA + (size_t)(t + 2) * kstep; const char* b2 = last ? nB : cB + (size_t)(t + 2) * kstep;
            const char* a3 = a2 + kstep; const char* b3 = b2 + kstep;
            if (last && has_next) S.a_ready(nxt);
            if constexpr (SP2) {
            PG8_LDB(B0, 0, 0); PG8_LDB(B1, 0, 1); PG8_SCHED; PG8_LDA(At, 0, 0); PG8_STAGE(PG8_SA(1, 1), a1 + hstep, voffA);
            PG8_WAIT_V(8); PG8_WAIT_L(0); PG8_BAR; PG8_MMA(0, 0, At, B0); PG8_MMA(0, 1, At, B1); PG8_BAR; PG8_SCHED;
            PG8_LDA(At, 0, 1); PG8_STAGE(PG8_SB(0, 0), b2, voffB); PG8_STAGE(PG8_SB(0, 1), b2 + hstep, voffB); PG8_STAGE(PG8_SA(0, 0), a2, voffA);
            PG8_WAIT_V(8); PG8_WAIT_L(0); PG8_BAR; PG8_MMA(1, 0, At, B0); PG8_MMA(1, 1, At, B1); PG8_BAR; PG8_SCHED;
            PG8_LDB(B0, 1, 0); PG8_LDB(B1, 1, 1); PG8_SCHED; PG8_LDA(At, 1, 0); PG8_STAGE(PG8_SA(0, 1), a2 + hstep, voffA);
            PG8_WAIT_V(8); PG8_WAIT_L(0); PG8_BAR; PG8_MMA(0, 0, At, B0); PG8_MMA(0, 1, At, B1); PG8_BAR; PG8_SCHED;
            PG8_LDA(At, 1, 1); PG8_STAGE(PG8_SB(1, 0), b3, voffB); PG8_STAGE(PG8_SB(1, 1), b3 + hstep, voffB); PG8_STAGE(PG8_SA(1, 0), a3, voffA);
            PG8_WAIT_V(8); PG8_WAIT_L(0); PG8_BAR; PG8_MMA(1, 0, At, B0); PG8_MMA(1, 1, At, B1); PG8_BAR; PG8_SCHED;
            } else {
            PG8_LDB(B0, 0, 0); PG8_SCHED; PG8_LDA(At, 0, 0); PG8_STAGE(PG8_SA(1, 1), a1 + hstep, voffA);
            PG8_WAIT_L(8); PG8_BAR; PG8_WAIT_L(0); PG8_MMA(0, 0, At, B0); PG8_BAR; PG8_SCHED;
            PG8_LDB(B1, 0, 1); PG8_STAGE(PG8_SB(0, 0), b2, voffB);
            PG8_BAR; PG8_WAIT_L(0); PG8_MMA(0, 1, At, B1); PG8_BAR;
            PG8_LDA(At, 0, 1); PG8_STAGE(PG8_SA(0, 0), a2, voffA);
            PG8_BAR; PG8_WAIT_L(0); PG8_MMA(1, 0, At, B0); PG8_BAR; PG8_SCHED;
            PG8_STAGE(PG8_SB(0, 1), b2 + hstep, voffB);
            PG8_WAIT_V(6); PG8_BAR; PG8_MMA(1, 1, At, B1); PG8_BAR;
            PG8_LDB(B0, 1, 0); PG8_SCHED; PG8_LDA(At, 1, 0); PG8_STAGE(PG8_SA(0, 1), a2 + hstep, voffA);
            PG8_WAIT_L(8); PG8_BAR; PG8_WAIT_L(0); PG8_MMA(0, 0, At, B0); PG8_BAR; PG8_SCHED;
            PG8_LDB(B1, 1, 1); PG8_STAGE(PG8_SB(1, 0), b3, voffB);
            PG8_BAR; PG8_WAIT_L(0); PG8_MMA(0, 1, At, B1); PG8_BAR;
            PG8_LDA(At, 1, 1); PG8_STAGE(PG8_SA(1, 0), a3, voffA);
            PG8_BAR; PG8_WAIT_L(0); PG8_MMA(1, 0, At, B0); PG8_BAR; PG8_SCHED;
            PG8_STAGE(PG8_SB(1, 1), b3 + hstep, voffB);
            PG8_WAIT_V(6); PG8_BAR; PG8_MMA(1, 1, At, B1); PG8_BAR;
            }
        }
        if constexpr (ALIGN_EPI) { if (wr == 0) PG8_BAR; }
        if constexpr (!Epi::AFTER_DRAIN) { E(acc, cur, wr, wc, fr, fq); S.done(cur); }
        if (!has_next) break;
#pragma unroll
        for (int a = 0; a < 2; ++a)
#pragma unroll
            for (int b = 0; b < 2; ++b)
#pragma unroll
                for (int m = 0; m < 4; ++m)
#pragma unroll
                    for (int n = 0; n < 2; ++n) acc[a][b][m][n] = (f32x4){0.f, 0.f, 0.f, 0.f};
        cur = nxt; cA = nA; cB = nB; ++ui;
        if constexpr (ALIGN_EPI) { if (wr == 1) PG8_BAR; }
    }
    PG8_WAIT_V(0);
    if constexpr (!ALIGN_EPI) { if (wr == 0) PG8_BAR; }
    PG8_BAR;
    if constexpr (Epi::AFTER_DRAIN) { E.fused(acc, cur, wr, wc, fr, fq, lds, wid, lane); S.done(cur); }
#undef PG8_SA
#undef PG8_SB
#undef PG8_STAGE
#undef PG8_LDA
#undef PG8_LDB
#undef PG8_MMA
#undef PG8_WAIT_V
#undef PG8_WAIT_L
#undef PG8_BAR
#undef PG8_SCHED
}
}
#define GAS __attribute__((address_space(1)))
#define LAS __attribute__((address_space(3)))
typedef unsigned short bf16;
typedef unsigned v4u __attribute__((ext_vector_type(4)));
typedef float f32x4 __attribute__((ext_vector_type(4)));
typedef short bf16x8 __attribute__((ext_vector_type(8)));
typedef GAS unsigned gu32;
typedef GAS unsigned long long gu64;
#define RLX_AGENT __ATOMIC_RELAXED, __HIP_MEMORY_SCOPE_AGENT
#define LDS_WAIT() asm volatile("s_waitcnt lgkmcnt(0)" ::: "memory")
#define VM_WAIT() asm volatile("s_waitcnt vmcnt(0)" ::: "memory")
__device__ __forceinline__ unsigned long long rt() { return __builtin_amdgcn_s_memrealtime(); }
__device__ __forceinline__ unsigned f2bf(float f) { unsigned u = __builtin_bit_cast(unsigned, f); return (u + 0x7fffu + ((u >> 16) & 1u)) >> 16; }
__device__ __forceinline__ unsigned pk2(float lo, float hi) { return f2bf(lo) | (f2bf(hi) << 16); }

#define XB_TMO      128
#define XB_XCNT(j)  (256  + 64 * (j))
#define XB_XSUB(j)  (1280 + 64 * (j))
#define XB_XGEN(j)  (2304 + 64 * (j))
#define XB_TOP      3328
#define XB_TOPGEN   3392
#define XCD_BAR_WORDS 3456
#define XB_SPIN_CAP (1u << 18)

__device__ __forceinline__ unsigned xb_ld(unsigned* p)              { return __hip_atomic_load(p, __ATOMIC_RELAXED, __HIP_MEMORY_SCOPE_AGENT); }
__device__ __forceinline__ unsigned xb_add(unsigned* p, unsigned v) { return __hip_atomic_fetch_add(p, v, __ATOMIC_RELAXED, __HIP_MEMORY_SCOPE_AGENT); }
__device__ __forceinline__ unsigned xb_xcc_id() { return (unsigned)__builtin_amdgcn_s_getreg((3 << 11) | 20) & 0xFu; }
#define XB_SPIN(cond, bar) do { unsigned _sp = 0; while (cond) { __builtin_amdgcn_s_sleep(1); \
    if ((++_sp & 255u) == 0u) { if (xb_ld(&(bar)[XB_TMO])) break; if (_sp > XB_SPIN_CAP) { atomicAdd(&(bar)[XB_TMO], 1u); break; } } } } while (0)

struct XcdBarrier {
    unsigned* bar; unsigned x;
    volatile LAS unsigned* st;
};

__device__ __forceinline__ XcdBarrier xcd_barrier_post(unsigned* bar, volatile LAS unsigned* st) {
    XcdBarrier b; b.bar = bar; b.x = xb_xcc_id(); b.st = st;
    if (threadIdx.x == 0) (void)xb_add(&bar[XB_XCNT(b.x)], 1u);
    return b;
}
__device__ __forceinline__ void xcd_barrier_complete(unsigned* bar, unsigned x, unsigned& nloc, unsigned& nx) {
    const unsigned G = gridDim.x * gridDim.y * gridDim.z;
    unsigned sum, cnt, mine, sp = 0u;
    for (;;) {
        sum = 0u; cnt = 0u; mine = 0u;
#pragma unroll
        for (unsigned j = 0; j < 16; ++j) { const unsigned c = xb_ld(&bar[XB_XCNT(j)]); sum += c; cnt += (c > 0u) ? 1u : 0u; mine = (j == x) ? c : mine; }
        if (sum == G) break;
        __builtin_amdgcn_s_sleep(1);
        if ((++sp & 255u) == 0u) { if (xb_ld(&bar[XB_TMO])) break; if (sp > XB_SPIN_CAP) { atomicAdd(&bar[XB_TMO], 1u); break; } }
    }
    nloc = mine > 0u ? mine : 1u; nx = cnt > 0u ? cnt : 1u;
}

__device__ __forceinline__ void xcd_barrier(const XcdBarrier& b) {
    asm volatile("s_waitcnt vmcnt(0)" ::: "memory");
    __syncthreads();
    if (threadIdx.x == 0) {
        unsigned* bar = b.bar;
        __builtin_amdgcn_s_waitcnt(0);
        unsigned nloc = b.st[0], nx = b.st[1];
        if (nloc == 0u) { xcd_barrier_complete(bar, b.x, nloc, nx); b.st[0] = nloc; b.st[1] = nx; }
        const unsigned old = xb_add(&bar[XB_XSUB(b.x)], 1u);
        const unsigned gen = old / nloc;
        if (old + 1u == (gen + 1u) * nloc) {
            __builtin_amdgcn_fence(__ATOMIC_RELEASE, "agent");
            asm volatile("s_waitcnt vmcnt(0)" ::: "memory");
            const unsigned og = xb_add(&bar[XB_TOP], 1u);
            const unsigned tg = og / nx;
            if (og + 1u == (tg + 1u) * nx) xb_add(&bar[XB_TOPGEN], 1u);
            else XB_SPIN(xb_ld(&bar[XB_TOPGEN]) == tg, bar);
            __builtin_amdgcn_fence(__ATOMIC_ACQUIRE, "agent");
            xb_add(&bar[XB_XGEN(b.x)], 1u);
            asm volatile("s_waitcnt vmcnt(0)" ::: "memory");
        } else {
            XB_SPIN(xb_ld(&bar[XB_XGEN(b.x)]) == gen, bar);
            __builtin_amdgcn_fence(__ATOMIC_ACQUIRE, "agent");
            asm volatile("s_waitcnt vmcnt(0)" ::: "memory");
        }
    }
    __syncthreads();
}
__device__ __forceinline__ float wave_sum(float v) {
#pragma unroll
    for (int o = 1; o < 64; o <<= 1) v += __shfl_xor(v, o);
    return v;
}
template <bool GV>
__device__ __forceinline__ void p0_transpose_item_t(const float* W, int K, int N, bf16* WT, int row_off, LAS float* scr, int kb, int nb, int lane, const float* sh, float (&ca)[8]) {
    const int k0 = 64 * kb, n0 = 32 * nb;
    f32x4 wv[8];
#pragma unroll
    for (int i = 0; i < 8; ++i) wv[i] = __builtin_nontemporal_load((const GAS f32x4*)(W + (size_t)(k0 + 8 * i + (lane >> 3)) * N + n0 + 4 * (lane & 7)));
#pragma unroll
    for (int i = 0; i < 8; ++i) { LAS float* d = scr + (8 * i + (lane >> 3)) * 33 + 4 * (lane & 7); d[0] = wv[i].x; d[1] = wv[i].y; d[2] = wv[i].z; d[3] = wv[i].w; }
    LDS_WAIT(); asm volatile("" ::: "memory");
    const int c = lane & 7;
    f32x4 s0[2], s1[2];
    if constexpr (GV) { const GAS f32x4* q0 = (const GAS f32x4*)(sh + k0 + 8 * c); const GAS f32x4* q1 = (const GAS f32x4*)(sh + 12288 + k0 + 8 * c); s0[0] = q0[0]; s0[1] = q0[1]; s1[0] = q1[0]; s1[1] = q1[1]; }
#pragma unroll
    for (int j = 0; j < 4; ++j) { const int n = (lane >> 3) + 8 * j; const LAS float* s = scr + (8 * c) * 33 + n;
        if constexpr (GV) { const float t0 = s[0 * 33], t1 = s[1 * 33], t2 = s[2 * 33], t3 = s[3 * 33], t4 = s[4 * 33], t5 = s[5 * 33], t6 = s[6 * 33], t7 = s[7 * 33];
            ca[j] += (t0 * s0[0].x + t1 * s0[0].y + t2 * s0[0].z + t3 * s0[0].w) + (t4 * s0[1].x + t5 * s0[1].y + t6 * s0[1].z + t7 * s0[1].w);
            ca[4 + j] += (t0 * s1[0].x + t1 * s1[0].y + t2 * s1[0].z + t3 * s1[0].w) + (t4 * s1[1].x + t5 * s1[1].y + t6 * s1[1].z + t7 * s1[1].w); }
        v4u o; o.x = pk2(s[0 * 33], s[1 * 33]); o.y = pk2(s[2 * 33], s[3 * 33]); o.z = pk2(s[4 * 33], s[5 * 33]); o.w = pk2(s[6 * 33], s[7 * 33]);
        __builtin_nontemporal_store(o, (GAS v4u*)(WT + (size_t)(row_off + n0 + n) * K + k0 + 8 * c)); }
    LDS_WAIT(); asm volatile("" ::: "memory");
}
__device__ __forceinline__ void p0_transpose_item(const float* W, int K, int N, bf16* WT, int row_off, LAS float* scr, int item, int lane) {
    const int nblk = N / 32; float ca[8];
    p0_transpose_item_t<false>(W, K, N, WT, row_off, scr, item / nblk, item % nblk, lane, nullptr, ca);
}

#define DI __device__ __forceinline__
typedef float f32x2 __attribute__((ext_vector_type(2)));
typedef float f32x16 __attribute__((ext_vector_type(16)));
typedef unsigned v2u __attribute__((ext_vector_type(2)));
typedef __bf16 bf16x2_t __attribute__((ext_vector_type(2)));
#define MFMA32(a, b, c) __builtin_amdgcn_mfma_f32_32x32x16_bf16((a), (b), (c), 0, 0, 0)

constexpr int DM = 2048, SEQ = 4096, MPROMPT = 8192, MSAMP = 128, MTOK = 8320, MP = 8448;
constexpr int NQKV = 2560, DFF = 5632, NUP = 11264, NGIN = 12352, NGINP = 12544, GVAL = 4096;
constexpr int MODW = 12288, NMODROW = 34;
constexpr float NORM_EPS = 1e-6f;

constexpr size_t O_Y = 0;
constexpr size_t O_WKP = (size_t)MTOK * DM;
constexpr size_t O_WVP = O_WKP + 65536;
constexpr size_t O_WKS = O_WVP + 65536;
constexpr size_t O_WVS = O_WKS + 1048576;
constexpr size_t O_GDNP = O_WVS + 1048576;
constexpr size_t O_GDNS = O_GDNP + 1048576;
constexpr size_t O_GCP = O_GDNS + 16777216;
constexpr size_t O_GCS = O_GCP + 49152;
constexpr size_t O_FCP = O_GCS + 786432;
constexpr size_t O_FCS = O_FCP + 90112;
constexpr size_t O_END = O_FCS + 1441792;

constexpr size_t MiB = 1u << 20;
constexpr size_t WS_CTL = 0, CTL_ZERO_BYTES = 1 * MiB;
constexpr size_t WS_MOD = 1 * MiB;
constexpr size_t WS_WQKV = 5 * MiB, WS_WO = 15 * MiB, WS_WGIN = 23 * MiB, WS_WGOUT = 72 * MiB;
constexpr size_t WS_WUP0 = 88 * MiB, WS_WUP1 = 132 * MiB, WS_WDN0 = 176 * MiB, WS_WDN1 = 198 * MiB;
constexpr size_t WS_H = 220 * MiB;
constexpr size_t WS_BIG = 253 * MiB;
constexpr size_t WS_R = 456 * MiB;
constexpr size_t WS_QKV = WS_R;
constexpr size_t WS_AO = 498 * MiB;
constexpr size_t WS_ACT = 531 * MiB;
constexpr size_t WS_KQ = WS_R;
constexpr size_t WS_TH = 552 * MiB;
constexpr size_t WS_VEC = 680 * MiB;
constexpr size_t WS_BA = 684 * MiB;
constexpr size_t WS_GO = 687 * MiB;
constexpr size_t WS_END = 753 * MiB;
static_assert(WS_H + (size_t)MP * DM * 2 <= WS_BIG && WS_BIG + (size_t)MP * NGINP * 2 <= WS_R, "ws map");
static_assert(WS_QKV + (size_t)MP * NQKV * 2 <= WS_AO && WS_AO + (size_t)MP * DM * 2 <= WS_ACT && WS_ACT + (size_t)MP * DFF * 2 <= WS_VEC, "ws map");
static_assert(WS_KQ + (size_t)2048 * 49152 <= WS_TH && WS_TH + (size_t)4096 * 32768 <= WS_VEC && WS_VEC + (size_t)4096 * 1024 <= WS_BA, "ws map");
static_assert(WS_BA + (size_t)MP * 64 * 4 <= WS_GO && WS_GO + (size_t)MP * GVAL * 2 <= WS_END, "ws map");
constexpr int CW_QUEUE = 64;
constexpr int CW_BAR = 4096;
constexpr int CW_SNC = 24576;
constexpr int CW_SSQ = 65536;
constexpr int CW_CV = 131072;
constexpr int CV_UP0 = 0, CV_GIN = 2 * 11264, CV_UP1 = CV_GIN + 2 * 12352;
static_assert(CW_CV + CV_UP1 + 2 * 11264 <= 262144, "control region is 1 MiB");
constexpr int CW_PROG = 16384;

constexpr int LDS_BYTES = 155648;
constexpr int MISC_OFF = 151552;

DI float bflo(unsigned w) { return __uint_as_float(w << 16); }
DI float bfhi(unsigned w) { return __uint_as_float(w & 0xffff0000u); }
DI float bf2f(unsigned short b) { return __uint_as_float((unsigned)b << 16); }
DI unsigned pkbf(float lo, float hi) { f32x2 v = {lo, hi}; bf16x2_t b = __builtin_convertvector(v, bf16x2_t); return __builtin_bit_cast(unsigned, b); }
DI unsigned short f2bf16(float f) { return (unsigned short)(pkbf(f, 0.f) & 0xffffu); }
DI void unpack8(v4u w, float (&x)[8]) { x[0] = bflo(w.x); x[1] = bfhi(w.x); x[2] = bflo(w.y); x[3] = bfhi(w.y); x[4] = bflo(w.z); x[5] = bfhi(w.z); x[6] = bflo(w.w); x[7] = bfhi(w.w); }
DI v4u pack8f(const float (&x)[8]) { v4u w; w.x = pkbf(x[0], x[1]); w.y = pkbf(x[2], x[3]); w.z = pkbf(x[4], x[5]); w.w = pkbf(x[6], x[7]); return w; }
DI float silu_f(float x) { return x * __builtin_amdgcn_rcpf(1.f + __expf(-x)); }
DI float sigmoid_f(float x) { return __builtin_amdgcn_rcpf(1.f + __expf(-x)); }
DI float softplus_f(float x) { return fmaxf(x, 0.f) + log1pf(__expf(-fabsf(x))); }
DI int crow(int reg, int h) { return (reg & 3) + 8 * (reg >> 2) + 4 * h; }
DI int rho32(int p) { return (p & ~12) | ((p & 4) << 1) | ((p & 8) >> 1); }
DI int pos64(int j) { return (j & ~31) | rho32(j & 31); }
template <int S_> DI bf16x8 pack_acc(const f32x16& x) {
    v4u p; p.x = pkbf(x[8 * S_ + 0], x[8 * S_ + 1]); p.y = pkbf(x[8 * S_ + 2], x[8 * S_ + 3]); p.z = pkbf(x[8 * S_ + 4], x[8 * S_ + 5]); p.w = pkbf(x[8 * S_ + 6], x[8 * S_ + 7]);
    return __builtin_bit_cast(bf16x8, p);
}
DI f32x16 zero16() { f32x16 z; _Pragma("unroll") for (int i = 0; i < 16; ++i) z[i] = 0.f; return z; }

struct P {
    const float *x_prompt, *x_sample, *c_prompt, *c_sample, *cache_k, *cache_v, *state_gdn, *state_gconv, *state_fconv, *rel_table;
    const float *w_ada, *b_ada, *norm_mix, *norm_ffn, *w_qkv, *q_norm, *k_norm, *sinks, *w_o, *w_gin, *gconv_w, *a_log, *dt_bias, *out_norm, *w_gout;
    const float *w_up, *fconv_w, *fconv_b, *w_dn;
    float* out; unsigned char* ws;
};

namespace pg8 {
constexpr int PF_OFF = 131072, PF_IMG = 6144;
__device__ __forceinline__ void norm_fixup(const f32x4 (&acc)[2][2][4][2], const PG8_LAS float* pfb, int rowl, int coll) {
    f32x4 (&a)[2][2][4][2] = const_cast<f32x4 (&)[2][2][4][2]>(acc);
    f32x4 c4[2][2];
#pragma unroll
    for (int bj = 0; bj < 2; ++bj)
#pragma unroll
        for (int n = 0; n < 2; ++n) c4[bj][n] = *(const PG8_LAS f32x4*)(pfb + 256 + coll + bj * HALF + 4 * n);
#pragma unroll
    for (int ai = 0; ai < 2; ++ai)
#pragma unroll
        for (int m = 0; m < 4; ++m) { const float rs = rsqrtf(pfb[rowl + ai * HALF + m * 16] * (1.f / 2048.f) + 1e-6f);
#pragma unroll
            for (int bj = 0; bj < 2; ++bj)
#pragma unroll
                for (int n = 0; n < 2; ++n) a[ai][bj][m][n] = a[ai][bj][m][n] * rs + c4[bj][n]; }
}
struct PrefOrder {
    StaticOrder S; PG8_LAS unsigned char* lds; const float* ssq; const float* cv; int ldcv; const float* cw; const float* cb;
    __device__ __forceinline__ bool next_inl(int i, Unit& u) const {
        const long L = (long)i * S.G + S.c; if (L >= S.nwg) return false;
        int wgid = (int)L; { const int q = S.nwg / NXCD, r = S.nwg % NXCD, xcd = wgid % NXCD, off = wgid / NXCD; wgid = (xcd < r ? xcd * (q + 1) : r * (q + 1) + (xcd - r) * q) + off; }
        const int nig = WGM * S.nN, gid = wgid / nig, fm = gid * WGM, gsz = (S.nM - fm) < WGM ? (S.nM - fm) : WGM;
        u.pm = fm + ((wgid % nig) % gsz); u.pn = (wgid % nig) / gsz; u.ui = i; return true;
    }
    __device__ __forceinline__ bool next(int i, Unit& u) const {
        const bool ok = next_inl(i, u);
        Unit c;
        if (i >= 1 && next_inl(i - 1, c)) { const int t = threadIdx.x;
            const float* src = t < 256 ? ssq + c.pm * BM + t : cv + (size_t)(c.pm >> 4) * ldcv + c.pn * BM + (t - 256);
            const int wv = __builtin_amdgcn_readfirstlane(t >> 6);
            __builtin_amdgcn_global_load_lds((const unsigned*)src, (PG8_LAS unsigned*)(lds + PF_OFF + ((i - 1) & 1) * PF_IMG + wv * 256), 4, 0, 0);
            if (cw != nullptr) {
#pragma unroll
                for (int q = 0; q < 2; ++q) { const int jj = 2 * q + (wv >> 2), col = (wv & 3) * 64 + (t & 63);
                    const float* s2 = (jj < 3 ? cw + (size_t)jj * 11264 : cb) + (col < 128 ? c.pn * 128 + col : 5632 + c.pn * 128 + col - 128);
                    __builtin_amdgcn_global_load_lds((const unsigned*)s2, (PG8_LAS unsigned*)(lds + PF_OFF + ((i - 1) & 1) * PF_IMG + 2048 + jj * 1024 + (wv & 3) * 256), 4, 0, 0); } } }
        return ok;
    }
    __device__ __forceinline__ void a_ready(const Unit&) const {}
    __device__ __forceinline__ void done(const Unit&) const {}
};
template <bool NRM>
struct EpiStoreT {
    static constexpr bool PERM = true, AFTER_DRAIN = false;
    bf16_t* O; int ldc; float* side; int sidepn; PG8_LAS unsigned char* lds;
    __device__ __forceinline__ void operator()(const f32x4 (&acc)[2][2][4][2], const Unit& u, int wr, int wc, int fr, int fq) const {
        const int row0 = u.pm * BM + wr * 64 + fr;
        if constexpr (NRM) norm_fixup(acc, (const PG8_LAS float*)(lds + PF_OFF + (u.ui & 1) * PF_IMG), wr * 64 + fr, wc * 32 + 8 * fq);
#if defined(NULLEPI)
        if (O == nullptr) {
#pragma unroll
            for (int ai = 0; ai < 2; ++ai)
#pragma unroll
                for (int bj = 0; bj < 2; ++bj)
#pragma unroll
                    for (int m = 0; m < 4; ++m)
#pragma unroll
                        for (int n = 0; n < 2; ++n) asm volatile("" :: "v"(acc[ai][bj][m][n]));
            return;
        }
#endif
        if (side != nullptr && u.pn == sidepn) {
            if (wc < 2) {
#pragma unroll
                for (int ai = 0; ai < 2; ++ai)
#pragma unroll
                    for (int m = 0; m < 4; ++m) { float* rp = side + (size_t)(row0 + ai * HALF + m * 16) * 64 + wc * 32 + 8 * fq;
                        *(f32x4*)(rp) = acc[ai][0][m][0]; *(f32x4*)(rp + 4) = acc[ai][0][m][1]; }
            }
            return;
        }
        const int col0 = u.pn * BM + wc * 32 + 8 * fq;
#pragma unroll
        for (int ai = 0; ai < 2; ++ai)
#pragma unroll
            for (int m = 0; m < 4; ++m) { bf16_t* rowp = O + (size_t)(row0 + ai * HALF + m * 16) * ldc + col0;
#pragma unroll
                for (int bj = 0; bj < 2; ++bj) { const f32x4 v0 = acc[ai][bj][m][0], v1 = acc[ai][bj][m][1];
                    u32x4 w; w.x = cvt_pk_bf16(v0[0], v0[1]); w.y = cvt_pk_bf16(v0[2], v0[3]); w.z = cvt_pk_bf16(v1[0], v1[1]); w.w = cvt_pk_bf16(v1[2], v1[3]);
                    *(u32x4*)(rowp + bj * HALF) = w; } }
    }
};
using EpiStore = EpiStoreT<false>;
using EpiStoreN = EpiStoreT<true>;
struct EpiResid {
    static constexpr bool PERM = false, AFTER_DRAIN = false;
    const float* xin_p; const float* xin_s; float* xout; const float* gate;
    __device__ __forceinline__ void operator()(const f32x4 (&acc)[2][2][4][2], const Unit& u, int wr, int wc, int fr, int fq) const {
#if defined(NULLEPI)
        if (xout == nullptr) {
#pragma unroll
            for (int ai = 0; ai < 2; ++ai)
#pragma unroll
                for (int bj = 0; bj < 2; ++bj)
#pragma unroll
                    for (int m = 0; m < 4; ++m)
#pragma unroll
                        for (int n = 0; n < 2; ++n) asm volatile("" :: "v"(acc[ai][bj][m][n]));
            return;
        }
#endif
        const int col0 = u.pn * BM + wc * 32 + 4 * fq;
        if (u.pm < 32) {
            const float* g = gate + (size_t)(u.pm >> 4) * 12288 + col0;
            f32x4 gv[2][2];
#pragma unroll
            for (int bj = 0; bj < 2; ++bj)
#pragma unroll
                for (int n = 0; n < 2; ++n) gv[bj][n] = *(const f32x4*)(g + bj * HALF + n * 16);
#pragma unroll
            for (int ai = 0; ai < 2; ++ai)
#pragma unroll
                for (int m = 0; m < 4; ++m) { const size_t off = (size_t)(u.pm * BM + ai * HALF + wr * 64 + m * 16 + fr) * 2048 + col0;
#pragma unroll
                    for (int bj = 0; bj < 2; ++bj)
#pragma unroll
                        for (int n = 0; n < 2; ++n) { const f32x4 xv = *(const f32x4*)(xin_p + off + bj * HALF + n * 16);
                            *(f32x4*)(xout + off + bj * HALF + n * 16) = xv + gv[bj][n] * acc[ai][bj][m][n]; }
                    asm volatile("" ::: "memory"); }
        } else {
#pragma unroll
            for (int m = 0; m < 4; ++m) { const int rs = wr * 64 + m * 16 + fr;
                const float* g = gate + (size_t)(2 + (rs >> 2)) * 12288 + col0; const size_t off = (size_t)rs * 2048 + col0;
#pragma unroll
                for (int bj = 0; bj < 2; ++bj)
#pragma unroll
                    for (int n = 0; n < 2; ++n) { const f32x4 gvv = *(const f32x4*)(g + bj * HALF + n * 16); const f32x4 xv = *(const f32x4*)(xin_s + off + bj * HALF + n * 16);
                        *(f32x4*)(xout + (size_t)8192 * 2048 + off + bj * HALF + n * 16) = xv + gvv * acc[0][bj][m][n]; }
                asm volatile("" ::: "memory"); }
        }
    }
};
typedef unsigned u32x2 __attribute__((ext_vector_type(2)));
struct EpiResidN {
    static constexpr bool PERM = false, AFTER_DRAIN = false;
    const float* xin_p; float* xout; const float* gate; bf16_t* Hs; const float* ng; const float* nmod; float* ssq;
    __device__ __forceinline__ void operator()(const f32x4 (&acc)[2][2][4][2], const Unit& u, int wr, int wc, int fr, int fq) const {
        const int col0 = u.pn * BM + wc * 32 + 4 * fq;
        const float* g = gate + (size_t)(u.pm >> 4) * 12288 + col0;
        const float* sc = nmod + (size_t)(u.pm >> 4) * 12288 + 2048 + col0;
        f32x4 gv[2][2], wv[2][2];
#pragma unroll
        for (int bj = 0; bj < 2; ++bj)
#pragma unroll
            for (int n = 0; n < 2; ++n) { gv[bj][n] = *(const f32x4*)(g + bj * HALF + 16 * n); wv[bj][n] = *(const f32x4*)(ng + col0 + bj * HALF + 16 * n) * (*(const f32x4*)(sc + bj * HALF + 16 * n) + 1.f); }
#pragma unroll
        for (int ai = 0; ai < 2; ++ai)
#pragma unroll
            for (int m = 0; m < 4; ++m) { const int row = u.pm * BM + ai * HALF + wr * 64 + m * 16 + fr; const size_t off = (size_t)row * 2048 + col0; float ss = 0.f;
#pragma unroll
                for (int bj = 0; bj < 2; ++bj)
#pragma unroll
                    for (int n = 0; n < 2; ++n) { const f32x4 xv = *(const f32x4*)(xin_p + off + bj * HALF + 16 * n); f32x4 y = xv + gv[bj][n] * acc[ai][bj][m][n];
                        *(f32x4*)(xout + off + bj * HALF + 16 * n) = y; ss += (y[0] * y[0] + y[1] * y[1]) + (y[2] * y[2] + y[3] * y[3]); y = y * wv[bj][n];
                        u32x2 w; w.x = cvt_pk_bf16(y[0], y[1]); w.y = cvt_pk_bf16(y[2], y[3]);
                        *(u32x2*)(Hs + off + bj * HALF + 16 * n) = w; }
                ss += __shfl_xor(ss, 16); ss += __shfl_xor(ss, 32);
                if (fq == 0) atomicAdd(ssq + row, ss);
                asm volatile("" ::: "memory"); }
    }
};
}

template <int CTRL> DI float dpp1(float x) { return __builtin_bit_cast(float, __builtin_amdgcn_update_dpp(0, __builtin_bit_cast(int, x), CTRL, 0xf, 0xf, true)); }
template <int CTRL> DI f32x4 dpp4(f32x4 v) { return (f32x4){dpp1<CTRL>(v.x), dpp1<CTRL>(v.y), dpp1<CTRL>(v.z), dpp1<CTRL>(v.w)}; }
namespace pg8 {
struct EpiAct {
    static constexpr bool PERM = true, AFTER_DRAIN = false;
    bf16_t* ACT; bf16_t* U; const float* cw; const float* cb;
    PG8_LAS unsigned char* lds;
    __device__ __forceinline__ void operator()(const f32x4 (&acc)[2][2][4][2], const Unit& u, int wr, int wc, int fr, int fq) const {
        const int rowg = u.pm * BM + wr * 64, jc = u.pn * 128 + wc * 32 + 8 * fq;
        norm_fixup(acc, (const PG8_LAS float*)(lds + PF_OFF + (u.ui & 1) * PF_IMG), wr * 64 + fr, wc * 32 + 8 * fq);
#if defined(EPIACT_RAW)
#pragma unroll
        for (int ai = 0; ai < 2; ++ai)
#pragma unroll
            for (int m = 0; m < 4; ++m)
#pragma unroll
                for (int bj = 0; bj < 2; ++bj) { const f32x4 v0 = acc[ai][bj][m][0], v1 = acc[ai][bj][m][1];
                    u32x4 w; w.x = cvt_pk_bf16(v0[0], v0[1]); w.y = cvt_pk_bf16(v0[2], v0[3]); w.z = cvt_pk_bf16(v1[0], v1[1]); w.w = cvt_pk_bf16(v1[2], v1[3]);
                    *(u32x4*)(U + (size_t)(rowg + ai * HALF + m * 16 + fr) * 11264 + bj * 5632 + jc) = w; }
        return;
#endif
        if (fr < 2 || fr >= 14) { const int m = fr < 2 ? 0 : 3;
#pragma unroll
            for (int ai = 0; ai < 2; ++ai)
#pragma unroll
                for (int bj = 0; bj < 2; ++bj) { const f32x4 v0 = fr < 2 ? acc[ai][bj][0][0] : acc[ai][bj][3][0], v1 = fr < 2 ? acc[ai][bj][0][1] : acc[ai][bj][3][1];
                    u32x4 w; w.x = cvt_pk_bf16(v0[0], v0[1]); w.y = cvt_pk_bf16(v0[2], v0[3]); w.z = cvt_pk_bf16(v1[0], v1[1]); w.w = cvt_pk_bf16(v1[2], v1[3]);
                    *(u32x4*)(U + (size_t)(rowg + ai * HALF + m * 16 + fr) * 11264 + bj * 5632 + jc) = w; } }
        const PG8_LAS float* cim = (const PG8_LAS float*)(lds + PF_OFF + (u.ui & 1) * PF_IMG + 2048) + wc * 32 + 8 * fq;
        unsigned hold[2][4][2][2];
#pragma unroll
        for (int n = 0; n < 2; ++n) {
            f32x4 wg[3], wv[3], bg, bv;
#pragma unroll
            for (int j = 0; j < 3; ++j) { wg[j] = *(const PG8_LAS f32x4*)(cim + j * 256 + 4 * n); wv[j] = *(const PG8_LAS f32x4*)(cim + j * 256 + 128 + 4 * n); }
            bg = *(const PG8_LAS f32x4*)(cim + 3 * 256 + 4 * n); bv = *(const PG8_LAS f32x4*)(cim + 3 * 256 + 128 + 4 * n);
#pragma unroll
            for (int ai = 0; ai < 2; ++ai)
#pragma unroll
                for (int m = 0; m < 4; ++m) { f32x4 y[2];
#pragma unroll
                    for (int bj = 0; bj < 2; ++bj) { const f32x4 cur = acc[ai][bj][m][n], prv = acc[ai][bj][m > 0 ? m - 1 : 0][n];
                        const f32x4 x1 = m > 0 ? (fr == 15 ? prv : cur) : cur, x2 = m > 0 ? (fr >= 14 ? prv : cur) : cur;
                        const f32x4 u1 = dpp4<0x121>(x1), u2 = dpp4<0x122>(x2);
                        y[bj] = bj == 0 ? wg[0] * u2 + wg[1] * u1 + wg[2] * cur + bg : wv[0] * u2 + wv[1] * u1 + wv[2] * cur + bv; }
                    f32x4 av;
#pragma unroll
                    for (int e = 0; e < 4; ++e) av[e] = y[0][e] * __builtin_amdgcn_rcpf(1.f + __expf(-y[0][e])) * y[1][e];
                    hold[ai][m][n][0] = cvt_pk_bf16(av[0], av[1]); hold[ai][m][n][1] = cvt_pk_bf16(av[2], av[3]); }
        }
#pragma unroll
        for (int ai = 0; ai < 2; ++ai)
#pragma unroll
            for (int m = 0; m < 4; ++m) if (m > 0 || fr >= 2) { u32x4 w; w.x = hold[ai][m][0][0]; w.y = hold[ai][m][0][1]; w.z = hold[ai][m][1][0]; w.w = hold[ai][m][1][1];
                *(u32x4*)(ACT + (size_t)(rowg + ai * HALF + m * 16 + fr) * 5632 + jc) = w; }
    }
};
}

constexpr int I_QKV = 32 * 80, I_O = 32 * 64, I_GIN = 32 * 386, I_GOUT = 64 * 64, I_UP = 32 * 352, I_DN = 88 * 64;
constexpr int IT_O = I_QKV, IT_UP0 = IT_O + I_O, IT_DN0 = IT_UP0 + I_UP, IT_GIN = IT_DN0 + I_DN, IT_GOUT = IT_GIN + I_GIN, IT_UP1 = IT_GOUT + I_GOUT, IT_DN1 = IT_UP1 + I_UP, NITEMS = IT_DN1 + I_DN;
constexpr int IT_GIN_MID = IT_GIN + I_GIN / 2;
DI int up_row_off(int nb) { const int n0 = 32 * nb; const int nn = n0 < DFF ? n0 : n0 - DFF; return 256 * (nn >> 7) + (n0 < DFF ? 0 : 128) + (nn & 127) - n0; }
DI void p0_item(const P& p, int it, LAS float* scr, int lane) {
    unsigned char* ws = p.ws;
    if (it < IT_O) { p0_transpose_item(p.w_qkv, 2048, NQKV, (bf16*)(ws + WS_WQKV), 0, scr, it, lane); return; }
    if (it < IT_UP0) { p0_transpose_item(p.w_o, 2048, 2048, (bf16*)(ws + WS_WO), 0, scr, it - IT_O, lane); return; }
    if (it < IT_DN0) { const int r = it - IT_UP0; p0_transpose_item(p.w_up, 2048, NUP, (bf16*)(ws + WS_WUP0), up_row_off(r % (NUP / 32)), scr, r, lane); return; }
    if (it < IT_GIN) { p0_transpose_item(p.w_dn, DFF, 2048, (bf16*)(ws + WS_WDN0), 0, scr, it - IT_DN0, lane); return; }
    if (it < IT_GOUT) { p0_transpose_item(p.w_gin, 2048, NGIN, (bf16*)(ws + WS_WGIN), 0, scr, it - IT_GIN, lane); return; }
    if (it < IT_UP1) { p0_transpose_item(p.w_gout, 4096, 2048, (bf16*)(ws + WS_WGOUT), 0, scr, it - IT_GOUT, lane); return; }
    if (it < IT_DN1) { const int r = it - IT_UP1; p0_transpose_item(p.w_up + (size_t)2048 * NUP, 2048, NUP, (bf16*)(ws + WS_WUP1), up_row_off(r % (NUP / 32)), scr, r, lane); return; }
    p0_transpose_item(p.w_dn + (size_t)DFF * 2048, DFF, 2048, (bf16*)(ws + WS_WDN1), 0, scr, it - IT_DN1, lane);
}
DI int gv_kind(int it) { return (it >= IT_UP0 && it < IT_DN0) ? 0 : (it >= IT_GIN && it < IT_GOUT) ? 1 : (it >= IT_UP1 && it < IT_DN1) ? 2 : -1; }
DI void p0_item_gv(const P& p, int kind, int it, LAS float* scr, int lane, float (&ca)[8]) {
    unsigned char* ws = p.ws; const float* mod = (const float*)(ws + WS_MOD);
    const int r = it - (kind == 0 ? IT_UP0 : kind == 1 ? IT_GIN : IT_UP1), nblk = kind == 1 ? NGIN / 32 : NUP / 32, g = r >> 2, nb = g % nblk, kb = 4 * (g / nblk) + (r & 3);
    if (kind == 0) p0_transpose_item_t<true>(p.w_up, 2048, NUP, (bf16*)(ws + WS_WUP0), up_row_off(nb), scr, kb, nb, lane, mod + 3 * DM, ca);
    else if (kind == 1) p0_transpose_item_t<true>(p.w_gin, 2048, NGIN, (bf16*)(ws + WS_WGIN), 0, scr, kb, nb, lane, mod + (size_t)NMODROW * MODW, ca);
    else p0_transpose_item_t<true>(p.w_up + (size_t)2048 * NUP, 2048, NUP, (bf16*)(ws + WS_WUP1), up_row_off(nb), scr, kb, nb, lane, mod + (size_t)NMODROW * MODW + 3 * DM, ca);
}
DI void p0_gv_flush(const P& p, int kind, int it, int lane, float (&ca)[8]) {
    const int r = it - (kind == 0 ? IT_UP0 : kind == 1 ? IT_GIN : IT_UP1), nblk = kind == 1 ? NGIN / 32 : NUP / 32, nb = (r >> 2) % nblk, ldcv = kind == 1 ? NGIN : NUP;
    float* cv = (float*)(p.ws + WS_CTL) + CW_CV + (kind == 0 ? CV_UP0 : kind == 1 ? CV_GIN : CV_UP1);
#pragma unroll
    for (int i = 0; i < 8; ++i) { ca[i] += __shfl_xor(ca[i], 1); ca[i] += __shfl_xor(ca[i], 2); ca[i] += __shfl_xor(ca[i], 4); }
    const int c = lane & 7;
    float v = ca[0];
#pragma unroll
    for (int i = 1; i < 8; ++i) v = c == i ? ca[i] : v;
    atomicAdd(cv + (size_t)(c >> 2) * ldcv + (kind == 1 ? 0 : up_row_off(nb)) + 32 * nb + (lane >> 3) + 8 * (c & 3), v);
}
DI void convert_queue(const P& p, int qi, int lo, int hi, LAS unsigned char* lds, volatile LAS unsigned* misc, int tid, int wave, int lane, int max_batches = 1 << 30) {
    asm volatile("" : "+v"(tid), "+v"(lane));
    gu32* q = (gu32*)(p.ws + WS_CTL) + CW_QUEUE + 64 * qi;
    LAS float* scr = (LAS float*)(lds + wave * 16384);
    __syncthreads();
    for (int nb_ = 0; nb_ < max_batches; ++nb_) {
        if (tid == 0) misc[0] = __hip_atomic_fetch_add(q, 32u, __ATOMIC_RELAXED, __HIP_MEMORY_SCOPE_AGENT);
        __syncthreads();
        const int base = lo + (int)misc[0];
        __syncthreads();
        if (base >= hi) break;
        const int kind = gv_kind(base);
        if (kind < 0) {
#pragma unroll 1
            for (int i = 0; i < 4; ++i) { const int it = base + wave * 4 + i; if (it < hi) p0_item(p, it, scr, lane); }
        } else { float ca[8] = {0.f, 0.f, 0.f, 0.f, 0.f, 0.f, 0.f, 0.f};
#pragma unroll 1
            for (int i = 0; i < 4; ++i) p0_item_gv(p, kind, base + wave * 4 + i, scr, lane, ca);
            p0_gv_flush(p, kind, base + wave * 4, lane, ca); }
    }
}
constexpr int AD_ST = 0, AD_ST_LD = 1040;
constexpr int AD_WS = 64 * AD_ST_LD, AD_WS_LD = 400, AD_WS_SZ = 16 * AD_WS_LD;
constexpr int AD_RED = 0;
static_assert(AD_WS + 8 * AD_WS_SZ <= MISC_OFF && 8 * 34 * 96 * 4 <= MISC_OFF, "adaLN LDS");
DI void p0_adaln_unit(const P& p, int unit, LAS unsigned char* lds, int tid, int wave, int lane) {
    const int layer = unit >> 7, n0 = (unit & 127) * 96;
    const int c = lane & 31, h = lane >> 5;
    const float* wbase = p.w_ada + (size_t)layer * 2048 * MODW + n0;
    LAS unsigned char* wst = lds + AD_WS + wave * AD_WS_SZ;
    f32x16 acc[2][3];
#pragma unroll
    for (int mt = 0; mt < 2; ++mt)
#pragma unroll
        for (int nt = 0; nt < 3; ++nt) acc[mt][nt] = zero16();
    unsigned voff[6], loff[6];
#pragma unroll
    for (int i = 0; i < 6; ++i) { const int id = lane + 64 * i, sr = id / 24, sc4 = (id % 24) * 4; voff[i] = (unsigned)(sr * MODW + sc4) * 4u; loff[i] = (unsigned)(sr * AD_WS_LD + sc4 * 4); }
    __syncthreads();
    for (int i = tid; i < 30 * (AD_ST_LD / 4); i += 512) ((LAS unsigned*)(lds + AD_ST + 34 * AD_ST_LD))[i] = 0u;
    f32x4 wv[2][6];
#define AD_LOAD(slot, kstep) do { const GAS unsigned char* wk_ = (const GAS unsigned char*)wbase + (size_t)(kstep) * (16 * MODW * 4); \
        _Pragma("unroll") for (int i_ = 0; i_ < 6; ++i_) wv[slot][i_] = __builtin_nontemporal_load((const GAS f32x4*)(wk_ + voff[i_])); } while (0)
    AD_LOAD(0, 4 * wave + 0); AD_LOAD(1, 4 * wave + 1);
    for (int kc = 0; kc < 4; ++kc) {
        __syncthreads();
        for (int idx = tid; idx < 34 * 512; idx += 512) { const int r = idx >> 9, kk = idx & 511;
            const float cv = (r < 2) ? p.c_prompt[r * 2048 + kc * 512 + kk] : p.c_sample[(r - 2) * 2048 + kc * 512 + kk];
            *(LAS unsigned short*)(lds + AD_ST + r * AD_ST_LD + kk * 2) = f2bf16(silu_f(cv)); }
        __syncthreads();
#pragma unroll
        for (int j = 0; j < 4; ++j) {
            const int slot = j & 1;
#pragma unroll
            for (int i = 0; i < 6; ++i) *(LAS f32x4*)(wst + loff[i]) = wv[slot][i];
            { const int nj = j + 2, nkc = kc + (nj >> 2); if (nkc < 4) AD_LOAD(slot, nkc * 32 + 4 * wave + (nj & 3)); }
            const bf16x8 a0 = *(const LAS bf16x8*)(lds + AD_ST + c * AD_ST_LD + ((4 * wave + j) * 16 + 8 * h) * 2);
            const bf16x8 a1 = *(const LAS bf16x8*)(lds + AD_ST + (32 + c) * AD_ST_LD + ((4 * wave + j) * 16 + 8 * h) * 2);
#pragma unroll
            for (int nt = 0; nt < 3; ++nt) { float e[8];
#pragma unroll
                for (int q = 0; q < 8; ++q) e[q] = *(const LAS float*)(wst + (8 * h + q) * AD_WS_LD + (32 * nt + c) * 4);
                const bf16x8 bfr = __builtin_bit_cast(bf16x8, pack8f(e));
                acc[0][nt] = MFMA32(a0, bfr, acc[0][nt]); acc[1][nt] = MFMA32(a1, bfr, acc[1][nt]); }
        }
    }
#undef AD_LOAD
    __syncthreads();
    LAS float* red = (LAS float*)(lds + AD_RED);
#pragma unroll
    for (int nt = 0; nt < 3; ++nt) {
#pragma unroll
        for (int r = 0; r < 16; ++r) { red[(wave * 34 + crow(r, h)) * 96 + 32 * nt + c] = acc[0][nt][r];
            const int row1 = 32 + crow(r, h); if (row1 < 34) red[(wave * 34 + row1) * 96 + 32 * nt + c] = acc[1][nt][r]; } }
    __syncthreads();
    float* mod = (float*)(p.ws + WS_MOD);
    for (int idx = tid; idx < 34 * 96; idx += 512) { const int r = idx / 96, ci = idx - r * 96; float v = p.b_ada[layer * MODW + n0 + ci];
#pragma unroll
        for (int w = 0; w < 8; ++w) v += red[(w * 34 + r) * 96 + ci];
        mod[((size_t)layer * NMODROW + r) * MODW + n0 + ci] = v; }
    __syncthreads();
}
DI void p0_phase(const P& p, LAS unsigned char* lds, volatile LAS unsigned* misc, int tid, int wave, int lane, int rep) {
    const int G = gridDim.x, bx = blockIdx.x;
    { GAS v4u* z = (GAS v4u*)(p.ws + WS_WGIN + (size_t)NGIN * 2048 * 2); const int n = (NGINP - NGIN) * 2048 * 2 / 16;
      for (int i = bx * 512 + tid; i < n; i += G * 512) z[i] = (v4u){0u, 0u, 0u, 0u}; }
    for (int u = bx; u < 256; u += G) p0_adaln_unit(p, u, lds, tid, wave, lane);
    convert_queue(p, 2 * 0 + rep, 0, IT_UP0, lds, misc, tid, wave, lane);
}

DI void norm_phase(const float* xp, const float* xs, const float* gain, const float* modl, int shc, bf16* H, int tid, int wave, int lane, float* seed_s = nullptr, int row_lo = 0, int row_hi = MP, int bid = -1) {
    const int gw = (bid < 0 ? (int)blockIdx.x : bid) * 8 + wave, NGW = gridDim.x * 8;
    for (int row0 = row_lo + gw; row0 < row_hi; row0 += 2 * NGW) {
        f32x4 v[2][8]; float ss[2] = {0.f, 0.f}; bool live[2];
#pragma unroll
        for (int q = 0; q < 2; ++q) { const int row = row0 + q * NGW; live[q] = row < MTOK;
            if (live[q]) { const float* src = row < MPROMPT ? xp + (size_t)row * DM : xs + (size_t)(row - MPROMPT) * DM; const GAS f32x4* s4 = (const GAS f32x4*)src + lane;
#pragma unroll
                for (int j = 0; j < 8; ++j) v[q][j] = s4[64 * j]; } }
#pragma unroll
        for (int q = 0; q < 2; ++q) { const int row = row0 + q * NGW; if (row >= row_hi) continue;
            GAS v2u* o = (GAS v2u*)(H + (size_t)row * DM) + lane;
            if (!live[q]) {
#pragma unroll
                for (int j = 0; j < 8; ++j) o[64 * j] = (v2u){0u, 0u};
                continue; }
#pragma unroll
            for (int j = 0; j < 8; ++j) ss[q] += (v[q][j].x * v[q][j].x + v[q][j].y * v[q][j].y) + (v[q][j].z * v[q][j].z + v[q][j].w * v[q][j].w);
            if (seed_s != nullptr && row >= MPROMPT) {
#pragma unroll
                for (int j = 0; j < 8; ++j) ((GAS f32x4*)(seed_s + (size_t)(row - MPROMPT) * DM))[lane + 64 * j] = v[q][j]; }
            const int mr = row < MPROMPT ? (row >> 12) : 2 + ((row - MPROMPT) >> 2);
            const float rstd = rsqrtf(wave_sum(ss[q]) * (1.f / DM) + NORM_EPS);
            const GAS f32x4* g4 = (const GAS f32x4*)gain + lane;
            const GAS f32x4* sh4 = (const GAS f32x4*)(modl + (size_t)mr * MODW + shc * DM) + lane;
            const GAS f32x4* sc4 = sh4 + DM / 4;
#pragma unroll
            for (int j = 0; j < 8; ++j) { const f32x4 y = v[q][j] * rstd * g4[64 * j] * (sc4[64 * j] + 1.f) + sh4[64 * j];
                o[64 * j] = (v2u){pkbf(y.x, y.y), pkbf(y.z, y.w)}; }
        }
    }
}

DI void sample_prenorm(const P& p, int slot, const float* XR, const float* gain, const float* modl, int shc, bf16* H, int tid, int wave, int lane) {
    const int rb = (int)gridDim.x - 1 - (int)blockIdx.x;
    if (rb * 8 >= MTOK - MPROMPT) return;
    norm_phase(XR, XR + (size_t)MPROMPT * DM, gain, modl, shc, H, tid, wave, lane, nullptr, MPROMPT, MTOK, rb);
    asm volatile("s_waitcnt vmcnt(0)" ::: "memory");
    __syncthreads();
    if (tid == 0) { __builtin_amdgcn_fence(__ATOMIC_RELEASE, "agent"); asm volatile("s_waitcnt vmcnt(0)" ::: "memory");
        __hip_atomic_fetch_add((gu32*)(p.ws + WS_CTL) + CW_SNC + 64 * slot, 1u, __ATOMIC_RELAXED, __HIP_MEMORY_SCOPE_AGENT); }
}
DI void sample_prenorm_wait(const P& p, int slot, int tid) {
    const unsigned need = (unsigned)(((int)gridDim.x * 8 >= MTOK - MPROMPT) ? (MTOK - MPROMPT) / 8 : (int)gridDim.x);
    if (tid == 0) { gu32* cnt = (gu32*)(p.ws + WS_CTL) + CW_SNC + 64 * slot; unsigned spins = 0;
        while (__hip_atomic_load(cnt, __ATOMIC_RELAXED, __HIP_MEMORY_SCOPE_AGENT) < need && spins < (1u << 20)) { __builtin_amdgcn_s_sleep(4); ++spins; }
        __builtin_amdgcn_fence(__ATOMIC_ACQUIRE, "agent"); asm volatile("s_waitcnt vmcnt(0)" ::: "memory"); }
    __syncthreads();
}

constexpr int AT_KS = 144, AT_VT = 528;
constexpr int AT_KS_OFF = 0, AT_VT_OFF = 256 * AT_KS, AT_LUT_OFF = AT_VT_OFF + 64 * AT_VT, AT_END = AT_LUT_OFF + 8 * 132 * 4;
static_assert(AT_END <= MISC_OFF, "attention LDS");

template <bool SAMPLE>
DI void attn_tile(const P& p, LAS unsigned char* lds, int b, int kvh, int qb, int qt, int wave, int lane) {
    const int c = lane & 31, h = lane >> 5;
    const bf16* QKV = (const bf16*)(p.ws + WS_QKV);
    bf16* AO = (bf16*)(p.ws + WS_AO);
    int qrow, gq;
    if (!SAMPLE) { qrow = b * SEQ + qb * 128 + 32 * qt + c; gq = wave; } else { qrow = MPROMPT + 4 * b + (c >> 3); gq = c & 7; }
    const int head = kvh * 8 + gq;
    const float sinkv = p.sinks[head];
    bf16x8 qfr[4];
    {
        const bf16* qp = QKV + (size_t)qrow * NQKV + head * 64 + 8 * h;
        float qf[4][8]; float ss = 0.f;
#pragma unroll
        for (int s = 0; s < 4; ++s) { const v4u w = *(const GAS v4u*)(qp + 16 * s); unpack8(w, qf[s]);
#pragma unroll
            for (int j = 0; j < 8; ++j) ss += qf[s][j] * qf[s][j]; }
        ss += __shfl_xor(ss, 32);
        const float rs = rsqrtf(ss * (1.f / 64.f) + NORM_EPS) * 0.125f;
#pragma unroll
        for (int s = 0; s < 4; ++s) { float y[8];
#pragma unroll
            for (int j = 0; j < 8; ++j) y[j] = qf[s][j] * rs * p.q_norm[16 * s + 8 * h + j];
            qfr[s] = __builtin_bit_cast(bf16x8, pack8f(y)); }
    }
    const int kt0 = SAMPLE ? 0 : qt;
    f32x16 sc[5];
#pragma unroll
    for (int i = 0; i < 5; ++i) { f32x16 acc = zero16();
#pragma unroll
        for (int s = 0; s < 4; ++s) { const bf16x8 a = *(const LAS bf16x8*)(lds + AT_KS_OFF + (32 * (kt0 + i) + c) * AT_KS + (16 * s + 8 * h) * 2); acc = MFMA32(a, qfr[s], acc); }
        sc[i] = acc; }
    const LAS float* lut = (const LAS float*)(lds + AT_LUT_OFF) + gq * 132;
    float m = sinkv;
#pragma unroll
    for (int i = 0; i < 5; ++i)
#pragma unroll
        for (int r = 0; r < 16; ++r) { const int key = 32 * (kt0 + i) + crow(r, h); int dist; bool valid;
            if (!SAMPLE) { dist = 32 * qt + c + 128 - key; valid = (dist >= 0) && (dist <= 128) && (qb > 0 || key >= 128); }
            else { dist = (c >> 3) + 128 - key; valid = (dist >= 0) && (dist <= 128) && (key < 132); }
            const int dcl = dist < 0 ? 0 : (dist > 128 ? 128 : dist);
            const float v = valid ? sc[i][r] + lut[dcl] : -1e30f; sc[i][r] = v; m = fmaxf(m, v); }
    m = fmaxf(m, __shfl_xor(m, 32));
    float l = 0.f;
#pragma unroll
    for (int i = 0; i < 5; ++i)
#pragma unroll
        for (int r = 0; r < 16; ++r) { const float e = __expf(sc[i][r] - m); sc[i][r] = e; l += e; }
    l += __shfl_xor(l, 32);
    l += __expf(sinkv - m);
    f32x16 o[2]; o[0] = zero16(); o[1] = zero16();
#pragma unroll
    for (int i = 0; i < 5; ++i) {
        const bf16x8 b0 = pack_acc<0>(sc[i]), b1 = pack_acc<1>(sc[i]);
#pragma unroll
        for (int dt = 0; dt < 2; ++dt) {
            const LAS unsigned char* vp = lds + AT_VT_OFF + (32 * dt + c) * AT_VT + (32 * (kt0 + i) + 8 * h) * 2;
            const bf16x8 a0 = *(const LAS bf16x8*)(vp), a1 = *(const LAS bf16x8*)(vp + 32);
            o[dt] = MFMA32(a0, b0, o[dt]); o[dt] = MFMA32(a1, b1, o[dt]); }
    }
    const float inv = 1.f / l;
    bf16* op = AO + (size_t)qrow * DM + head * 64;
#pragma unroll
    for (int dt = 0; dt < 2; ++dt)
#pragma unroll
        for (int q4 = 0; q4 < 4; ++q4) { const int d0 = 32 * dt + 8 * q4 + 4 * h;
            *(GAS v2u*)(op + d0) = (v2u){pkbf(o[dt][4 * q4] * inv, o[dt][4 * q4 + 1] * inv), pkbf(o[dt][4 * q4 + 2] * inv, o[dt][4 * q4 + 3] * inv)}; }
}

template <bool SAMPLE>
DI void attn_unit(const P& p, int unit, LAS unsigned char* lds, int tid, int wave, int lane) {
    int b, kvh, qb;
    if (!SAMPLE) { kvh = unit & 3; qb = (unit >> 2) & 31; b = unit >> 7; } else { kvh = unit & 3; b = unit >> 2; qb = 0; }
    const bf16* QKV = (const bf16*)(p.ws + WS_QKV);
    __syncthreads();
    constexpr int NK = SAMPLE ? 160 : 256;
    for (int cidx = tid; cidx < NK * 8; cidx += 512) {
        const int key = cidx >> 3, part = cidx & 7;
        float kx[8], vx[8]; bool need_norm = false, have = false;
#pragma unroll
        for (int e = 0; e < 8; ++e) { kx[e] = 0.f; vx[e] = 0.f; }
        if (!SAMPLE) {
            const int pos = qb * 128 - 128 + key;
            if (pos >= 0) { const bf16* rp = QKV + (size_t)(b * SEQ + pos) * NQKV + 2048 + kvh * 64 + part * 8;
                unpack8(*(const GAS v4u*)rp, kx); unpack8(*(const GAS v4u*)(rp + 256), vx); need_norm = true; have = true; }
        } else {
            if (key < 128) { const size_t off = ((size_t)(b * 128 + key) * 4 + kvh) * 64 + part * 8;
                const f32x4 k0 = *(const GAS f32x4*)(p.cache_k + off), k1 = *(const GAS f32x4*)(p.cache_k + off + 4), v0 = *(const GAS f32x4*)(p.cache_v + off), v1 = *(const GAS f32x4*)(p.cache_v + off + 4);
                kx[0] = k0.x; kx[1] = k0.y; kx[2] = k0.z; kx[3] = k0.w; kx[4] = k1.x; kx[5] = k1.y; kx[6] = k1.z; kx[7] = k1.w;
                vx[0] = v0.x; vx[1] = v0.y; vx[2] = v0.z; vx[3] = v0.w; vx[4] = v1.x; vx[5] = v1.y; vx[6] = v1.z; vx[7] = v1.w; have = true; }
            else if (key < 132) { const bf16* rp = QKV + (size_t)(MPROMPT + 4 * b + key - 128) * NQKV + 2048 + kvh * 64 + part * 8;
                unpack8(*(const GAS v4u*)rp, kx); unpack8(*(const GAS v4u*)(rp + 256), vx); need_norm = true; have = true; }
        }
        float ss = 0.f;
#pragma unroll
        for (int e = 0; e < 8; ++e) ss += kx[e] * kx[e];
        ss += __shfl_xor(ss, 1); ss += __shfl_xor(ss, 2); ss += __shfl_xor(ss, 4);
        if (need_norm) { const float rs = rsqrtf(ss * (1.f / 64.f) + NORM_EPS);
#pragma unroll
            for (int e = 0; e < 8; ++e) kx[e] = kx[e] * rs * p.k_norm[part * 8 + e]; }
        *(LAS v4u*)(lds + AT_KS_OFF + key * AT_KS + part * 16) = pack8f(kx);
        const int kpos = pos64(key);
#pragma unroll
        for (int e = 0; e < 8; ++e) *(LAS unsigned short*)(lds + AT_VT_OFF + (part * 8 + e) * AT_VT + kpos * 2) = f2bf16(vx[e]);
        if (!SAMPLE) {
            if (qb == 31 && key >= 128) { const size_t off = ((size_t)(b * 128 + key - 128) * 4 + kvh) * 64 + part * 8;
                float* ok = p.out + O_WKP + off; float* ov = p.out + O_WVP + off;
                *(GAS f32x4*)ok = (f32x4){kx[0], kx[1], kx[2], kx[3]}; *(GAS f32x4*)(ok + 4) = (f32x4){kx[4], kx[5], kx[6], kx[7]};
                *(GAS f32x4*)ov = (f32x4){vx[0], vx[1], vx[2], vx[3]}; *(GAS f32x4*)(ov + 4) = (f32x4){vx[4], vx[5], vx[6], vx[7]}; }
        } else {
            if (have && key >= 4) { const size_t off = ((size_t)(b * 128 + key - 4) * 4 + kvh) * 64 + part * 8;
                float* ok = p.out + O_WKS + off; float* ov = p.out + O_WVS + off;
                *(GAS f32x4*)ok = (f32x4){kx[0], kx[1], kx[2], kx[3]}; *(GAS f32x4*)(ok + 4) = (f32x4){kx[4], kx[5], kx[6], kx[7]};
                *(GAS f32x4*)ov = (f32x4){vx[0], vx[1], vx[2], vx[3]}; *(GAS f32x4*)(ov + 4) = (f32x4){vx[4], vx[5], vx[6], vx[7]}; }
        }
    }
    for (int i = tid; i < 8 * 132; i += 512) { const int g = i / 132, d = i - g * 132; float v = 0.f;
        if (d <= 128) { int bk = d;
            if (d >= 16) { bk = 16 + (int)(__logf((float)d * (1.f / 16.f)) / 2.0794415416798357f * 16.f); bk = bk > 31 ? 31 : bk; }
            v = p.rel_table[bk * 32 + kvh * 8 + g]; }
        ((LAS float*)(lds + AT_LUT_OFF))[i] = v; }
    __syncthreads();
    if (!SAMPLE) {
#pragma unroll 1
        for (int qt = 0; qt < 4; ++qt) attn_tile<false>(p, lds, b, kvh, qb, qt, wave, lane);
    } else { if (wave == 0) attn_tile<true>(p, lds, b, kvh, 0, 0, wave, lane); }
}
DI void attn_phase(const P& p, LAS unsigned char* lds, int tid, int wave, int lane) {
    const int G = gridDim.x;
    for (int u = blockIdx.x; u < 256 + 128; u += G) { if (u < 256) attn_unit<false>(p, u, lds, tid, wave, lane); else attn_unit<true>(p, u - 256, lds, tid, wave, lane); }
    __syncthreads();
}

DI void ffn_act_phase(const P& p, int layer, int tid) {
    const bf16* U = (const bf16*)(p.ws + WS_BIG);
    bf16* ACT = (bf16*)(p.ws + WS_ACT);
    const float* cw = p.fconv_w + (size_t)layer * 3 * NUP; const float* cb = p.fconv_b + (size_t)layer * NUP;
    constexpr int NOCT = DFF / 8, NPR = (MPROMPT / 64) * NOCT, NTASK = NPR + 32 * NOCT, NCPY = 2 * 2 * (NUP / 8);
    for (int task = blockIdx.x * 512 + tid; task < NTASK; task += gridDim.x * 512) {
        int row0, nrows, oct; bool samp; int sb = 0;
#if defined(EPIACT_RAW)
        if (task < NPR) { const int run = task / NOCT; oct = task - run * NOCT; row0 = run * 64; nrows = 64; samp = false; }
#else
        if (task < NPR) { const int run = task / NOCT; oct = task - run * NOCT; row0 = run * 64; nrows = 2; samp = false; }
#endif
        else { const int t2 = task - NPR; sb = t2 / NOCT; oct = t2 - sb * NOCT; row0 = MPROMPT + 4 * sb; nrows = 4; samp = true; }
        const int cg = oct * 8, cv = DFF + oct * 8;
        float wg[3][8], wv[3][8], bg[8], bv[8];
#pragma unroll
        for (int j = 0; j < 3; ++j)
#pragma unroll
            for (int e = 0; e < 8; ++e) { wg[j][e] = cw[j * NUP + cg + e]; wv[j][e] = cw[j * NUP + cv + e]; }
#pragma unroll
        for (int e = 0; e < 8; ++e) { bg[e] = cb[cg + e]; bv[e] = cb[cv + e]; }
        float g0[8], g1[8], v0[8], v1[8];
        if (samp) { const float* h0 = p.state_fconv + ((size_t)(layer * 32 + sb) * 2) * NUP;
#pragma unroll
            for (int e = 0; e < 8; ++e) { g0[e] = h0[cg + e]; v0[e] = h0[cv + e]; g1[e] = h0[NUP + cg + e]; v1[e] = h0[NUP + cv + e]; } }
        else if ((row0 & (SEQ - 1)) == 0) {
#pragma unroll
            for (int e = 0; e < 8; ++e) { g0[e] = 0.f; g1[e] = 0.f; v0[e] = 0.f; v1[e] = 0.f; } }
        else { unpack8(*(const GAS v4u*)(U + (size_t)(row0 - 2) * NUP + cg), g0); unpack8(*(const GAS v4u*)(U + (size_t)(row0 - 2) * NUP + cv), v0);
               unpack8(*(const GAS v4u*)(U + (size_t)(row0 - 1) * NUP + cg), g1); unpack8(*(const GAS v4u*)(U + (size_t)(row0 - 1) * NUP + cv), v1); }
#pragma unroll 4
        for (int i = 0; i < nrows; ++i) {
            const int row = row0 + i; float g2[8], v2[8], a[8];
            unpack8(*(const GAS v4u*)(U + (size_t)row * NUP + cg), g2); unpack8(*(const GAS v4u*)(U + (size_t)row * NUP + cv), v2);
#pragma unroll
            for (int e = 0; e < 8; ++e) { const float yg = wg[0][e] * g0[e] + wg[1][e] * g1[e] + wg[2][e] * g2[e] + bg[e];
                const float yv = wv[0][e] * v0[e] + wv[1][e] * v1[e] + wv[2][e] * v2[e] + bv[e]; a[e] = silu_f(yg) * yv; }
            *(GAS v4u*)(ACT + (size_t)row * DFF + cg) = pack8f(a);
            int orow = -1; float* ob = nullptr;
            if (samp) { if (i >= 2) { orow = i - 2; ob = p.out + O_FCS + ((size_t)(layer * 32 + sb) * 2) * NUP; } }

            if (orow >= 0) { float* o = ob + (size_t)orow * NUP;
                *(GAS f32x4*)(o + cg) = (f32x4){g2[0], g2[1], g2[2], g2[3]}; *(GAS f32x4*)(o + cg + 4) = (f32x4){g2[4], g2[5], g2[6], g2[7]};
                *(GAS f32x4*)(o + cv) = (f32x4){v2[0], v2[1], v2[2], v2[3]}; *(GAS f32x4*)(o + cv + 4) = (f32x4){v2[4], v2[5], v2[6], v2[7]}; }
#pragma unroll
            for (int e = 0; e < 8; ++e) { g0[e] = g1[e]; g1[e] = g2[e]; v0[e] = v1[e]; v1[e] = v2[e]; }
        }
    }
    for (int t = blockIdx.x * 512 + tid; t < NCPY; t += gridDim.x * 512) { const int c8 = t % (NUP / 8), rr = (t / (NUP / 8)) & 1, bb = t / (2 * (NUP / 8));
        float x[8]; unpack8(*(const GAS v4u*)(U + (size_t)(bb * SEQ + SEQ - 2 + rr) * NUP + c8 * 8), x);
        float* o = p.out + O_FCP + ((size_t)(layer * 2 + bb) * 2 + rr) * NUP + c8 * 8;
        *(GAS f32x4*)o = (f32x4){x[0], x[1], x[2], x[3]}; *(GAS f32x4*)(o + 4) = (f32x4){x[4], x[5], x[6], x[7]}; }
}

constexpr int CH_VB = 0, CH_VB_LD = 528;
constexpr int CH_KB = 33792, CH_QB = 51200, CH_KQ_LD = 272;
constexpr int CH_VEC = 68608;
constexpr int CH_A = 69632, CH_A_LD = 68;
static_assert(CH_A + 2 * 64 * CH_A_LD * 4 <= MISC_OFF, "chunk LDS");

DI void gdn_tsolve(const LAS float* Am, bf16* Tg, int lane) {
    asm volatile("" : "+v"(lane));
    const int pc = pos64(lane);
    f32x2 T2[32];
#pragma unroll
    for (int k = 0; k < 32; ++k) T2[k] = (f32x2){0.f, 0.f};
    f32x4 an[16];
#pragma unroll
    for (int q = 0; q < 16; ++q) an[q] = (f32x4){0.f, 0.f, 0.f, 0.f};
#pragma unroll
    for (int i = 0; i < 64; ++i) {
        f32x4 ac[16];
        if (i < 40) {
#pragma unroll
            for (int q = 0; q < 16; ++q) ac[q] = an[q];
            if (i + 1 < 40) {
#pragma unroll
                for (int q = 0; q < (i + 1 + 3) / 4; ++q) an[q] = *(const LAS f32x4*)(Am + (i + 1) * CH_A_LD + 4 * q); }
        } else {
#pragma unroll
            for (int q = 0; q < (i + 3) / 4; ++q) ac[q] = *(const LAS f32x4*)(Am + i * CH_A_LD + 4 * q);
        }
        __builtin_amdgcn_sched_barrier(0);
        f32x2 s0 = (f32x2){0.f, 0.f}, s1 = (f32x2){0.f, 0.f};
#pragma unroll
        for (int q = 0; q < (i + 3) / 4; ++q) { s0 += (f32x2){ac[q].x, ac[q].y} * T2[2 * q]; s1 += (f32x2){ac[q].z, ac[q].w} * T2[2 * q + 1]; }
        const float ti = ((i == lane) ? 1.f : 0.f) - ((s0.x + s0.y) + (s1.x + s1.y));
        T2[i >> 1][i & 1] = ti;
        Tg[i * 64 + pc] = f2bf16(ti);
        __builtin_amdgcn_sched_barrier(0);
    }
}

#ifndef CHUNK_DUP
#define CHUNK_DUP 0
#endif
template <bool NOST>
DI void gdn_chunk_phase(const P& p, LAS unsigned char* lds, int tid, int wave, int lane) {
    const bf16* PROJ = (const bf16*)(p.ws + WS_BIG);
    const float* BA = (const float*)(p.ws + WS_BA);
    LAS float* vec = (LAS float*)(lds + CH_VEC);
    const bool solver = wave < 2;
    int wt = solver ? 0 : (wave - 2) * 64 + lane;
    const int G = gridDim.x;
    int prev_unit = -1;
    v4u xs[2][10];
#define CH_LOADU(XN, tsk, un) do { const int un_ = (un), n_ = un_ & 63, kh_ = (un_ >> 6) & 15, b_ = (un_ >> 10) & 1, cg_ = wt & 31, tp_ = (tsk) >> 5; \
        const int pc_ = cg_ < 8 ? kh_ * 128 + cg_ * 16 : (cg_ < 16 ? 2048 + kh_ * 128 + (cg_ - 8) * 16 : 4096 + 2 * kh_ * 128 + (cg_ - 16) * 16); \
        _Pragma("unroll") for (int k_ = 0; k_ < 5; ++k_) { int tr_ = n_ * 64 + 2 * tp_ - 3 + k_; tr_ = tr_ < 0 ? 0 : tr_; \
            const bf16* rp_ = PROJ + (size_t)(b_ * SEQ + tr_) * NGINP + pc_; XN[2 * k_] = *(const GAS v4u*)rp_; XN[2 * k_ + 1] = *(const GAS v4u*)(rp_ + 8); } } while (0)
    float s1v[4] = {0.f, 0.f, 0.f, 0.f};
#define CH_LOADS(un) do { if (wt < 128) { const int us_ = (un), hd_ = 2 * ((us_ >> 6) & 15) + (wt >> 6); const size_t ro_ = (size_t)(((us_ >> 10) & 1) * SEQ + (us_ & 63) * 64 + (wt & 63)) * 64; \
        s1v[0] = BA[ro_ + hd_]; s1v[1] = BA[ro_ + 32 + hd_]; s1v[2] = p.a_log[hd_]; s1v[3] = p.dt_bias[hd_]; } } while (0)
    if (!solver) { const int u0_ = (int)blockIdx.x < 2048 ? (int)blockIdx.x : 2047; CH_LOADS(u0_); CH_LOADU(xs[0], wt, u0_); CH_LOADU(xs[1], wt + 384, u0_); }
    __syncthreads();
    if (solver) {
    for (int unit = blockIdx.x; ; unit += G) {
        asm volatile("" : "+v"(tid), "+v"(lane));
        const bool live = unit < 2048;
        const int n = unit & 63, kh = (unit >> 6) & 15, b = (unit >> 10) & 1;
        const int R0 = b * SEQ + n * 64;
        {
            if (prev_unit >= 0) { const int pn = prev_unit & 63, pkh = (prev_unit >> 6) & 15, pb = prev_unit >> 10, hh = wave;
                gdn_tsolve((const LAS float*)(lds + CH_A) + hh * 64 * CH_A_LD, (bf16*)(p.ws + WS_TH + (size_t)((pb * 32 + 2 * pkh + hh) * 64 + pn) * 32768), lane); }
        }
        __syncthreads();
        if (!live) break;
        {
            unsigned char* kq = p.ws + WS_KQ + (size_t)((b * 16 + kh) * 64 + n) * 49152;
#pragma unroll
            for (int i = 0; i < 2; ++i) { const int cc = tid + 512 * i, t = cc >> 4, ch = cc & 15;
                const int dlo = 32 * (ch >> 2) + 16 * ((ch >> 1) & 1) + 4 * (ch & 1);
                const v2u ka = *(const LAS v2u*)(lds + CH_KB + t * CH_KQ_LD + dlo * 2), kb2 = *(const LAS v2u*)(lds + CH_KB + t * CH_KQ_LD + (dlo + 8) * 2);
                const v2u qa = *(const LAS v2u*)(lds + CH_QB + t * CH_KQ_LD + dlo * 2), qb2 = *(const LAS v2u*)(lds + CH_QB + t * CH_KQ_LD + (dlo + 8) * 2);
                { const v4u s_ = (v4u){ka.x, ka.y, kb2.x, kb2.y}; if constexpr (NOST) asm volatile("" :: "v"(s_)); else *(GAS v4u*)(kq + (size_t)t * 256 + ch * 16) = s_; }
                { const v4u s_ = (v4u){qa.x, qa.y, qb2.x, qb2.y}; if constexpr (NOST) asm volatile("" :: "v"(s_)); else *(GAS v4u*)(kq + 16384 + (size_t)t * 256 + ch * 16) = s_; } }
            if (tid < 256) {
#pragma unroll
                for (int q = 0; q < 4; ++q) { const int item = q * 256 + tid, d = item >> 3, ch = item & 7; const int tlo = 32 * (ch >> 2) + 16 * ((ch >> 1) & 1) + 4 * (ch & 1); unsigned short e[8];
#pragma unroll
                    for (int j = 0; j < 8; ++j) e[j] = *(const LAS unsigned short*)(lds + CH_KB + (tlo + 8 * (j >> 2) + (j & 3)) * CH_KQ_LD + d * 2);
                    { const v4u s_ = (v4u){(unsigned)e[0] | ((unsigned)e[1] << 16), (unsigned)e[2] | ((unsigned)e[3] << 16), (unsigned)e[4] | ((unsigned)e[5] << 16), (unsigned)e[6] | ((unsigned)e[7] << 16)}; if constexpr (NOST) asm volatile("" :: "v"(s_)); else *(GAS v4u*)(kq + 32768 + (size_t)d * 128 + ch * 16) = s_; } } }
            {
#pragma unroll
                for (int q = 0; q < 4; ++q) { const int item = q * 512 + tid, hh = item >> 10, v = (item >> 3) & 127, ch = item & 7; const int tlo = 32 * (ch >> 2) + 16 * ((ch >> 1) & 1) + 4 * (ch & 1); float e[8];
                    unsigned char* th = p.ws + WS_TH + (size_t)((b * 32 + 2 * kh + hh) * 64 + n) * 32768;
#pragma unroll
                    for (int j = 0; j < 8; ++j) { const int tj = tlo + 8 * (j >> 2) + (j & 3); e[j] = bf2f(*(const LAS unsigned short*)(lds + CH_VB + tj * CH_VB_LD + (hh * 128 + v) * 2)) * vec[hh * 64 + tj]; }
                    { const v4u s_ = pack8f(e); if constexpr (NOST) asm volatile("" :: "v"(s_)); else *(GAS v4u*)(th + 16384 + (size_t)v * 128 + ch * 16) = s_; } } }
            if (tid < 128) { const int hh = tid >> 6, t = tid & 63; float* vo = (float*)(p.ws + WS_VEC) + (size_t)((b * 32 + 2 * kh + hh) * 64 + n) * 256;
                const float beta = vec[hh * 64 + t], gc = vec[128 + hh * 64 + t], gl = vec[128 + hh * 64 + 63];
                vo[t] = __expf(gc); vo[64 + t] = beta * __expf(gc); vo[128 + t] = __expf(gl - gc); vo[192 + t] = __expf(gl); }
        }
        {
            f32x16 accK = zero16(), accQ = zero16();
            const int hh = wave >> 2, mt = (wave >> 1) & 1, nt = wave & 1, c = lane & 31, h = lane >> 5;
#pragma unroll
            for (int s8 = 0; s8 < 8; ++s8) {
                const bf16x8 bk = *(const LAS bf16x8*)(lds + CH_KB + (32 * nt + c) * CH_KQ_LD + (16 * s8 + 8 * h) * 2);
                const bf16x8 ak = *(const LAS bf16x8*)(lds + CH_KB + (32 * mt + c) * CH_KQ_LD + (16 * s8 + 8 * h) * 2);
                const bf16x8 aq = *(const LAS bf16x8*)(lds + CH_QB + (32 * mt + c) * CH_KQ_LD + (16 * s8 + 8 * h) * 2);
                accK = MFMA32(ak, bk, accK); accQ = MFMA32(aq, bk, accQ); }
            const int j = 32 * nt + c; const float gj = vec[128 + hh * 64 + j];
            bf16* qkg = (bf16*)(p.ws + WS_TH + (size_t)((b * 32 + 2 * kh + hh) * 64 + n) * 32768 + 8192);
            LAS float* Am = (LAS float*)(lds + CH_A) + hh * 64 * CH_A_LD;
#pragma unroll
            for (int r = 0; r < 16; ++r) { const int i = 32 * mt + crow(r, h);
                const float gi = vec[128 + hh * 64 + i], bi = vec[hh * 64 + i];
                const float dec = __expf(fminf(gi - gj, 0.f));
                Am[i * CH_A_LD + j] = (i > j) ? bi * accK[r] * dec : 0.f;
                qkg[i * 64 + pos64(j)] = f2bf16((i >= j) ? accQ[r] * dec : 0.f); }
        }
        __syncthreads();
        prev_unit = unit;
    }
    } else {
    for (int unit = blockIdx.x; ; unit += G) {
        asm volatile("" : "+v"(tid), "+v"(lane));
        const bool live = unit < 2048;
        const int n = unit & 63, kh = (unit >> 6) & 15, b = (unit >> 10) & 1;
        const int R0 = b * SEQ + n * 64;
        if (live) {
            asm volatile("" : "+v"(wt));
            if (wt < 128) { const int hh = wt >> 6, t = wt & 63;
                const float bv = s1v[0], av = s1v[1];
                const float beta = sigmoid_f(bv);
                float g = -__expf(s1v[2]) * softplus_f(av + s1v[3]);
#pragma unroll
                for (int o = 1; o < 64; o <<= 1) { const float up = __shfl_up(g, o); if (t >= o) g += up; }
                vec[hh * 64 + t] = beta; vec[128 + hh * 64 + t] = g; }
            const int cgi = wt & 31;
            const int pc0 = cgi < 8 ? kh * 128 + cgi * 16 : (cgi < 16 ? 2048 + kh * 128 + (cgi - 8) * 16 : 4096 + 2 * kh * 128 + (cgi - 16) * 16);
#define CH_LOADX(XN, tsk) do { const int tp_ = (tsk) >> 5; _Pragma("unroll") for (int k_ = 0; k_ < 5; ++k_) { int tr_ = n * 64 + 2 * tp_ - 3 + k_; tr_ = tr_ < 0 ? 0 : tr_; \
                const bf16* rp_ = PROJ + (size_t)(b * SEQ + tr_) * NGINP + pc0; XN[2 * k_] = *(const GAS v4u*)rp_; XN[2 * k_ + 1] = *(const GAS v4u*)(rp_ + 8); } } while (0)
#pragma unroll
            for (int it3 = 0; it3 < 3; ++it3) { const int it = it3 & 1;
                const int task = wt + 384 * it3; const int tp = task >> 5;
                const bool act = task < 1024;
                f32x2 y0p[8], y1p[8];
#pragma unroll
                for (int e = 0; e < 8; ++e) { y0p[e] = (f32x2){0.f, 0.f}; y1p[e] = (f32x2){0.f, 0.f}; }
                f32x4 wprev[4];
#pragma unroll
                for (int k = 0; k < 5; ++k) { const int tr = 2 * tp - 3 + k;
                    f32x4 wcur[4];
                    if (k < 4) { int woff = k * 8192 + pc0; asm volatile("" : "+v"(woff));
#pragma unroll
                        for (int q = 0; q < 4; ++q) wcur[q] = *(const GAS f32x4*)(p.gconv_w + woff + 4 * q); }
                    const unsigned km = (n > 0 || tr >= 0) ? 0xFFFFFFFFu : 0u;
                    const v4u wa = xs[it][2 * k], wb = xs[it][2 * k + 1];
                    f32x2 x2[8];
                    x2[0] = (f32x2){bflo(wa.x & km), bfhi(wa.x & km)}; x2[1] = (f32x2){bflo(wa.y & km), bfhi(wa.y & km)}; x2[2] = (f32x2){bflo(wa.z & km), bfhi(wa.z & km)}; x2[3] = (f32x2){bflo(wa.w & km), bfhi(wa.w & km)};
                    x2[4] = (f32x2){bflo(wb.x & km), bfhi(wb.x & km)}; x2[5] = (f32x2){bflo(wb.y & km), bfhi(wb.y & km)}; x2[6] = (f32x2){bflo(wb.z & km), bfhi(wb.z & km)}; x2[7] = (f32x2){bflo(wb.w & km), bfhi(wb.w & km)};
                    if (k < 4) {
#pragma unroll
                        for (int e = 0; e < 8; ++e) y0p[e] += (f32x2){wcur[e >> 1][2 * (e & 1)], wcur[e >> 1][2 * (e & 1) + 1]} * x2[e]; }
                    if (k >= 1) {
#pragma unroll
                        for (int e = 0; e < 8; ++e) y1p[e] += (f32x2){wprev[e >> 1][2 * (e & 1)], wprev[e >> 1][2 * (e & 1) + 1]} * x2[e]; }
#pragma unroll
                    for (int q = 0; q < 4; ++q) wprev[q] = wcur[q];
                    if (k >= 3 && act && n == 63 && tr >= 61) { float* o = p.out + O_GCP + (size_t)(b * 3 + (tr - 61)) * 8192 + pc0;
#pragma unroll
                        for (int q = 0; q < 4; ++q) *(GAS f32x4*)(o + 4 * q) = (f32x4){x2[2 * q].x, x2[2 * q].y, x2[2 * q + 1].x, x2[2 * q + 1].y}; } }
                float y0[16], y1[16];
                f32x2 sp0 = (f32x2){0.f, 0.f}, sp1 = (f32x2){0.f, 0.f};
#pragma unroll
                for (int e = 0; e < 8; ++e) {
                    f32x2 a = y0p[e], c2 = y1p[e];
                    a = a * (f32x2){__builtin_amdgcn_rcpf(1.f + __expf(-a.x)), __builtin_amdgcn_rcpf(1.f + __expf(-a.y))};
                    c2 = c2 * (f32x2){__builtin_amdgcn_rcpf(1.f + __expf(-c2.x)), __builtin_amdgcn_rcpf(1.f + __expf(-c2.y))};
                    sp0 += a * a; sp1 += c2 * c2;
                    y0[2 * e] = a.x; y0[2 * e + 1] = a.y; y1[2 * e] = c2.x; y1[2 * e + 1] = c2.y; }
                float ss0 = sp0.x + sp0.y, ss1 = sp1.x + sp1.y;
                ss0 += __shfl_xor(ss0, 1); ss0 += __shfl_xor(ss0, 2); ss0 += __shfl_xor(ss0, 4);
                ss1 += __shfl_xor(ss1, 1); ss1 += __shfl_xor(ss1, 2); ss1 += __shfl_xor(ss1, 4);
                if (act) {
                    float r0 = 1.f, r1 = 1.f; LAS unsigned char* dst; int ld;
                    if (cgi < 8) { r0 = rsqrtf(ss0 + NORM_EPS) * 0.08838834764831845f; r1 = rsqrtf(ss1 + NORM_EPS) * 0.08838834764831845f; dst = lds + CH_QB + 2 * tp * CH_KQ_LD + cgi * 32; ld = CH_KQ_LD; }
                    else if (cgi < 16) { r0 = rsqrtf(ss0 + NORM_EPS); r1 = rsqrtf(ss1 + NORM_EPS); dst = lds + CH_KB + 2 * tp * CH_KQ_LD + (cgi - 8) * 32; ld = CH_KQ_LD; }
                    else { dst = lds + CH_VB + 2 * tp * CH_VB_LD + (cgi - 16) * 32; ld = CH_VB_LD; }
                    v4u o0, o1;
                    o0.x = pkbf(y0[0] * r0, y0[1] * r0); o0.y = pkbf(y0[2] * r0, y0[3] * r0); o0.z = pkbf(y0[4] * r0, y0[5] * r0); o0.w = pkbf(y0[6] * r0, y0[7] * r0);
                    o1.x = pkbf(y0[8] * r0, y0[9] * r0); o1.y = pkbf(y0[10] * r0, y0[11] * r0); o1.z = pkbf(y0[12] * r0, y0[13] * r0); o1.w = pkbf(y0[14] * r0, y0[15] * r0);
                    *(LAS v4u*)dst = o0; *(LAS v4u*)(dst + 16) = o1;
                    o0.x = pkbf(y1[0] * r1, y1[1] * r1); o0.y = pkbf(y1[2] * r1, y1[3] * r1); o0.z = pkbf(y1[4] * r1, y1[5] * r1); o0.w = pkbf(y1[6] * r1, y1[7] * r1);
                    o1.x = pkbf(y1[8] * r1, y1[9] * r1); o1.y = pkbf(y1[10] * r1, y1[11] * r1); o1.z = pkbf(y1[12] * r1, y1[13] * r1); o1.w = pkbf(y1[14] * r1, y1[15] * r1);
                    *(LAS v4u*)(dst + ld) = o0; *(LAS v4u*)(dst + ld + 16) = o1;
                }
                if (it3 == 0) { int tk_ = wt + 768; tk_ = tk_ < 1024 ? tk_ : 1023; asm volatile("" : "+v"(tk_)); CH_LOADX(xs[0], tk_); }
            }
#undef CH_LOADX
        }
        __syncthreads();
        if (!live) break;
        { int nxu = unit + G; nxu = nxu < 2048 ? nxu : unit; asm volatile("" : "+v"(wt)); CH_LOADS(nxu); CH_LOADU(xs[0], wt, nxu); CH_LOADU(xs[1], wt + 384, nxu); }
        {
            unsigned char* kq = p.ws + WS_KQ + (size_t)((b * 16 + kh) * 64 + n) * 49152;
#pragma unroll
            for (int i = 0; i < 2; ++i) { const int cc = tid + 512 * i, t = cc >> 4, ch = cc & 15;
                const int dlo = 32 * (ch >> 2) + 16 * ((ch >> 1) & 1) + 4 * (ch & 1);
                const v2u ka = *(const LAS v2u*)(lds + CH_KB + t * CH_KQ_LD + dlo * 2), kb2 = *(const LAS v2u*)(lds + CH_KB + t * CH_KQ_LD + (dlo + 8) * 2);
                const v2u qa = *(const LAS v2u*)(lds + CH_QB + t * CH_KQ_LD + dlo * 2), qb2 = *(const LAS v2u*)(lds + CH_QB + t * CH_KQ_LD + (dlo + 8) * 2);
                { const v4u s_ = (v4u){ka.x, ka.y, kb2.x, kb2.y}; if constexpr (NOST) asm volatile("" :: "v"(s_)); else *(GAS v4u*)(kq + (size_t)t * 256 + ch * 16) = s_; }
                { const v4u s_ = (v4u){qa.x, qa.y, qb2.x, qb2.y}; if constexpr (NOST) asm volatile("" :: "v"(s_)); else *(GAS v4u*)(kq + 16384 + (size_t)t * 256 + ch * 16) = s_; } }
            if (tid < 256) {
#pragma unroll
                for (int q = 0; q < 4; ++q) { const int item = q * 256 + tid, d = item >> 3, ch = item & 7; const int tlo = 32 * (ch >> 2) + 16 * ((ch >> 1) & 1) + 4 * (ch & 1); unsigned short e[8];
#pragma unroll
                    for (int j = 0; j < 8; ++j) e[j] = *(const LAS unsigned short*)(lds + CH_KB + (tlo + 8 * (j >> 2) + (j & 3)) * CH_KQ_LD + d * 2);
                    { const v4u s_ = (v4u){(unsigned)e[0] | ((unsigned)e[1] << 16), (unsigned)e[2] | ((unsigned)e[3] << 16), (unsigned)e[4] | ((unsigned)e[5] << 16), (unsigned)e[6] | ((unsigned)e[7] << 16)}; if constexpr (NOST) asm volatile("" :: "v"(s_)); else *(GAS v4u*)(kq + 32768 + (size_t)d * 128 + ch * 16) = s_; } } }
            {
#pragma unroll
                for (int q = 0; q < 4; ++q) { const int item = q * 512 + tid, hh = item >> 10, v = (item >> 3) & 127, ch = item & 7; const int tlo = 32 * (ch >> 2) + 16 * ((ch >> 1) & 1) + 4 * (ch & 1); float e[8];
                    unsigned char* th = p.ws + WS_TH + (size_t)((b * 32 + 2 * kh + hh) * 64 + n) * 32768;
#pragma unroll
                    for (int j = 0; j < 8; ++j) { const int tj = tlo + 8 * (j >> 2) + (j & 3); e[j] = bf2f(*(const LAS unsigned short*)(lds + CH_VB + tj * CH_VB_LD + (hh * 128 + v) * 2)) * vec[hh * 64 + tj]; }
                    { const v4u s_ = pack8f(e); if constexpr (NOST) asm volatile("" :: "v"(s_)); else *(GAS v4u*)(th + 16384 + (size_t)v * 128 + ch * 16) = s_; } } }
            if (tid < 128) { const int hh = tid >> 6, t = tid & 63; float* vo = (float*)(p.ws + WS_VEC) + (size_t)((b * 32 + 2 * kh + hh) * 64 + n) * 256;
                const float beta = vec[hh * 64 + t], gc = vec[128 + hh * 64 + t], gl = vec[128 + hh * 64 + 63];
                vo[t] = __expf(gc); vo[64 + t] = beta * __expf(gc); vo[128 + t] = __expf(gl - gc); vo[192 + t] = __expf(gl); }
        }
        {
            f32x16 accK = zero16(), accQ = zero16();
            const int hh = wave >> 2, mt = (wave >> 1) & 1, nt = wave & 1, c = lane & 31, h = lane >> 5;
#pragma unroll
            for (int s8 = 0; s8 < 8; ++s8) {
                const bf16x8 bk = *(const LAS bf16x8*)(lds + CH_KB + (32 * nt + c) * CH_KQ_LD + (16 * s8 + 8 * h) * 2);
                const bf16x8 ak = *(const LAS bf16x8*)(lds + CH_KB + (32 * mt + c) * CH_KQ_LD + (16 * s8 + 8 * h) * 2);
                const bf16x8 aq = *(const LAS bf16x8*)(lds + CH_QB + (32 * mt + c) * CH_KQ_LD + (16 * s8 + 8 * h) * 2);
                accK = MFMA32(ak, bk, accK); accQ = MFMA32(aq, bk, accQ); }
            const int j = 32 * nt + c; const float gj = vec[128 + hh * 64 + j];
            bf16* qkg = (bf16*)(p.ws + WS_TH + (size_t)((b * 32 + 2 * kh + hh) * 64 + n) * 32768 + 8192);
            LAS float* Am = (LAS float*)(lds + CH_A) + hh * 64 * CH_A_LD;
#pragma unroll
            for (int r = 0; r < 16; ++r) { const int i = 32 * mt + crow(r, h);
                const float gi = vec[128 + hh * 64 + i], bi = vec[hh * 64 + i];
                const float dec = __expf(fminf(gi - gj, 0.f));
                Am[i * CH_A_LD + j] = (i > j) ? bi * accK[r] * dec : 0.f;
                qkg[i * 64 + pos64(j)] = f2bf16((i >= j) ? accQ[r] * dec : 0.f); }
        }
        __syncthreads();
        prev_unit = unit;
    }
    }
}

constexpr int SC_KP = 0, SC_QP = 17408, SC_KT = 34816, SC_T = 53248, SC_QK = 62464, SC_VBT = 71680, SC_VEC = 90112, SC_OST = 91136, SC_OST_LD = 272  , SC_OST_SZ = 64 * SC_OST_LD, SC_ON = SC_OST + 2 * SC_OST_SZ  , SC_PFD = SC_ON + 512  , SC_END = SC_PFD + 1024;
static_assert(SC_END <= MISC_OFF, "scan LDS");

#ifndef SCAN_DUP
#define SCAN_DUP 0
#endif
#undef CH_LOADU
#undef CH_LOADS
DI void gdn_scan_unit(const P& p, int unit, LAS unsigned char* lds, int tid, int wave, int lane) {
    asm volatile("" : "+v"(tid), "+v"(lane));
    const int h_ = unit & 31, b = unit >> 5, kh = h_ >> 1;
    const int c = lane & 31, h = lane >> 5;
    const bf16* PROJ = (const bf16*)(p.ws + WS_BIG);
    bf16* GO = (bf16*)(p.ws + WS_GO);
    const int lt = tid - 256;
    const int lb16 = (lt >> 4) * 272 + (lt & 15) * 16, lb8 = (lt >> 3) * 144 + (lt & 7) * 16;
    const unsigned lt16 = (unsigned)lt * 16u;
#define SCAN_FETCH(PF, PFV, nn) do { const int nn_ = (nn) < 63 ? (nn) : 63;     \
        const GAS unsigned char* kq_ = (const GAS unsigned char*)(p.ws + WS_KQ + (size_t)((b * 16 + kh) * 64 + nn_) * 49152);     \
        const GAS unsigned char* th_ = (const GAS unsigned char*)(p.ws + WS_TH + (size_t)((b * 32 + h_) * 64 + nn_) * 32768); \
        unsigned lo_ = lt16; asm volatile("" : "+v"(lo_)); \
        _Pragma("unroll") for (int i_ = 0; i_ < 12; ++i_) PF[i_] = *(const GAS v4u*)(kq_ + i_ * 4096 + lo_); \
        _Pragma("unroll") for (int i_ = 0; i_ < 8; ++i_) PF[12 + i_] = *(const GAS v4u*)(th_ + i_ * 4096 + lo_); \
        PFV = *(const GAS v4u*)((const GAS unsigned char*)(p.ws + WS_VEC + (size_t)((b * 32 + h_) * 64 + nn_) * 1024) + (lo_ & 1023u)); } while (0)
#define SCAN_PUT(PF, PFV) do { \
        _Pragma("unroll") for (int i_ = 0; i_ < 4; ++i_) { *(LAS v4u*)(lds + SC_KP + lb16 + i_ * 16 * 272) = PF[i_]; *(LAS v4u*)(lds + SC_QP + lb16 + i_ * 16 * 272) = PF[4 + i_]; \
            *(LAS v4u*)(lds + SC_KT + lb8 + i_ * 32 * 144) = PF[8 + i_]; *(LAS v4u*)(lds + SC_VBT + lb8 + i_ * 32 * 144) = PF[16 + i_]; } \
        _Pragma("unroll") for (int i_ = 0; i_ < 2; ++i_) { *(LAS v4u*)(lds + SC_T + lb8 + i_ * 32 * 144) = PF[12 + i_]; *(LAS v4u*)(lds + SC_QK + lb8 + i_ * 32 * 144) = PF[14 + i_]; } \
        if (lt < 64) *(LAS v4u*)(lds + SC_VEC + lt * 16) = PFV; } while (0)
    __syncthreads();
    const LAS float* vec = (const LAS float*)(lds + SC_VEC);
    gu32* prog = (gu32*)(p.ws + WS_CTL) + CW_PROG + 64 * unit;
    if (wave >= 4) {
        v4u pfA[20], pfB[20]; v4u pvA = (v4u){0u, 0u, 0u, 0u}, pvB = (v4u){0u, 0u, 0u, 0u};
        SCAN_FETCH(pfA, pvA, 0); SCAN_PUT(pfA, pvA);
        SCAN_FETCH(pfA, pvA, 1); SCAN_FETCH(pfB, pvB, 2);
        __syncthreads();
#pragma unroll 1
        for (int n = 0; n < 64; n += 2) {
            __syncthreads();
            if (lt == 0) __hip_atomic_store(prog, (unsigned)(n + 1), __ATOMIC_RELAXED, __HIP_MEMORY_SCOPE_AGENT);
            SCAN_PUT(pfA, pvA);
            __syncthreads();
            SCAN_FETCH(pfA, pvA, n + 3);
            __syncthreads();
            if (lt == 0) __hip_atomic_store(prog, (unsigned)(n + 2), __ATOMIC_RELAXED, __HIP_MEMORY_SCOPE_AGENT);
            if (n + 2 < 64) SCAN_PUT(pfB, pvB);
            __syncthreads();
            SCAN_FETCH(pfB, pvB, n + 4);
        }
        __syncthreads();
    } else {
        f32x16 S[4]; S[0] = zero16(); S[1] = zero16(); S[2] = zero16(); S[3] = zero16();
        __syncthreads();
#pragma unroll 1
        for (int n = 0; n < 64; ++n) {
            {
            const int w = wave;
#define SB() __builtin_amdgcn_sched_barrier(0)
#define FRAG(base, ld, row, col) (*(const LAS bf16x8*)(lds + (base) + (row) * (ld) + (col) * 2))
            bf16x8 fbuf[2][4];
            f32x16 ks0, ks1, vn0, vn1, qs0, qs1;
            bf16x8 tb[2][2], vb[2][2], vs[2][2];
#if (SCAN_DUP & 8)
            fbuf[0][0] = FRAG(SC_KP, 272, 0 + c, 0 + 8 * h);
            fbuf[0][1] = FRAG(SC_KP, 272, 0 + c, 16 + 8 * h);
            fbuf[0][2] = FRAG(SC_KP, 272, 0 + c, 32 + 8 * h);
            fbuf[0][3] = FRAG(SC_KP, 272, 0 + c, 48 + 8 * h);
            SB();
            fbuf[1][0] = FRAG(SC_KP, 272, 0 + c, 64 + 8 * h);
            fbuf[1][1] = FRAG(SC_KP, 272, 0 + c, 80 + 8 * h);
            fbuf[1][2] = FRAG(SC_KP, 272, 0 + c, 96 + 8 * h);
            fbuf[1][3] = FRAG(SC_KP, 272, 0 + c, 112 + 8 * h);
            SB();
            ks0 = MFMA32(fbuf[0][0], pack_acc<0>(S[0]), zero16());
            ks0 = MFMA32(fbuf[0][1], pack_acc<1>(S[0]), ks0);
            ks0 = MFMA32(fbuf[0][2], pack_acc<0>(S[1]), ks0);
            ks0 = MFMA32(fbuf[0][3], pack_acc<1>(S[1]), ks0);
            SB();
            fbuf[0][0] = FRAG(SC_KP, 272, 32 + c, 0 + 8 * h);
            fbuf[0][1] = FRAG(SC_KP, 272, 32 + c, 16 + 8 * h);
            fbuf[0][2] = FRAG(SC_KP, 272, 32 + c, 32 + 8 * h);
            fbuf[0][3] = FRAG(SC_KP, 272, 32 + c, 48 + 8 * h);
            SB();
            ks0 = MFMA32(fbuf[1][0], pack_acc<0>(S[2]), ks0);
            ks0 = MFMA32(fbuf[1][1], pack_acc<1>(S[2]), ks0);
            ks0 = MFMA32(fbuf[1][2], pack_acc<0>(S[3]), ks0);
            ks0 = MFMA32(fbuf[1][3], pack_acc<1>(S[3]), ks0);
            SB();
            fbuf[1][0] = FRAG(SC_KP, 272, 32 + c, 64 + 8 * h);
            fbuf[1][1] = FRAG(SC_KP, 272, 32 + c, 80 + 8 * h);
            fbuf[1][2] = FRAG(SC_KP, 272, 32 + c, 96 + 8 * h);
            fbuf[1][3] = FRAG(SC_KP, 272, 32 + c, 112 + 8 * h);
            SB();
            ks1 = MFMA32(fbuf[0][0], pack_acc<0>(S[0]), zero16());
            ks1 = MFMA32(fbuf[0][1], pack_acc<1>(S[0]), ks1);
            ks1 = MFMA32(fbuf[0][2], pack_acc<0>(S[1]), ks1);
            ks1 = MFMA32(fbuf[0][3], pack_acc<1>(S[1]), ks1);
            SB();
            fbuf[0][0] = FRAG(SC_T, 144, 0 + c, 0 + 8 * h);
            fbuf[0][1] = FRAG(SC_T, 144, 0 + c, 16 + 8 * h);
            fbuf[0][2] = FRAG(SC_VBT, 144, 32 * w + c, 0 + 8 * h);
            fbuf[0][3] = FRAG(SC_VBT, 144, 32 * w + c, 16 + 8 * h);
            SB();
            ks1 = MFMA32(fbuf[1][0], pack_acc<0>(S[2]), ks1);
            ks1 = MFMA32(fbuf[1][1], pack_acc<1>(S[2]), ks1);
            ks1 = MFMA32(fbuf[1][2], pack_acc<0>(S[3]), ks1);
            ks1 = MFMA32(fbuf[1][3], pack_acc<1>(S[3]), ks1);
            SB();
            fbuf[1][0] = FRAG(SC_T, 144, 32 + c, 0 + 8 * h);
            fbuf[1][1] = FRAG(SC_T, 144, 32 + c, 16 + 8 * h);
            fbuf[1][2] = FRAG(SC_VBT, 144, 32 * w + c, 0 + 8 * h);
            fbuf[1][3] = FRAG(SC_VBT, 144, 32 * w + c, 16 + 8 * h);
            SB();
            _Pragma("unroll") for (int q4 = 0; q4 < 4; ++q4) { const f32x4 g4 = *(const LAS f32x4*)(vec + 64 + 0 + 8 * q4 + 4 * h);
                ks0[4 * q4] *= -g4.x; ks0[4 * q4 + 1] *= -g4.y; ks0[4 * q4 + 2] *= -g4.z; ks0[4 * q4 + 3] *= -g4.w; }
            _Pragma("unroll") for (int q4 = 0; q4 < 4; ++q4) { const f32x4 g4 = *(const LAS f32x4*)(vec + 64 + 32 + 8 * q4 + 4 * h);
                ks1[4 * q4] *= -g4.x; ks1[4 * q4 + 1] *= -g4.y; ks1[4 * q4 + 2] *= -g4.z; ks1[4 * q4 + 3] *= -g4.w; }
            tb[0][0] = pack_acc<0>(ks0); tb[0][1] = pack_acc<1>(ks0); tb[1][0] = pack_acc<0>(ks1); tb[1][1] = pack_acc<1>(ks1);
            vn0 = MFMA32(fbuf[0][0], tb[0][0], zero16());
            vn0 = MFMA32(fbuf[0][0], fbuf[0][2], vn0);
            vn0 = MFMA32(fbuf[0][1], tb[0][1], vn0);
            vn0 = MFMA32(fbuf[0][1], fbuf[0][3], vn0);
            SB();
            fbuf[0][0] = FRAG(SC_T, 144, 32 + c, 32 + 8 * h);
            fbuf[0][1] = FRAG(SC_T, 144, 32 + c, 48 + 8 * h);
            fbuf[0][2] = FRAG(SC_VBT, 144, 32 * w + c, 32 + 8 * h);
            fbuf[0][3] = FRAG(SC_VBT, 144, 32 * w + c, 48 + 8 * h);
            SB();
            vn1 = MFMA32(fbuf[1][0], tb[0][0], zero16());
            vn1 = MFMA32(fbuf[1][0], fbuf[1][2], vn1);
            vn1 = MFMA32(fbuf[1][1], tb[0][1], vn1);
            vn1 = MFMA32(fbuf[1][1], fbuf[1][3], vn1);
            SB();
            fbuf[1][0] = FRAG(SC_QP, 272, 0 + c, 0 + 8 * h);
            fbuf[1][1] = FRAG(SC_QP, 272, 0 + c, 16 + 8 * h);
            fbuf[1][2] = FRAG(SC_QP, 272, 0 + c, 32 + 8 * h);
            fbuf[1][3] = FRAG(SC_QP, 272, 0 + c, 48 + 8 * h);
            SB();
            vn1 = MFMA32(fbuf[0][0], tb[1][0], vn1);
            vn1 = MFMA32(fbuf[0][0], fbuf[0][2], vn1);
            vn1 = MFMA32(fbuf[0][1], tb[1][1], vn1);
            vn1 = MFMA32(fbuf[0][1], fbuf[0][3], vn1);
            SB();
            fbuf[0][0] = FRAG(SC_QP, 272, 0 + c, 64 + 8 * h);
            fbuf[0][1] = FRAG(SC_QP, 272, 0 + c, 80 + 8 * h);
            fbuf[0][2] = FRAG(SC_QP, 272, 0 + c, 96 + 8 * h);
            fbuf[0][3] = FRAG(SC_QP, 272, 0 + c, 112 + 8 * h);
            SB();
            asm volatile("" : "+v"(S[0]), "+v"(S[1]), "+v"(S[2]), "+v"(S[3]));
            vb[0][0] = pack_acc<0>(vn0); vb[0][1] = pack_acc<1>(vn0); vb[1][0] = pack_acc<0>(vn1); vb[1][1] = pack_acc<1>(vn1);
            _Pragma("unroll") for (int q4 = 0; q4 < 4; ++q4) { const f32x4 g4 = *(const LAS f32x4*)(vec + 128 + 0 + 8 * q4 + 4 * h);
                vn0[4 * q4] *= g4.x; vn0[4 * q4 + 1] *= g4.y; vn0[4 * q4 + 2] *= g4.z; vn0[4 * q4 + 3] *= g4.w; }
            _Pragma("unroll") for (int q4 = 0; q4 < 4; ++q4) { const f32x4 g4 = *(const LAS f32x4*)(vec + 128 + 32 + 8 * q4 + 4 * h);
                vn1[4 * q4] *= g4.x; vn1[4 * q4 + 1] *= g4.y; vn1[4 * q4 + 2] *= g4.z; vn1[4 * q4 + 3] *= g4.w; }
            vs[0][0] = pack_acc<0>(vn0); vs[0][1] = pack_acc<1>(vn0); vs[1][0] = pack_acc<0>(vn1); vs[1][1] = pack_acc<1>(vn1);
            qs0 = MFMA32(fbuf[1][0], pack_acc<0>(S[0]), zero16());
            qs0 = MFMA32(fbuf[1][1], pack_acc<1>(S[0]), qs0);
            qs0 = MFMA32(fbuf[1][2], pack_acc<0>(S[1]), qs0);
            qs0 = MFMA32(fbuf[1][3], pack_acc<1>(S[1]), qs0);
            SB();
            fbuf[1][0] = FRAG(SC_QP, 272, 32 + c, 0 + 8 * h);
            fbuf[1][1] = FRAG(SC_QP, 272, 32 + c, 16 + 8 * h);
            fbuf[1][2] = FRAG(SC_QP, 272, 32 + c, 32 + 8 * h);
            fbuf[1][3] = FRAG(SC_QP, 272, 32 + c, 48 + 8 * h);
            SB();
            qs0 = MFMA32(fbuf[0][0], pack_acc<0>(S[2]), qs0);
            qs0 = MFMA32(fbuf[0][1], pack_acc<1>(S[2]), qs0);
            qs0 = MFMA32(fbuf[0][2], pack_acc<0>(S[3]), qs0);
            qs0 = MFMA32(fbuf[0][3], pack_acc<1>(S[3]), qs0);
            SB();
            fbuf[0][0] = FRAG(SC_QP, 272, 32 + c, 64 + 8 * h);
            fbuf[0][1] = FRAG(SC_QP, 272, 32 + c, 80 + 8 * h);
            fbuf[0][2] = FRAG(SC_QP, 272, 32 + c, 96 + 8 * h);
            fbuf[0][3] = FRAG(SC_QP, 272, 32 + c, 112 + 8 * h);
            SB();
            qs1 = MFMA32(fbuf[1][0], pack_acc<0>(S[0]), zero16());
            qs1 = MFMA32(fbuf[1][1], pack_acc<1>(S[0]), qs1);
            qs1 = MFMA32(fbuf[1][2], pack_acc<0>(S[1]), qs1);
            qs1 = MFMA32(fbuf[1][3], pack_acc<1>(S[1]), qs1);
            SB();
            fbuf[1][0] = FRAG(SC_QK, 144, 0 + c, 0 + 8 * h);
            fbuf[1][1] = FRAG(SC_QK, 144, 0 + c, 16 + 8 * h);
            fbuf[1][2] = FRAG(SC_QK, 144, 32 + c, 0 + 8 * h);
            fbuf[1][3] = FRAG(SC_QK, 144, 32 + c, 16 + 8 * h);
            SB();
            qs1 = MFMA32(fbuf[0][0], pack_acc<0>(S[2]), qs1);
            qs1 = MFMA32(fbuf[0][1], pack_acc<1>(S[2]), qs1);
            qs1 = MFMA32(fbuf[0][2], pack_acc<0>(S[3]), qs1);
            qs1 = MFMA32(fbuf[0][3], pack_acc<1>(S[3]), qs1);
            SB();
            fbuf[0][0] = FRAG(SC_QK, 144, 32 + c, 32 + 8 * h);
            fbuf[0][1] = FRAG(SC_QK, 144, 32 + c, 48 + 8 * h);
            SB();
            _Pragma("unroll") for (int q4 = 0; q4 < 4; ++q4) { const f32x4 g4 = *(const LAS f32x4*)(vec + 0 + 0 + 8 * q4 + 4 * h);
                qs0[4 * q4] *= g4.x; qs0[4 * q4 + 1] *= g4.y; qs0[4 * q4 + 2] *= g4.z; qs0[4 * q4 + 3] *= g4.w; }
            _Pragma("unroll") for (int q4 = 0; q4 < 4; ++q4) { const f32x4 g4 = *(const LAS f32x4*)(vec + 0 + 32 + 8 * q4 + 4 * h);
                qs1[4 * q4] *= g4.x; qs1[4 * q4 + 1] *= g4.y; qs1[4 * q4 + 2] *= g4.z; qs1[4 * q4 + 3] *= g4.w; }
            qs0 = MFMA32(fbuf[1][0], vb[0][0], qs0);
            qs0 = MFMA32(fbuf[1][1], vb[0][1], qs0);
            qs1 = MFMA32(fbuf[1][2], vb[0][0], qs1);
            qs1 = MFMA32(fbuf[1][3], vb[0][1], qs1);
            SB();
            qs1 = MFMA32(fbuf[0][0], vb[1][0], qs1);
            qs1 = MFMA32(fbuf[0][1], vb[1][1], qs1);
            SB();
#endif
            fbuf[0][0] = FRAG(SC_KP, 272, 0 + c, 0 + 8 * h);
            fbuf[0][1] = FRAG(SC_KP, 272, 0 + c, 16 + 8 * h);
            fbuf[0][2] = FRAG(SC_KP, 272, 0 + c, 32 + 8 * h);
            fbuf[0][3] = FRAG(SC_KP, 272, 0 + c, 48 + 8 * h);
            SB();
            fbuf[1][0] = FRAG(SC_KP, 272, 0 + c, 64 + 8 * h);
            fbuf[1][1] = FRAG(SC_KP, 272, 0 + c, 80 + 8 * h);
            fbuf[1][2] = FRAG(SC_KP, 272, 0 + c, 96 + 8 * h);
            fbuf[1][3] = FRAG(SC_KP, 272, 0 + c, 112 + 8 * h);
            SB();
            ks0 = MFMA32(fbuf[0][0], pack_acc<0>(S[0]), zero16());
            ks0 = MFMA32(fbuf[0][1], pack_acc<1>(S[0]), ks0);
            ks0 = MFMA32(fbuf[0][2], pack_acc<0>(S[1]), ks0);
            ks0 = MFMA32(fbuf[0][3], pack_acc<1>(S[1]), ks0);
            SB();
            fbuf[0][0] = FRAG(SC_KP, 272, 32 + c, 0 + 8 * h);
            fbuf[0][1] = FRAG(SC_KP, 272, 32 + c, 16 + 8 * h);
            fbuf[0][2] = FRAG(SC_KP, 272, 32 + c, 32 + 8 * h);
            fbuf[0][3] = FRAG(SC_KP, 272, 32 + c, 48 + 8 * h);
            SB();
            ks0 = MFMA32(fbuf[1][0], pack_acc<0>(S[2]), ks0);
            ks0 = MFMA32(fbuf[1][1], pack_acc<1>(S[2]), ks0);
            ks0 = MFMA32(fbuf[1][2], pack_acc<0>(S[3]), ks0);
            ks0 = MFMA32(fbuf[1][3], pack_acc<1>(S[3]), ks0);
            SB();
            fbuf[1][0] = FRAG(SC_KP, 272, 32 + c, 64 + 8 * h);
            fbuf[1][1] = FRAG(SC_KP, 272, 32 + c, 80 + 8 * h);
            fbuf[1][2] = FRAG(SC_KP, 272, 32 + c, 96 + 8 * h);
            fbuf[1][3] = FRAG(SC_KP, 272, 32 + c, 112 + 8 * h);
            SB();
            ks1 = MFMA32(fbuf[0][0], pack_acc<0>(S[0]), zero16());
            ks1 = MFMA32(fbuf[0][1], pack_acc<1>(S[0]), ks1);
            ks1 = MFMA32(fbuf[0][2], pack_acc<0>(S[1]), ks1);
            ks1 = MFMA32(fbuf[0][3], pack_acc<1>(S[1]), ks1);
            SB();
            fbuf[0][0] = FRAG(SC_T, 144, 0 + c, 0 + 8 * h);
            fbuf[0][1] = FRAG(SC_T, 144, 0 + c, 16 + 8 * h);
            fbuf[0][2] = FRAG(SC_VBT, 144, 32 * w + c, 0 + 8 * h);
            fbuf[0][3] = FRAG(SC_VBT, 144, 32 * w + c, 16 + 8 * h);
            SB();
            ks1 = MFMA32(fbuf[1][0], pack_acc<0>(S[2]), ks1);
            ks1 = MFMA32(fbuf[1][1], pack_acc<1>(S[2]), ks1);
            ks1 = MFMA32(fbuf[1][2], pack_acc<0>(S[3]), ks1);
            ks1 = MFMA32(fbuf[1][3], pack_acc<1>(S[3]), ks1);
            SB();
            fbuf[1][0] = FRAG(SC_T, 144, 32 + c, 0 + 8 * h);
            fbuf[1][1] = FRAG(SC_T, 144, 32 + c, 16 + 8 * h);
            fbuf[1][2] = FRAG(SC_VBT, 144, 32 * w + c, 0 + 8 * h);
            fbuf[1][3] = FRAG(SC_VBT, 144, 32 * w + c, 16 + 8 * h);
            SB();
            _Pragma("unroll") for (int q4 = 0; q4 < 4; ++q4) { const f32x4 g4 = *(const LAS f32x4*)(vec + 64 + 0 + 8 * q4 + 4 * h);
                ks0[4 * q4] *= -g4.x; ks0[4 * q4 + 1] *= -g4.y; ks0[4 * q4 + 2] *= -g4.z; ks0[4 * q4 + 3] *= -g4.w; }
            _Pragma("unroll") for (int q4 = 0; q4 < 4; ++q4) { const f32x4 g4 = *(const LAS f32x4*)(vec + 64 + 32 + 8 * q4 + 4 * h);
                ks1[4 * q4] *= -g4.x; ks1[4 * q4 + 1] *= -g4.y; ks1[4 * q4 + 2] *= -g4.z; ks1[4 * q4 + 3] *= -g4.w; }
            tb[0][0] = pack_acc<0>(ks0); tb[0][1] = pack_acc<1>(ks0); tb[1][0] = pack_acc<0>(ks1); tb[1][1] = pack_acc<1>(ks1);
            vn0 = MFMA32(fbuf[0][0], tb[0][0], zero16());
            vn0 = MFMA32(fbuf[0][0], fbuf[0][2], vn0);
            vn0 = MFMA32(fbuf[0][1], tb[0][1], vn0);
            vn0 = MFMA32(fbuf[0][1], fbuf[0][3], vn0);
            SB();
            fbuf[0][0] = FRAG(SC_T, 144, 32 + c, 32 + 8 * h);
            fbuf[0][1] = FRAG(SC_T, 144, 32 + c, 48 + 8 * h);
            fbuf[0][2] = FRAG(SC_VBT, 144, 32 * w + c, 32 + 8 * h);
            fbuf[0][3] = FRAG(SC_VBT, 144, 32 * w + c, 48 + 8 * h);
            SB();
            vn1 = MFMA32(fbuf[1][0], tb[0][0], zero16());
            vn1 = MFMA32(fbuf[1][0], fbuf[1][2], vn1);
            vn1 = MFMA32(fbuf[1][1], tb[0][1], vn1);
            vn1 = MFMA32(fbuf[1][1], fbuf[1][3], vn1);
            SB();
            fbuf[1][0] = FRAG(SC_QP, 272, 0 + c, 0 + 8 * h);
            fbuf[1][1] = FRAG(SC_QP, 272, 0 + c, 16 + 8 * h);
            fbuf[1][2] = FRAG(SC_QP, 272, 0 + c, 32 + 8 * h);
            fbuf[1][3] = FRAG(SC_QP, 272, 0 + c, 48 + 8 * h);
            SB();
            vn1 = MFMA32(fbuf[0][0], tb[1][0], vn1);
            vn1 = MFMA32(fbuf[0][0], fbuf[0][2], vn1);
            vn1 = MFMA32(fbuf[0][1], tb[1][1], vn1);
            vn1 = MFMA32(fbuf[0][1], fbuf[0][3], vn1);
            SB();
            fbuf[0][0] = FRAG(SC_QP, 272, 0 + c, 64 + 8 * h);
            fbuf[0][1] = FRAG(SC_QP, 272, 0 + c, 80 + 8 * h);
            fbuf[0][2] = FRAG(SC_QP, 272, 0 + c, 96 + 8 * h);
            fbuf[0][3] = FRAG(SC_QP, 272, 0 + c, 112 + 8 * h);
            SB();
            asm volatile("" : "+v"(S[0]), "+v"(S[1]), "+v"(S[2]), "+v"(S[3]));
            vb[0][0] = pack_acc<0>(vn0); vb[0][1] = pack_acc<1>(vn0); vb[1][0] = pack_acc<0>(vn1); vb[1][1] = pack_acc<1>(vn1);
            _Pragma("unroll") for (int q4 = 0; q4 < 4; ++q4) { const f32x4 g4 = *(const LAS f32x4*)(vec + 128 + 0 + 8 * q4 + 4 * h);
                vn0[4 * q4] *= g4.x; vn0[4 * q4 + 1] *= g4.y; vn0[4 * q4 + 2] *= g4.z; vn0[4 * q4 + 3] *= g4.w; }
            _Pragma("unroll") for (int q4 = 0; q4 < 4; ++q4) { const f32x4 g4 = *(const LAS f32x4*)(vec + 128 + 32 + 8 * q4 + 4 * h);
                vn1[4 * q4] *= g4.x; vn1[4 * q4 + 1] *= g4.y; vn1[4 * q4 + 2] *= g4.z; vn1[4 * q4 + 3] *= g4.w; }
            vs[0][0] = pack_acc<0>(vn0); vs[0][1] = pack_acc<1>(vn0); vs[1][0] = pack_acc<0>(vn1); vs[1][1] = pack_acc<1>(vn1);
            qs0 = MFMA32(fbuf[1][0], pack_acc<0>(S[0]), zero16());
            qs0 = MFMA32(fbuf[1][1], pack_acc<1>(S[0]), qs0);
            qs0 = MFMA32(fbuf[1][2], pack_acc<0>(S[1]), qs0);
            qs0 = MFMA32(fbuf[1][3], pack_acc<1>(S[1]), qs0);
            SB();
            fbuf[1][0] = FRAG(SC_QP, 272, 32 + c, 0 + 8 * h);
            fbuf[1][1] = FRAG(SC_QP, 272, 32 + c, 16 + 8 * h);
            fbuf[1][2] = FRAG(SC_QP, 272, 32 + c, 32 + 8 * h);
            fbuf[1][3] = FRAG(SC_QP, 272, 32 + c, 48 + 8 * h);
            SB();
            qs0 = MFMA32(fbuf[0][0], pack_acc<0>(S[2]), qs0);
            qs0 = MFMA32(fbuf[0][1], pack_acc<1>(S[2]), qs0);
            qs0 = MFMA32(fbuf[0][2], pack_acc<0>(S[3]), qs0);
            qs0 = MFMA32(fbuf[0][3], pack_acc<1>(S[3]), qs0);
            SB();
            fbuf[0][0] = FRAG(SC_QP, 272, 32 + c, 64 + 8 * h);
            fbuf[0][1] = FRAG(SC_QP, 272, 32 + c, 80 + 8 * h);
            fbuf[0][2] = FRAG(SC_QP, 272, 32 + c, 96 + 8 * h);
            fbuf[0][3] = FRAG(SC_QP, 272, 32 + c, 112 + 8 * h);
            SB();
            qs1 = MFMA32(fbuf[1][0], pack_acc<0>(S[0]), zero16());
            qs1 = MFMA32(fbuf[1][1], pack_acc<1>(S[0]), qs1);
            qs1 = MFMA32(fbuf[1][2], pack_acc<0>(S[1]), qs1);
            qs1 = MFMA32(fbuf[1][3], pack_acc<1>(S[1]), qs1);
            SB();
            fbuf[1][0] = FRAG(SC_QK, 144, 0 + c, 0 + 8 * h);
            fbuf[1][1] = FRAG(SC_QK, 144, 0 + c, 16 + 8 * h);
            fbuf[1][2] = FRAG(SC_QK, 144, 32 + c, 0 + 8 * h);
            fbuf[1][3] = FRAG(SC_QK, 144, 32 + c, 16 + 8 * h);
            SB();
            qs1 = MFMA32(fbuf[0][0], pack_acc<0>(S[2]), qs1);
            qs1 = MFMA32(fbuf[0][1], pack_acc<1>(S[2]), qs1);
            qs1 = MFMA32(fbuf[0][2], pack_acc<0>(S[3]), qs1);
            qs1 = MFMA32(fbuf[0][3], pack_acc<1>(S[3]), qs1);
            SB();
            fbuf[0][0] = FRAG(SC_QK, 144, 32 + c, 32 + 8 * h);
            fbuf[0][1] = FRAG(SC_QK, 144, 32 + c, 48 + 8 * h);
            SB();
            _Pragma("unroll") for (int q4 = 0; q4 < 4; ++q4) { const f32x4 g4 = *(const LAS f32x4*)(vec + 0 + 0 + 8 * q4 + 4 * h);
                qs0[4 * q4] *= g4.x; qs0[4 * q4 + 1] *= g4.y; qs0[4 * q4 + 2] *= g4.z; qs0[4 * q4 + 3] *= g4.w; }
            _Pragma("unroll") for (int q4 = 0; q4 < 4; ++q4) { const f32x4 g4 = *(const LAS f32x4*)(vec + 0 + 32 + 8 * q4 + 4 * h);
                qs1[4 * q4] *= g4.x; qs1[4 * q4 + 1] *= g4.y; qs1[4 * q4 + 2] *= g4.z; qs1[4 * q4 + 3] *= g4.w; }
            qs0 = MFMA32(fbuf[1][0], vb[0][0], qs0);
            qs0 = MFMA32(fbuf[1][1], vb[0][1], qs0);
            qs1 = MFMA32(fbuf[1][2], vb[0][0], qs1);
            qs1 = MFMA32(fbuf[1][3], vb[0][1], qs1);
            SB();
            fbuf[1][0] = FRAG(SC_KT, 144, 0 + c, 0 + 8 * h);
            fbuf[1][1] = FRAG(SC_KT, 144, 0 + c, 16 + 8 * h);
            fbuf[1][2] = FRAG(SC_KT, 144, 0 + c, 32 + 8 * h);
            fbuf[1][3] = FRAG(SC_KT, 144, 0 + c, 48 + 8 * h);
            SB();
            qs1 = MFMA32(fbuf[0][0], vb[1][0], qs1);
            qs1 = MFMA32(fbuf[0][1], vb[1][1], qs1);
            SB();
            fbuf[0][0] = FRAG(SC_KT, 144, 32 + c, 0 + 8 * h);
            fbuf[0][1] = FRAG(SC_KT, 144, 32 + c, 16 + 8 * h);
            fbuf[0][2] = FRAG(SC_KT, 144, 32 + c, 32 + 8 * h);
            fbuf[0][3] = FRAG(SC_KT, 144, 32 + c, 48 + 8 * h);
            SB();
            { const float dec = vec[192];
            _Pragma("unroll") for (int dt = 0; dt < 4; ++dt) _Pragma("unroll") for (int r = 0; r < 16; ++r) S[dt][r] *= dec; }
            S[0] = MFMA32(fbuf[1][0], vs[0][0], S[0]);
            S[0] = MFMA32(fbuf[1][1], vs[0][1], S[0]);
            S[0] = MFMA32(fbuf[1][2], vs[1][0], S[0]);
            S[0] = MFMA32(fbuf[1][3], vs[1][1], S[0]);
            SB();
            fbuf[1][0] = FRAG(SC_KT, 144, 64 + c, 0 + 8 * h);
            fbuf[1][1] = FRAG(SC_KT, 144, 64 + c, 16 + 8 * h);
            fbuf[1][2] = FRAG(SC_KT, 144, 64 + c, 32 + 8 * h);
            fbuf[1][3] = FRAG(SC_KT, 144, 64 + c, 48 + 8 * h);
            SB();
            S[1] = MFMA32(fbuf[0][0], vs[0][0], S[1]);
            S[1] = MFMA32(fbuf[0][1], vs[0][1], S[1]);
            S[1] = MFMA32(fbuf[0][2], vs[1][0], S[1]);
            S[1] = MFMA32(fbuf[0][3], vs[1][1], S[1]);
            SB();
            fbuf[0][0] = FRAG(SC_KT, 144, 96 + c, 0 + 8 * h);
            fbuf[0][1] = FRAG(SC_KT, 144, 96 + c, 16 + 8 * h);
            fbuf[0][2] = FRAG(SC_KT, 144, 96 + c, 32 + 8 * h);
            fbuf[0][3] = FRAG(SC_KT, 144, 96 + c, 48 + 8 * h);
            SB();
            S[2] = MFMA32(fbuf[1][0], vs[0][0], S[2]);
            S[2] = MFMA32(fbuf[1][1], vs[0][1], S[2]);
            S[2] = MFMA32(fbuf[1][2], vs[1][0], S[2]);
            S[2] = MFMA32(fbuf[1][3], vs[1][1], S[2]);
            SB();
            S[3] = MFMA32(fbuf[0][0], vs[0][0], S[3]);
            S[3] = MFMA32(fbuf[0][1], vs[0][1], S[3]);
            S[3] = MFMA32(fbuf[0][2], vs[1][0], S[3]);
            S[3] = MFMA32(fbuf[0][3], vs[1][1], S[3]);
            SB();
#pragma unroll
            for (int r = 0; r < 16; ++r) { *(LAS unsigned short*)(lds + SC_OST + crow(r, h) * SC_OST_LD + (32 * w + c) * 2) = f2bf16(qs0[r]);
                *(LAS unsigned short*)(lds + SC_OST + (32 + crow(r, h)) * SC_OST_LD + (32 * w + c) * 2) = f2bf16(qs1[r]); }
#undef SB
#undef FRAG
            }
            asm volatile("s_waitcnt vmcnt(0)" ::: "memory");
            __syncthreads();
            if (tid == 0 && n > 0) __hip_atomic_store(prog + 1, (unsigned)n, __ATOMIC_RELAXED, __HIP_MEMORY_SCOPE_AGENT);
            { GAS unsigned char* ob_ = (GAS unsigned char*)(GO + (size_t)(b * SEQ + n * 64) * GVAL + h_ * 128);
              unsigned to_ = (unsigned)tid; asm volatile("" : "+v"(to_));
#pragma unroll
              for (int i = 0; i < 4; ++i) { const unsigned id = to_ + 256u * i, row = id >> 4, ch = id & 15u;
                  const v4u v = *(const LAS v4u*)(lds + SC_OST + row * SC_OST_LD + ch * 16);
                  GAS unsigned char* ga = ob_ + (size_t)row * (GVAL * 2) + ch * 16;
                  asm volatile("global_store_dwordx4 %0, %1, off sc1\n\ts_nop 1" :: "v"(ga), "v"(v) : "memory"); } }
            __syncthreads();
        }
        asm volatile("s_waitcnt vmcnt(0)" ::: "memory");
        __syncthreads();
        if (tid == 0) __hip_atomic_store(prog + 1, 64u, __ATOMIC_RELAXED, __HIP_MEMORY_SCOPE_AGENT);
        { float* so = p.out + O_GDNP + (size_t)(b * 32 + h_) * 128 * 128;
#pragma unroll
          for (int dt = 0; dt < 4; ++dt)
#pragma unroll
              for (int r = 0; r < 16; ++r) so[(size_t)(32 * dt + crow(r, h)) * 128 + 32 * wave + c] = S[dt][r]; }
    }
#undef SCAN_FETCH
#undef SCAN_PUT
}

DI void gdn_sample_unit(const P& p, int unit, LAS unsigned char* lds, int tid, int wave, int lane) {
    asm volatile("" : "+v"(tid), "+v"(lane));
    const int h_ = unit & 31, b = unit >> 5, kh = h_ >> 1;
    const bf16* PROJ = (const bf16*)(p.ws + WS_BIG);
    const float* BA = (const float*)(p.ws + WS_BA);
    bf16* GO = (bf16*)(p.ws + WS_GO);
    LAS float* L = (LAS float*)lds;
    __syncthreads();
    if (tid < 384) { const int which = tid >> 7, i = tid & 127;
        const int pc = which == 0 ? kh * 128 + i : (which == 1 ? 2048 + kh * 128 + i : 4096 + h_ * 128 + i);
        float x[7];
#pragma unroll
        for (int j = 0; j < 3; ++j) x[j] = p.state_gconv[(size_t)(b * 3 + j) * 8192 + pc];
#pragma unroll
        for (int t = 0; t < 4; ++t) x[3 + t] = bf2f(PROJ[(size_t)(MPROMPT + 4 * b + t) * NGINP + pc]);
        const float w0 = p.gconv_w[pc], w1 = p.gconv_w[8192 + pc], w2 = p.gconv_w[2 * 8192 + pc], w3 = p.gconv_w[3 * 8192 + pc];
#pragma unroll
        for (int t = 0; t < 4; ++t) L[which * 512 + t * 128 + i] = silu_f(w0 * x[t] + w1 * x[t + 1] + w2 * x[t + 2] + w3 * x[t + 3]);
#pragma unroll
        for (int r = 0; r < 3; ++r) p.out[O_GCS + (size_t)(b * 3 + r) * 8192 + pc] = x[4 + r];
    } else if (tid < 388) { const int t = tid - 384; const size_t row = MPROMPT + 4 * b + t;
        const float bv = BA[row * 64 + h_], av = BA[row * 64 + 32 + h_];
        L[2560 + t] = sigmoid_f(bv); L[2564 + t] = __expf(-__expf(p.a_log[h_]) * softplus_f(av + p.dt_bias[h_])); }
    __syncthreads();
    { LAS float* r = L + (wave < 4 ? 0 : 512) + (wave & 3) * 128; const float a = r[lane], c2 = r[lane + 64];
      const float rs = rsqrtf(wave_sum(a * a + c2 * c2) + NORM_EPS) * (wave < 4 ? 0.08838834764831845f : 1.f);
      r[lane] = a * rs; r[lane + 64] = c2 * rs; }
    __syncthreads();
    const int v = tid & 127, dg = tid >> 7;
    float S[32];
    const float* s0 = p.state_gdn + ((size_t)(b * 32 + h_) * 128 + 32 * dg) * 128 + v;
#pragma unroll
    for (int i = 0; i < 32; ++i) S[i] = __builtin_nontemporal_load(s0 + (size_t)i * 128);
#pragma unroll 1
    for (int t = 0; t < 4; ++t) {
        const float eg = L[2564 + t], beta = L[2560 + t];
        const LAS float* kk = L + 512 + t * 128 + 32 * dg; const LAS float* qq = L + t * 128 + 32 * dg;
        float part = 0.f;
#pragma unroll
        for (int i = 0; i < 32; ++i) { S[i] *= eg; part += S[i] * kk[i]; }
        L[1536 + dg * 128 + v] = part;
        __syncthreads();
        const float kv = (L[1536 + v] + L[1536 + 128 + v]) + (L[1536 + 256 + v] + L[1536 + 384 + v]);
        const float vnew = beta * (L[1024 + t * 128 + v] - kv);
        __syncthreads();
        float part2 = 0.f;
#pragma unroll
        for (int i = 0; i < 32; ++i) { S[i] += kk[i] * vnew; part2 += S[i] * qq[i]; }
        L[1536 + dg * 128 + v] = part2;
        __syncthreads();
        if (dg == 0) L[2048 + t * 128 + v] = (L[1536 + v] + L[1536 + 128 + v]) + (L[1536 + 256 + v] + L[1536 + 384 + v]);
        __syncthreads();
    }
    float* so = p.out + O_GDNS + ((size_t)(b * 32 + h_) * 128 + 32 * dg) * 128 + v;
#pragma unroll
    for (int i = 0; i < 32; ++i) __builtin_nontemporal_store(S[i], so + (size_t)i * 128);
    if (wave < 4) { const int t = wave; const size_t row = MPROMPT + 4 * b + t;
        const float o1 = L[2048 + t * 128 + lane], o2 = L[2048 + t * 128 + lane + 64];
        const float rs = rsqrtf(wave_sum(o1 * o1 + o2 * o2) * (1.f / 128.f) + NORM_EPS);
        const float z1 = bf2f(PROJ[row * NGINP + 8192 + h_ * 128 + lane]), z2 = bf2f(PROJ[row * NGINP + 8192 + h_ * 128 + lane + 64]);
        GO[row * GVAL + h_ * 128 + lane] = f2bf16(o1 * rs * p.out_norm[lane] * silu_f(z1));
        GO[row * GVAL + h_ * 128 + lane + 64] = f2bf16(o2 * rs * p.out_norm[lane + 64] * silu_f(z2)); }
}

DI void gdn_gate_phase(const P& p, int tid) {
    const bf16* PROJ = (const bf16*)(p.ws + WS_BIG);
    bf16* GO = (bf16*)(p.ws + WS_GO);
    const int NT = gridDim.x * 512;
    float gn[32];
#pragma unroll
    for (int i = 0; i < 32; ++i) gn[i] = p.out_norm[(tid & 3) * 32 + i];
    for (int t = blockIdx.x * 512 + tid; t < MPROMPT * 128; t += NT) {
        const int part = t & 3, hd = (t >> 2) & 31, row = t >> 7;
        bf16* gp = GO + (size_t)row * GVAL + hd * 128 + part * 32;
        const bf16* zp = PROJ + (size_t)row * NGINP + 8192 + hd * 128 + part * 32;
        v4u ow[4], zw[4];
#pragma unroll
        for (int i = 0; i < 4; ++i) { ow[i] = *(const GAS v4u*)(gp + 8 * i); zw[i] = *(const GAS v4u*)(zp + 8 * i); }
        float x[32]; float ss = 0.f;
#pragma unroll
        for (int i = 0; i < 4; ++i) { float u[8]; unpack8(ow[i], u);
#pragma unroll
            for (int e = 0; e < 8; ++e) { x[8 * i + e] = u[e]; ss += u[e] * u[e]; } }
        ss += __shfl_xor(ss, 1); ss += __shfl_xor(ss, 2);
        const float rs = rsqrtf(ss * (1.f / 128.f) + NORM_EPS);
#pragma unroll
        for (int i = 0; i < 4; ++i) { float z[8], y[8]; unpack8(zw[i], z);
#pragma unroll
            for (int e = 0; e < 8; ++e) y[e] = x[8 * i + e] * rs * gn[8 * i + e] * z[e] * __builtin_amdgcn_rcpf(1.f + __expf(-z[e]));
            *(GAS v4u*)(gp + 8 * i) = pack8f(y); }
    }
}

struct PrefetchCursor { int next; unsigned pad; };
constexpr int PF_PAD_OFF = 143360;
DI void scan_prefetch_tick(const P& p, int u, int j, PrefetchCursor& pc, int tid) {
    if (pc.next >= 64) return;
    const gu32* prog = (const gu32*)(p.ws + WS_CTL) + CW_PROG + 64 * u;
    const int done = __builtin_amdgcn_readfirstlane((int)__hip_atomic_load(prog, __ATOMIC_RELAXED, __HIP_MEMORY_SCOPE_AGENT));
    if (pc.next < done + 2) pc.next = done + 2;
    const int h_ = u & 31, b = u >> 5, kh = h_ >> 1;
    int tq = tid; asm volatile("" : "+v"(tq));
#pragma unroll 1
    while (pc.next < 64 && pc.next <= done + 6) {
        const int n = pc.next;
        const int l = tq < 216 ? 3 * tq + j : j;
        const unsigned char* g = l < 384 ? p.ws + WS_KQ + (size_t)((b * 16 + kh) * 64 + n) * 49152 + l * 128
                               : (l < 640 ? p.ws + WS_TH + (size_t)((b * 32 + h_) * 64 + n) * 32768 + (l - 384) * 128
                                          : p.ws + WS_VEC + (size_t)((b * 32 + h_) * 64 + n) * 1024 + (l - 640) * 128);
        unsigned keep; asm volatile("s_mov_b32 %0, m0\n\ts_mov_b32 m0, %2\n\ts_nop 0\n\tglobal_load_lds_dword %1, off\n\ts_mov_b32 m0, %0" : "=&s"(keep) : "v"(g), "s"(pc.pad) : "memory");
        pc.next = n + 1;
    }
}

DI void scan_gate_chunk(const P& p, int u, int m, int tid) {
    const int h_ = u & 31, b = u >> 5;
    const bf16* PROJ = (const bf16*)(p.ws + WS_BIG);
    bf16* GO = (bf16*)(p.ws + WS_GO);
    if (tid < 256) { const int t = tid >> 2, part = tid & 3; const int row = b * SEQ + m * 64 + t;
        bf16* gp = GO + (size_t)row * GVAL + h_ * 128 + part * 32;
        const bf16* zp = PROJ + (size_t)row * NGINP + 8192 + h_ * 128 + part * 32;
        v4u ow[4], zw[4];
#pragma unroll
        for (int i = 0; i < 4; ++i) { ow[i] = *(const GAS v4u*)(gp + 8 * i); zw[i] = *(const GAS v4u*)(zp + 8 * i); }
        float x[32]; float ss = 0.f;
#pragma unroll
        for (int i = 0; i < 4; ++i) { float uu[8]; unpack8(ow[i], uu);
#pragma unroll
            for (int e = 0; e < 8; ++e) { x[8 * i + e] = uu[e]; ss += uu[e] * uu[e]; } }
        ss += __shfl_xor(ss, 1); ss += __shfl_xor(ss, 2);
        const float rs = rsqrtf(ss * (1.f / 128.f) + NORM_EPS);
#pragma unroll
        for (int i = 0; i < 4; ++i) { float z[8], y[8]; unpack8(zw[i], z);
#pragma unroll
            for (int e = 0; e < 8; ++e) y[e] = x[8 * i + e] * rs * p.out_norm[part * 32 + 8 * i + e] * z[e] * __builtin_amdgcn_rcpf(1.f + __expf(-z[e]));
            *(GAS v4u*)(gp + 8 * i) = pack8f(y); } }
}
DI void scan_gate_tick(const P& p, int u, int j, int& gnext, int tid) {
    if (gnext >= 64) return;
    const gu32* prog = (const gu32*)(p.ws + WS_CTL) + CW_PROG + 64 * u + 1;
    const int gdone = __builtin_amdgcn_readfirstlane((int)__hip_atomic_load(prog, __ATOMIC_RELAXED, __HIP_MEMORY_SCOPE_AGENT));
    if (gnext >= gdone) return;
    __builtin_amdgcn_fence(__ATOMIC_ACQUIRE, "agent");
    asm volatile("s_waitcnt vmcnt(0)" ::: "memory");
#pragma unroll 1
    while (gnext < gdone) { scan_gate_chunk(p, u, gnext, tid); gnext += 3; }
}

constexpr int SG_LD = 144;
constexpr int SG_A = 0, SG_B = 2 * 128 * SG_LD, SG_END = SG_B + 2 * 64 * SG_LD;
template <class Epi>
DI void small_gemm_tile(LAS unsigned char* lds, const bf16* A, int lda, int row0, const bf16* Bt, int K, int col0, int kbeg, int nk, const Epi& E, int tid, int wave, int lane) {
    const int c = lane & 31, h = lane >> 5, wm = wave >> 1, wn = wave & 1;
    const int ar0 = tid >> 3, part = tid & 7;
    const bf16* ga0 = A + (size_t)(row0 + ar0) * lda + kbeg + part * 8;
    const bf16* ga1 = ga0 + (size_t)64 * lda;
    const bf16* gb = Bt + (size_t)(col0 + ar0) * K + kbeg + part * 8;
    v4u ra0[4], ra1[4], rb[4];
#pragma unroll
    for (int j = 0; j < 4; ++j) { ra0[j] = *(const GAS v4u*)(ga0 + (size_t)j * 64); ra1[j] = *(const GAS v4u*)(ga1 + (size_t)j * 64); rb[j] = *(const GAS v4u*)(gb + (size_t)j * 64); }
    __syncthreads();
    *(LAS v4u*)(lds + SG_A + ar0 * SG_LD + part * 16) = ra0[0]; *(LAS v4u*)(lds + SG_A + (ar0 + 64) * SG_LD + part * 16) = ra1[0]; *(LAS v4u*)(lds + SG_B + ar0 * SG_LD + part * 16) = rb[0];
    __syncthreads();
    f32x16 acc = zero16();
#pragma unroll 1
    for (int ks0 = 0; ks0 < nk; ks0 += 4) {
#pragma unroll
        for (int j = 0; j < 4; ++j) {
            const int ks = ks0 + j, cur = j & 1, nx = cur ^ 1, jn = (j + 1) & 3;
            if (ks + 4 < nk) { ra0[j] = *(const GAS v4u*)(ga0 + (size_t)(ks + 4) * 64); ra1[j] = *(const GAS v4u*)(ga1 + (size_t)(ks + 4) * 64); rb[j] = *(const GAS v4u*)(gb + (size_t)(ks + 4) * 64); }
            const LAS unsigned char* ap = lds + SG_A + cur * 128 * SG_LD + (32 * wm + c) * SG_LD + 16 * h;
            const LAS unsigned char* bp = lds + SG_B + cur * 64 * SG_LD + (32 * wn + c) * SG_LD + 16 * h;
#pragma unroll
            for (int s = 0; s < 4; ++s) { const bf16x8 a = *(const LAS bf16x8*)(ap + 32 * s), b = *(const LAS bf16x8*)(bp + 32 * s); acc = MFMA32(a, b, acc); }
            if (ks + 1 < nk) {
                *(LAS v4u*)(lds + SG_A + nx * 128 * SG_LD + ar0 * SG_LD + part * 16) = ra0[jn]; *(LAS v4u*)(lds + SG_A + nx * 128 * SG_LD + (ar0 + 64) * SG_LD + part * 16) = ra1[jn];
                *(LAS v4u*)(lds + SG_B + nx * 64 * SG_LD + ar0 * SG_LD + part * 16) = rb[jn]; }
            __syncthreads();
        }
    }
#pragma unroll
    for (int r = 0; r < 16; ++r) E(row0 + 32 * wm + crow(r, h), col0 + 32 * wn + c, acc[r]);
}
struct SEpiBf16 { bf16* O; int ldc; DI void operator()(int row, int col, float v) const { O[(size_t)row * ldc + col] = f2bf16(v); } };
struct SEpiUpSample { bf16* U; DI void operator()(int row, int col, float v) const { const int t = col >> 8, r = col & 255; U[(size_t)row * NUP + (r < 128 ? 128 * t + r : DFF + 128 * t + (r - 128))] = f2bf16(v); } };
struct SEpiF32 { float* O; int ldc; int col_off; DI void operator()(int row, int col, float v) const { O[(size_t)row * ldc + col - col_off] = v; } };
struct SEpiF32N { float* O; int ldc; int col_off; const float* ssq; const float* cv; int ldcv; DI void operator()(int row, int col, float v) const {
    if (row < MPROMPT) v = v * rsqrtf(ssq[row] * (1.f / DM) + NORM_EPS) + cv[(size_t)(row >> 12) * ldcv + col];
    O[(size_t)row * ldc + col - col_off] = v; } };
struct SEpiResid { const float* xin_s; float* xout_s; const float* gate; DI void operator()(int row, int col, float v) const { const int rs = row - MPROMPT;
    xout_s[(size_t)rs * DM + col] = xin_s[(size_t)rs * DM + col] + gate[(size_t)(2 + (rs >> 2)) * MODW + col] * v; } };
struct SEpiResidAdd { float* xs; const float* gate; DI void operator()(int row, int col, float v) const { const int rs = row - MPROMPT;
    atomicAdd(xs + (size_t)rs * DM + col, gate[(size_t)(2 + (rs >> 2)) * MODW + col] * v); } };
template <class Epi>
DI void small_gemm_phase(LAS unsigned char* lds, const bf16* A, int lda, int rowbase, int nrb, const bf16* Bt, int K, int colbase, int ncb, const Epi& E, int tid, int wave, int lane, int ksplit = 1, int rot = 0) {
    const int G = gridDim.x, first = (2 * G - 1 - (int)blockIdx.x - rot % G) % G, nt = nrb * ncb * ksplit, nks = (K >> 6) / ksplit;
    for (int i = first; i < nt; i += G) { const int ks = i % ksplit, t = i / ksplit, rb = t / ncb, cb = t - rb * ncb;
        small_gemm_tile(lds, A, lda, rowbase + 128 * rb, Bt, K, colbase + 64 * cb, ks * nks * 64, nks, E, tid, wave, lane); }
}

#ifndef MK_N_LAUNCHES
#define MK_N_LAUNCHES 1
#endif
constexpr int N_PHASES = 19;
#ifndef PROBE_MASK
#define PROBE_MASK 0u
#endif
#define REPS(k) (((PROBE_MASK >> (k)) & 1u) ? 2 : 1)
#ifndef CHUNK_STAGGER
#define CHUNK_STAGGER 0
#endif
#ifndef CHUNK_NOST
#define CHUNK_NOST 0
#endif
#ifndef STAGGER_BATCHES
#define STAGGER_BATCHES 2
#endif
struct Args { const float* in[29]; float* out; unsigned char* ws; int ph_lo, ph_hi, one, pad; };
static_assert(sizeof(Args) == 31 * 8 + 16, "Args has no padding");

__global__ void __launch_bounds__(512, 2) hybrid_fwd(Args args) {
    extern __shared__ __attribute__((aligned(16))) unsigned char lds_raw[];
    LAS unsigned char* lds = (LAS unsigned char*)lds_raw;
    volatile LAS unsigned* MISC = (volatile LAS unsigned*)(lds + MISC_OFF);
    const int tid0 = threadIdx.x;
    const int G = gridDim.x;
#define PHASE_IDS int tid = tid0; asm volatile("" : "+v"(tid)); const int lane = tid & 63, wave = __builtin_amdgcn_readfirstlane(tid >> 6); (void)lane; (void)wave;
    P p;     p.x_prompt = args.in[0]; p.x_sample = args.in[1]; p.c_prompt = args.in[2]; p.c_sample = args.in[3]; p.cache_k = args.in[4]; p.cache_v = args.in[5];     p.state_gdn = args.in[6]; p.state_gconv = args.in[7]; p.state_fconv = args.in[8]; p.rel_table = args.in[9]; p.w_ada = args.in[10]; p.b_ada = args.in[11];     p.norm_mix = args.in[12]; p.norm_ffn = args.in[13]; p.w_qkv = args.in[14]; p.q_norm = args.in[15]; p.k_norm = args.in[16]; p.sinks = args.in[17]; p.w_o = args.in[18];     p.w_gin = args.in[19]; p.gconv_w = args.in[20]; p.a_log = args.in[21]; p.dt_bias = args.in[22]; p.out_norm = args.in[23]; p.w_gout = args.in[24];     p.w_up = args.in[25]; p.fconv_w = args.in[26]; p.fconv_b = args.in[27]; p.w_dn = args.in[28];     p.out = args.out; p.ws = args.ws;
    unsigned char* ws = args.ws;
    for (int u = tid0; u < (LDS_BYTES - MISC_OFF) / 4; u += 512) ((LAS unsigned*)(lds + MISC_OFF))[u] = 0u;
    __syncthreads();
    XcdBarrier bar; bar.bar = (unsigned*)(ws + WS_CTL) + CW_BAR; bar.x = 0; bar.st = nullptr;
    if (MK_N_LAUNCHES == 1) bar = xcd_barrier_post((unsigned*)(ws + WS_CTL) + CW_BAR, MISC + 8);
    const int lo = args.ph_lo, hi = args.ph_hi;
    const int hot1 = args.one;
#ifndef ONLY_MASK
#define ONLY_MASK 0x7FFFFu
#endif
#define IN(k) (((ONLY_MASK >> (k)) & 1u) && lo <= (k) && (k) < hi)
#ifndef BARRIER_DUP
#define BARRIER_DUP 1
#endif
#define SEAM(k) do { if (IN(k) && IN((k) + 1)) { _Pragma("unroll") for (int bd_ = 0; bd_ < BARRIER_DUP; ++bd_) xcd_barrier(bar); } } while (0)
    float* XR = args.out + O_Y;
    const float* mod = (const float*)(ws + WS_MOD);
    bf16* H = (bf16*)(ws + WS_H);
    float* SSQ = (float*)(ws + WS_CTL) + CW_SSQ; const float* CV = (const float*)(ws + WS_CTL) + CW_CV;

    if (IN(0)) _Pragma("unroll") for (int rep = 0; rep < REPS(0); ++rep) { PHASE_IDS p0_phase(p, lds, MISC, tid, wave, lane, rep); } SEAM(0);
    if (IN(1)) _Pragma("unroll") for (int rep = 0; rep < REPS(1); ++rep) { PHASE_IDS norm_phase(p.x_prompt, p.x_sample, p.norm_mix, mod, 0, H, tid, wave, lane, XR + (size_t)MPROMPT * DM); } SEAM(1);
    if (IN(2)) _Pragma("unroll") for (int rep = 0; rep < REPS(2); ++rep) { PHASE_IDS pg8::Gemm g{H, (const bf16*)(ws + WS_WQKV), MPROMPT, NQKV, DM}; pg8::StaticOrder S; S.init(MPROMPT, NQKV, G, (int)blockIdx.x);
        pg8::EpiStore E{(bf16*)(ws + WS_QKV), NQKV, nullptr, -1};
        pg8::gemm_phase<pg8::EpiStore, pg8::StaticOrder, true, true>(lds, g, S, E);
        small_gemm_phase(lds, H, DM, MPROMPT, 1, (const bf16*)(ws + WS_WQKV), DM, 0, NQKV / 64, SEpiBf16{(bf16*)(ws + WS_QKV), NQKV}, tid, wave, lane);
        convert_queue(p, 2 * 1 + rep, IT_UP0, IT_DN0, lds, MISC, tid, wave, lane); } SEAM(2);
    if (IN(3)) _Pragma("unroll") for (int rep = 0; rep < REPS(3); ++rep) { PHASE_IDS attn_phase(p, lds, tid, wave, lane); } SEAM(3);
    if (IN(4)) _Pragma("unroll") for (int rep = 0; rep < REPS(4); ++rep) { PHASE_IDS pg8::Gemm g{(const bf16*)(ws + WS_AO), (const bf16*)(ws + WS_WO), MPROMPT, DM, DM}; pg8::StaticOrder S; S.init(MPROMPT, DM, G, (int)blockIdx.x);
        pg8::EpiResidN E{p.x_prompt, XR, mod + 2 * DM, H, p.norm_ffn, mod + 3 * DM, SSQ};
        pg8::gemm_phase<pg8::EpiResidN, pg8::StaticOrder, true, true>(lds, g, S, E);
        small_gemm_phase(lds, (const bf16*)(ws + WS_AO), DM, MPROMPT, 1, (const bf16*)(ws + WS_WO), DM, 0, DM / 64, SEpiResidAdd{XR + (size_t)MPROMPT * DM, mod + 2 * DM}, tid, wave, lane, 8);
        convert_queue(p, 2 * 2 + rep, IT_DN0, IT_GIN, lds, MISC, tid, wave, lane); } SEAM(4);
    if (IN(6)) _Pragma("unroll") for (int rep = 0; rep < REPS(6); ++rep) { PHASE_IDS sample_prenorm(p, 0, XR, p.norm_ffn, mod, 3, H, tid, wave, lane);
        pg8::Gemm g{H, (const bf16*)(ws + WS_WUP0), MPROMPT, NUP, DM}; pg8::StaticOrder S; S.init(MPROMPT, NUP, G, (int)blockIdx.x);
        pg8::EpiAct E{(bf16*)(ws + WS_ACT), (bf16*)(ws + WS_BIG), p.fconv_w + (size_t)0 * 3 * NUP, p.fconv_b + (size_t)0 * NUP, lds};
        pg8::PrefOrder PS{S, lds, SSQ, CV + CV_UP0, NUP, p.fconv_w + (size_t)0 * 3 * NUP, p.fconv_b + (size_t)0 * NUP};
        if ((int)blockIdx.x >= (MPROMPT / 256) * (NUP / 256) % G) { convert_queue(p, 2 * 3 + rep, IT_GIN, IT_GIN_MID, lds, MISC, tid, wave, lane, STAGGER_BATCHES); __syncthreads(); }
        pg8::gemm_phase<pg8::EpiAct, pg8::PrefOrder, true, true>(lds, g, PS, E);
        sample_prenorm_wait(p, 0, tid);
        small_gemm_phase(lds, H, DM, MPROMPT, 1, (const bf16*)(ws + WS_WUP0), DM, 0, NUP / 64, SEpiUpSample{(bf16*)(ws + WS_BIG)}, tid, wave, lane);
        convert_queue(p, 2 * 3 + rep, IT_GIN, IT_GIN_MID, lds, MISC, tid, wave, lane); } SEAM(6);
    if (IN(7)) _Pragma("unroll") for (int rep = 0; rep < REPS(7); ++rep) { PHASE_IDS ffn_act_phase(p, 0, tid); } SEAM(7);
    if (IN(8)) _Pragma("unroll") for (int rep = 0; rep < REPS(8); ++rep) { PHASE_IDS pg8::Gemm g{(const bf16*)(ws + WS_ACT), (const bf16*)(ws + WS_WDN0), MPROMPT, DM, DFF}; pg8::StaticOrder S; S.init(MPROMPT, DM, G, (int)blockIdx.x);
        pg8::EpiResidN E{XR, XR, mod + 5 * DM, H, p.norm_mix + DM, mod + (size_t)NMODROW * MODW, SSQ + 8192};
        pg8::gemm_phase<pg8::EpiResidN, pg8::StaticOrder, true, true>(lds, g, S, E);
        small_gemm_phase(lds, (const bf16*)(ws + WS_ACT), DFF, MPROMPT, 1, (const bf16*)(ws + WS_WDN0), DFF, 0, DM / 64, SEpiResidAdd{XR + (size_t)MPROMPT * DM, mod + 5 * DM}, tid, wave, lane, 11);
        convert_queue(p, 2 * 4 + rep, IT_GIN_MID, IT_GOUT, lds, MISC, tid, wave, lane); } SEAM(8);
    const float* mod1 = mod + (size_t)NMODROW * MODW;
    if (IN(10)) _Pragma("unroll") for (int rep = 0; rep < REPS(10); ++rep) { PHASE_IDS sample_prenorm(p, 1, XR, p.norm_mix + DM, mod1, 0, H, tid, wave, lane);
        pg8::Gemm g{H, (const bf16*)(ws + WS_WGIN), MPROMPT, 12288, DM}; pg8::StaticOrder S; S.init(MPROMPT, 12288, G, (int)blockIdx.x);
        pg8::EpiStoreN E{(bf16*)(ws + WS_BIG), NGINP, nullptr, -1, lds};
        pg8::PrefOrder PS{S, lds, SSQ + 8192, CV + CV_GIN, NGIN, nullptr, nullptr};
        const bool early = (((int)blockIdx.x >> 3) & 1) != 0;
#define P10_SMALL { sample_prenorm_wait(p, 1, tid); \
            small_gemm_phase(lds, H, DM, MPROMPT, 1, (const bf16*)(ws + WS_WGIN), DM, 0, 12288 / 64, SEpiBf16{(bf16*)(ws + WS_BIG), NGINP}, tid, wave, lane);            \
            small_gemm_phase(lds, H, DM, 0, MTOK / 128, (const bf16*)(ws + WS_WGIN), DM, 12288, 1, SEpiF32N{(float*)(ws + WS_BA), 64, 12288, SSQ + 8192, CV + CV_GIN, NGIN}, tid, wave, lane, 1, 12288 / 64);     \
            __syncthreads(); }
        if (early) P10_SMALL
        pg8::gemm_phase<pg8::EpiStoreN, pg8::PrefOrder, true, true>(lds, g, PS, E);
        if (!early) P10_SMALL
#undef P10_SMALL
        } SEAM(10);
    if (IN(11)) _Pragma("unroll") for (int rep = 0; rep < REPS(11); ++rep) { PHASE_IDS
        if (CHUNK_STAGGER > 0) { const int grp = ((int)blockIdx.x >> 3) & 7; _Pragma("unroll 1") for (int zz = 0; zz < CHUNK_STAGGER * grp; ++zz) __builtin_amdgcn_s_sleep(32); }
        if (REPS(11) == 2 && rep == 0 && CHUNK_NOST) gdn_chunk_phase<true>(p, lds, tid, wave, lane); else gdn_chunk_phase<false>(p, lds, tid, wave, lane); __syncthreads(); } SEAM(11);
    if (IN(12)) _Pragma("unroll") for (int rep = 0; rep < REPS(12); ++rep) { PHASE_IDS
        for (int u = blockIdx.x; u < 64; u += G) _Pragma("unroll 1") for (int z_ = 0; z_ < hot1; ++z_) gdn_scan_unit(p, u, lds, tid, wave, lane);
        if (G <= 64 || (int)blockIdx.x >= 64) { const int st0 = G > 64 ? (int)blockIdx.x - 64 : (int)blockIdx.x, str = G > 64 ? G - 64 : G;
            const bool helper = (G == 256);
            const int hu = st0 & 63, hj = st0 >> 6;
            PrefetchCursor pc; pc.next = helper ? 2 : 64; pc.pad = (unsigned)__builtin_amdgcn_readfirstlane((int)(unsigned)(uintptr_t)(lds + (wave & 3) * 16384 + 12288 + (wave >> 2) * 256));
            int gnext = helper ? hj : 64;
            for (int u = st0; u < 1024; u += str) { scan_prefetch_tick(p, hu, hj, pc, tid); scan_gate_tick(p, hu, hj, gnext, tid); gdn_sample_unit(p, u, lds, tid, wave, lane); }
            {
                gu32* q = (gu32*)(p.ws + WS_CTL) + CW_QUEUE + 64 * (2 * 5 + rep);
                LAS float* scr = (LAS float*)(lds + wave * 16384);
                __syncthreads();
                for (;;) {
                    scan_prefetch_tick(p, hu, hj, pc, tid); scan_gate_tick(p, hu, hj, gnext, tid);
                    if (tid == 0) MISC[0] = __hip_atomic_fetch_add(q, 32u, __ATOMIC_RELAXED, __HIP_MEMORY_SCOPE_AGENT);
                    __syncthreads();
                    const int base = IT_GOUT + (int)MISC[0];
                    __syncthreads();
                    if (base >= IT_DN1) break;
                    const int kind = gv_kind(base);
                    if (kind < 0) {
#pragma unroll 1
                        for (int i = 0; i < 4; ++i) { const int it = base + wave * 4 + i; if (it < IT_DN1) p0_item(p, it, scr, lane); }
                    } else { float ca[8] = {0.f, 0.f, 0.f, 0.f, 0.f, 0.f, 0.f, 0.f};
#pragma unroll 1
                        for (int i = 0; i < 4; ++i) p0_item_gv(p, kind, base + wave * 4 + i, scr, lane, ca);
                        p0_gv_flush(p, kind, base + wave * 4, lane, ca); }
                }
            }
            { unsigned spins = 0;
#pragma unroll 1
              while ((pc.next < 64 || gnext < 64) && spins < (1u << 22)) { scan_prefetch_tick(p, hu, hj, pc, tid); scan_gate_tick(p, hu, hj, gnext, tid); __builtin_amdgcn_s_sleep(16); ++spins; } }
        }
        __syncthreads(); } SEAM(12);
    if (IN(13)) _Pragma("unroll") for (int rep = 0; rep < REPS(13); ++rep) { PHASE_IDS if (G != 256) gdn_gate_phase(p, tid); } if (G != 256) SEAM(13);
    if (IN(14)) _Pragma("unroll") for (int rep = 0; rep < REPS(14); ++rep) { PHASE_IDS pg8::Gemm g{(const bf16*)(ws + WS_GO), (const bf16*)(ws + WS_WGOUT), MPROMPT, DM, GVAL}; pg8::StaticOrder S; S.init(MPROMPT, DM, G, (int)blockIdx.x);
        pg8::EpiResidN E{XR, XR, mod1 + 2 * DM, H, p.norm_ffn + DM, mod1 + 3 * DM, SSQ + 2 * 8192};
        pg8::gemm_phase<pg8::EpiResidN, pg8::StaticOrder, true, true>(lds, g, S, E);
        small_gemm_phase(lds, (const bf16*)(ws + WS_GO), GVAL, MPROMPT, 1, (const bf16*)(ws + WS_WGOUT), GVAL, 0, DM / 64, SEpiResidAdd{XR + (size_t)MPROMPT * DM, mod1 + 2 * DM}, tid, wave, lane, 8); } SEAM(14);
    if (IN(16)) _Pragma("unroll") for (int rep = 0; rep < REPS(16); ++rep) { PHASE_IDS sample_prenorm(p, 2, XR, p.norm_ffn + DM, mod1, 3, H, tid, wave, lane);
        pg8::Gemm g{H, (const bf16*)(ws + WS_WUP1), MPROMPT, NUP, DM}; pg8::StaticOrder S; S.init(MPROMPT, NUP, G, (int)blockIdx.x);
        pg8::EpiAct E{(bf16*)(ws + WS_ACT), (bf16*)(ws + WS_BIG), p.fconv_w + (size_t)1 * 3 * NUP, p.fconv_b + (size_t)1 * NUP, lds};
        pg8::PrefOrder PS{S, lds, SSQ + 2 * 8192, CV + CV_UP1, NUP, p.fconv_w + (size_t)1 * 3 * NUP, p.fconv_b + (size_t)1 * NUP};
        if ((int)blockIdx.x >= (MPROMPT / 256) * (NUP / 256) % G) { convert_queue(p, 2 * 6 + rep, IT_DN1, NITEMS, lds, MISC, tid, wave, lane, STAGGER_BATCHES); __syncthreads(); }
        pg8::gemm_phase<pg8::EpiAct, pg8::PrefOrder, true, true>(lds, g, PS, E);
        sample_prenorm_wait(p, 2, tid);
        small_gemm_phase(lds, H, DM, MPROMPT, 1, (const bf16*)(ws + WS_WUP1), DM, 0, NUP / 64, SEpiUpSample{(bf16*)(ws + WS_BIG)}, tid, wave, lane);
        convert_queue(p, 2 * 6 + rep, IT_DN1, NITEMS, lds, MISC, tid, wave, lane); } SEAM(16);
    if (IN(17)) _Pragma("unroll") for (int rep = 0; rep < REPS(17); ++rep) { PHASE_IDS ffn_act_phase(p, 1, tid); } SEAM(17);
    if (IN(18)) _Pragma("unroll") for (int rep = 0; rep < REPS(18); ++rep) { PHASE_IDS pg8::Gemm g{(const bf16*)(ws + WS_ACT), (const bf16*)(ws + WS_WDN1), MPROMPT, DM, DFF}; pg8::StaticOrder S; S.init(MPROMPT, DM, G, (int)blockIdx.x);
#if defined(NULLEPI)
        pg8::EpiResid E{XR, XR + (size_t)MPROMPT * DM, (REPS(18) == 2 && rep == 0) ? nullptr : XR, mod1 + 5 * DM};
#else
        pg8::EpiResid E{XR, XR + (size_t)MPROMPT * DM, (REPS(18) == 2 && rep == 0) ? (float*)(ws + WS_BIG) : XR, mod1 + 5 * DM};
#endif
        pg8::gemm_phase<pg8::EpiResid, pg8::StaticOrder, true, true>(lds, g, S, E);
        if (!(REPS(18) == 2 && rep == 0)) small_gemm_phase(lds, (const bf16*)(ws + WS_ACT), DFF, MPROMPT, 1, (const bf16*)(ws + WS_WDN1), DFF, 0, DM / 64, SEpiResidAdd{XR + (size_t)MPROMPT * DM, mod1 + 5 * DM}, tid, wave, lane, 11); }
#undef IN
#undef SEAM
}

extern "C" void kernel_launch(void* const* d_in, const int* in_sizes, int n_in, void* d_out, int out_size, void* d_ws, size_t ws_size, hipStream_t stream) {
    static int grid = 0;
    if (grid == 0) {
        if (n_in != 29 || (size_t)out_size != O_END || ws_size < WS_END) { fprintf(stderr, "kernel_launch: unexpected sizes: n_in %d out %d ws %zu (need 29, %zu, >= %zu)\n", n_in, out_size, ws_size, (size_t)O_END, (size_t)WS_END); grid = -1; return; }
        int dev = 0, cus = 0, per_cu = 0;
        if (hipGetDevice(&dev) != hipSuccess || hipDeviceGetAttribute(&cus, hipDeviceAttributeMultiprocessorCount, dev) != hipSuccess) { grid = -1; return; }
        if (hipFuncSetAttribute((const void*)hybrid_fwd, hipFuncAttributeMaxDynamicSharedMemorySize, LDS_BYTES) != hipSuccess) { fprintf(stderr, "kernel_launch: hipFuncSetAttribute failed\n"); grid = -1; return; }
        if (hipOccupancyMaxActiveBlocksPerMultiprocessor(&per_cu, (const void*)hybrid_fwd, 512, LDS_BYTES) != hipSuccess || per_cu < 1) { fprintf(stderr, "kernel_launch: occupancy query says %d\n", per_cu); per_cu = 1; }
        (void)hipGetLastError();
        grid = cus;
    }
    if (grid < 0) return;
    (void)hipMemsetAsync((char*)d_ws + WS_CTL, 0, CTL_ZERO_BYTES, stream);
    Args a{};
    for (int i = 0; i < 29; ++i) a.in[i] = (const float*)d_in[i];
    a.out = (float*)d_out; a.ws = (unsigned char*)d_ws; a.one = 1;
    if (MK_N_LAUNCHES == 1) { a.ph_lo = 0; a.ph_hi = N_PHASES; hipLaunchKernelGGL(hybrid_fwd, dim3(grid), dim3(512), LDS_BYTES, stream, a); }
    else { for (int k = 0; k < N_PHASES; ++k) { a.ph_lo = k; a.ph_hi = k + 1; hipLaunchKernelGGL(hybrid_fwd, dim3(grid), dim3(512), LDS_BYTES, stream, a); } }
}
```
